# Optimizing an MI355X kernel written in HIP

```python
import math
import jax, jax.numpy as jnp
from jax import lax
import numpy as np

D_MODEL = 2048
BATCH = 4
SEQ = 2048
DEPTH = 2

CTX_LEN = 256
GRID_W = 64
Q_BLOCK = 128
EPS = 1e-6
ROPE_THETA = 10000.0

DA_HEADS = 6
DA_QK_DIM = 64
DA_V_DIM = 2 * DA_QK_DIM
DA_WIDTH = DA_HEADS * DA_V_DIM
DA_QK_COLS = DA_HEADS * 2 * DA_QK_DIM
DA_SCALE = DA_QK_DIM ** -0.5

GM_GROUPS = 4
GM_CH = 128
GM_CHUNK = 128
GM_WIDTH = GM_GROUPS * GM_CH

MLA_HEADS = 6
MLA_Q_RANK = 512
MLA_KV_RANK = 512
MLA_NOPE = 128
MLA_ROPE = 64
MLA_V = 128
MLA_WIDTH = MLA_HEADS * MLA_V
MLA_SCALE = (MLA_NOPE + MLA_ROPE) ** -0.5

ROT_DIM = 64
MIX_WIDTH = DA_WIDTH + GM_WIDTH + MLA_WIDTH
IN_SIZES = (DA_QK_COLS, DA_QK_COLS, DA_WIDTH, GM_WIDTH, GM_WIDTH, MLA_Q_RANK, MLA_KV_RANK, MLA_ROPE)
IN_COLS = sum(IN_SIZES)
D_FF = 4 * D_MODEL

kernel_name = 'hybrid_diffattn_gmlp_mla_dit'


def rms_norm(x, g):
    xf = x.astype(jnp.float32)
    y = xf * lax.rsqrt(jnp.mean(xf * xf, axis=-1, keepdims=True) + EPS)
    return (y * g.astype(jnp.float32)).astype(x.dtype)


def modulate(h, shift, scale):
    return h * (1.0 + scale) + shift


def axial_rope_tables(rows):
    row = jnp.repeat(jnp.arange(rows, dtype=jnp.float32), GRID_W)
    col = jnp.tile(jnp.arange(GRID_W, dtype=jnp.float32), rows)
    n_f = ROT_DIM // 4
    inv = ROPE_THETA ** (-jnp.arange(n_f, dtype=jnp.float32) / n_f)
    ang = jnp.concatenate([row[:, None] * inv, col[:, None] * inv], axis=-1)
    return jnp.cos(ang), jnp.sin(ang)


def apply_rope(x, cos, sin):
    extra = x.ndim - 3
    cs = cos.reshape(cos.shape[:1] + (1,) * extra + cos.shape[1:]).astype(x.dtype)
    sn = sin.reshape(sin.shape[:1] + (1,) * extra + sin.shape[1:]).astype(x.dtype)
    xp = x.reshape(x.shape[:-1] + (x.shape[-1] // 2, 2))
    x0, x1 = xp[..., 0], xp[..., 1]
    return jnp.stack([x0 * cs - x1 * sn, x0 * sn + x1 * cs], axis=-1).reshape(x.shape)


def split_in(z):
    offs = [int(o) for o in np.cumsum(IN_SIZES)[:-1]]
    return jnp.split(z, offs, axis=-1)


def over_query_blocks(fn, *qs):
    b, n = qs[0].shape[:2]
    nb = n // Q_BLOCK
    blocks = tuple(jnp.moveaxis(q.reshape((b, nb, Q_BLOCK) + q.shape[2:]), 1, 0) for q in qs)
    out = lax.map(lambda blk: fn(*blk), blocks)
    out = jnp.moveaxis(out, 0, 1)
    return out.reshape((b, n) + out.shape[3:])


def diff_attention(q, k, v, lam, scale):
    s = jnp.einsum('bqhcd,bkhcd->bhcqk', q, k).astype(jnp.float32) * scale
    p = jax.nn.softmax(s, axis=-1)
    w = p[:, :, 0] - lam * p[:, :, 1]
    return jnp.einsum('bhqk,bkhd->bqhd', w.astype(v.dtype), v)


def mla_attention(q_nope, q_rope, k_nope, k_rope, v, scale):
    s = (jnp.einsum('bqhd,bkhd->bhqk', q_nope, k_nope)
         + jnp.einsum('bqhr,bkr->bhqk', q_rope, k_rope)).astype(jnp.float32) * scale
    p = jax.nn.softmax(s, axis=-1).astype(v.dtype)
    return jnp.einsum('bhqk,bkhd->bqhd', p, v)


def chunk_spatial_gating(u, v, w_spatial, b_spatial):
    b, n = u.shape[:2]
    vb = v.reshape(b, n // GM_CHUNK, GM_CHUNK, GM_GROUPS, GM_CH)
    mixed = jnp.einsum('gpq,bmqgc->bmpgc', w_spatial, vb) + b_spatial.T[None, None, :, :, None]
    return (u * mixed.reshape(b, n, GM_GROUPS, GM_CH)).reshape(b, n, GM_WIDTH)


def keys_values(z, g_mla_kv, w_mla_ukv, rope):
    b, n, _ = z.shape
    _, k, v, _, _, _, ckv, kr = split_in(z)
    k = k.reshape(b, n, DA_HEADS, 2, DA_QK_DIM)
    v = v.reshape(b, n, DA_HEADS, DA_V_DIM)
    kv = (rms_norm(ckv, g_mla_kv) @ w_mla_ukv).reshape(b, n, MLA_HEADS, MLA_NOPE + MLA_V)
    k_nope, v_mla = kv[..., :MLA_NOPE], kv[..., MLA_NOPE:]
    if rope is not None:
        cos, sin = rope
        k = apply_rope(k, cos, sin)
        kr = apply_rope(kr, cos, sin)
    return k, v, k_nope, kr, v_mla


def queries_and_gating(z, g_gm_v, w_spatial, b_spatial, g_mla_q, w_mla_uq, rope):
    b, n, _ = z.shape
    q, _, _, gu, gv, cq, _, _ = split_in(z)
    q = q.reshape(b, n, DA_HEADS, 2, DA_QK_DIM)
    qm = (rms_norm(cq, g_mla_q) @ w_mla_uq).reshape(b, n, MLA_HEADS, MLA_NOPE + MLA_ROPE)
    q_nope, q_rope = qm[..., :MLA_NOPE], qm[..., MLA_NOPE:]
    if rope is not None:
        cos, sin = rope
        q = apply_rope(q, cos, sin)
        q_rope = apply_rope(q_rope, cos, sin)
    u = jax.nn.gelu(gu, approximate=False).reshape(b, n, GM_GROUPS, GM_CH)
    v = rms_norm(jax.nn.gelu(gv, approximate=False).reshape(b, n, GM_GROUPS, GM_CH), g_gm_v)
    gated = chunk_spatial_gating(u, v, w_spatial, b_spatial)
    return q, q_nope, q_rope, gated


def diff_head_out(o, g_da_sub, lam_init):
    b, n = o.shape[:2]
    return (rms_norm(o, g_da_sub) * (1.0 - lam_init)).reshape(b, n, DA_WIDTH)


def sq_relu_mlp(h, w_fc1, w_fc2):
    return jnp.square(jax.nn.relu(h @ w_fc1)) @ w_fc2


def setup_inputs(seed: int = 0) -> dict:
    key = jax.random.key(seed)
    ks = jax.random.split(key, 25)
    f32 = jnp.float32

    def nrm(k, shape, scale):
        return jax.random.normal(k, shape, f32) * scale

    def gain(k, shape):
        return 1.0 + 0.02 * jax.random.normal(k, shape, f32)

    return {
        'x': nrm(ks[0], (BATCH, SEQ, D_MODEL), 1.0),
        'c': nrm(ks[1], (BATCH, D_MODEL), 1.0),
        'ctx': nrm(ks[2], (BATCH, CTX_LEN, D_MODEL), 1.0),
        'c_ctx': nrm(ks[3], (D_MODEL,), 1.0),
        'w_mod': nrm(ks[4], (DEPTH, D_MODEL, 6 * D_MODEL), 0.5 * D_MODEL ** -0.5),
        'b_mod': nrm(ks[5], (DEPTH, 6 * D_MODEL), 0.01),
        'g_norm_mix': gain(ks[6], (DEPTH, D_MODEL)),
        'g_norm_mlp': gain(ks[7], (DEPTH, D_MODEL)),
        'w_in': nrm(ks[8], (DEPTH, D_MODEL, IN_COLS), D_MODEL ** -0.5),
        'lam_q1': nrm(ks[9], (DEPTH, DA_QK_DIM), 0.1),
        'lam_k1': nrm(ks[10], (DEPTH, DA_QK_DIM), 0.1),
        'lam_q2': nrm(ks[11], (DEPTH, DA_QK_DIM), 0.1),
        'lam_k2': nrm(ks[12], (DEPTH, DA_QK_DIM), 0.1),
        'g_da_sub': gain(ks[13], (DEPTH, DA_V_DIM)),
        'g_gm_v': gain(ks[14], (DEPTH, GM_GROUPS, GM_CH)),
        'w_spatial': nrm(ks[15], (DEPTH, GM_GROUPS, GM_CHUNK, GM_CHUNK), GM_CHUNK ** -0.5),
        'b_spatial': gain(ks[16], (DEPTH, GM_GROUPS, GM_CHUNK)),
        'g_mla_q': gain(ks[17], (DEPTH, MLA_Q_RANK)),
        'w_mla_uq': nrm(ks[18], (DEPTH, MLA_Q_RANK, MLA_HEADS * (MLA_NOPE + MLA_ROPE)), MLA_Q_RANK ** -0.5),
        'g_mla_kv': gain(ks[19], (DEPTH, MLA_KV_RANK)),
        'w_mla_ukv': nrm(ks[20], (DEPTH, MLA_KV_RANK, MLA_HEADS * (MLA_NOPE + MLA_V)), MLA_KV_RANK ** -0.5),
        'w_out': nrm(ks[21], (DEPTH, MIX_WIDTH, D_MODEL), MIX_WIDTH ** -0.5),
        'w_fc1': nrm(ks[22], (DEPTH, D_MODEL, D_FF), D_MODEL ** -0.5),
        'w_fc2': nrm(ks[23], (DEPTH, D_FF, D_MODEL), D_FF ** -0.5),
        'g_final': gain(ks[24], (D_MODEL,)),
    }


def reference(x, c, ctx, c_ctx, w_mod, b_mod, g_norm_mix, g_norm_mlp, w_in,
              lam_q1, lam_k1, lam_q2, lam_k2, g_da_sub, g_gm_v, w_spatial, b_spatial,
              g_mla_q, w_mla_uq, g_mla_kv, w_mla_ukv, w_out, w_fc1, w_fc2, g_final):
    n = x.shape[1]
    rows = n // GRID_W
    rope = axial_rope_tables(rows)
    xc = ctx
    sc_lat = jax.nn.silu(c)
    sc_ctx = jax.nn.silu(c_ctx)

    for l in range(DEPTH):
        update_ctx = l < DEPTH - 1
        lam_init = 0.8 - 0.6 * math.exp(-0.3 * l)
        f32 = jnp.float32
        lam = (jnp.exp(jnp.sum(lam_q1[l].astype(f32) * lam_k1[l].astype(f32)))
               - jnp.exp(jnp.sum(lam_q2[l].astype(f32) * lam_k2[l].astype(f32))) + lam_init)

        mod = sc_lat @ w_mod[l] + b_mod[l]
        mod_c = sc_ctx @ w_mod[l] + b_mod[l]
        sh1, sc1, gt1, sh2, sc2, gt2 = jnp.split(mod[:, None, :], 6, axis=-1)
        csh1, csc1, cgt1, csh2, csc2, cgt2 = jnp.split(mod_c, 6, axis=-1)

        h = modulate(rms_norm(x, g_norm_mix[l]), sh1, sc1)
        hc = modulate(rms_norm(xc, g_norm_mix[l]), csh1, csc1)
        z = h @ w_in[l]
        zc = hc @ w_in[l]

        k, v, kn, kr, vm = keys_values(z, g_mla_kv[l], w_mla_ukv[l], rope)
        kc, vc, knc, krc, vmc = keys_values(zc, g_mla_kv[l], w_mla_ukv[l], None)
        q, qn, qr, gated = queries_and_gating(z, g_gm_v[l], w_spatial[l], b_spatial[l],
                                              g_mla_q[l], w_mla_uq[l], rope)

        k_all = jnp.concatenate([kc, k], axis=1)
        v_all = jnp.concatenate([vc, v], axis=1)
        kn_all = jnp.concatenate([knc, kn], axis=1)
        kr_all = jnp.concatenate([krc, kr], axis=1)
        vm_all = jnp.concatenate([vmc, vm], axis=1)
        o_da = over_query_blocks(lambda qb: diff_attention(qb, k_all, v_all, lam, DA_SCALE), q)
        o_mla = over_query_blocks(
            lambda qnb, qrb: mla_attention(qnb, qrb, kn_all, kr_all, vm_all, MLA_SCALE), qn, qr)
        heads = jnp.concatenate([diff_head_out(o_da, g_da_sub[l], lam_init), gated,
                                 o_mla.reshape(o_mla.shape[0], n, MLA_WIDTH)], axis=-1)
        x = x + gt1 * (heads @ w_out[l])

        h2 = modulate(rms_norm(x, g_norm_mlp[l]), sh2, sc2)
        x = x + gt2 * sq_relu_mlp(h2, w_fc1[l], w_fc2[l])

        if update_ctx:
            qc, qnc, qrc, gated_c = queries_and_gating(zc, g_gm_v[l], w_spatial[l], b_spatial[l],
                                                       g_mla_q[l], w_mla_uq[l], None)
            o_da_c = diff_attention(qc, kc, vc, lam, DA_SCALE)
            o_mla_c = mla_attention(qnc, qrc, knc, krc, vmc, MLA_SCALE)
            heads_c = jnp.concatenate([diff_head_out(o_da_c, g_da_sub[l], lam_init), gated_c,
                                       o_mla_c.reshape(o_mla_c.shape[0], CTX_LEN, MLA_WIDTH)], axis=-1)
            xc = xc + cgt1 * (heads_c @ w_out[l])
            h2c = modulate(rms_norm(xc, g_norm_mlp[l]), csh2, csc2)
            xc = xc + cgt2 * sq_relu_mlp(h2c, w_fc1[l], w_fc2[l])

    return rms_norm(x, g_final)
```

```cpp
#include <hip/hip_runtime.h>
#include <hip/hip_cooperative_groups.h>
#include <cstdio>
#include <cstdint>
namespace cg = cooperative_groups;
namespace pg8 {
#define PG8_LAS __attribute__((address_space(3)))
typedef unsigned short bf16_t;
typedef short bf16x8 __attribute__((ext_vector_type(8)));
typedef float f32x4 __attribute__((ext_vector_type(4)));
typedef unsigned u32x4 __attribute__((ext_vector_type(4)));
constexpr int BM = 256, BK = 64, HALF = 128, HTB = HALF * BK * 2  , STAGE_BYTES = 8 * HTB, NXCD = 8, WGM = 8;

__host__ __device__ __forceinline__ int lds_byte(int r, int c) { const int st = (r >> 4) * 2 + (c >> 5), rr = r & 15, cc = c & 31, ob = rr * 64 + cc * 2; return st * 1024 + (ob ^ (((ob >> 9) & 1) << 5)); }
__host__ __device__ __forceinline__ void stage_rc(int b, int& R, int& C) { const int st = b / 1024, sb = b % 1024, swz = sb ^ (((sb >> 9) & 1) << 5); R = (st >> 1) * 16 + swz / 64; C = (st & 1) * 32 + (swz % 64) / 2; }
__host__ __device__ __forceinline__ int perm32(int rho) { const int n = rho >> 4, i = rho & 15; return 8 * (i >> 2) + 4 * n + (i & 3); }

struct Unit { int pm, pn; };
struct Gemm { const bf16_t* A; const bf16_t* Bt; int M, N, K; };

__device__ __forceinline__ unsigned cvt_pk_bf16(float lo, float hi) { unsigned r; asm volatile("v_cvt_pk_bf16_f32 %0, %1, %2" : "=v"(r) : "v"(lo), "v"(hi)); return r; }
typedef float f32x2 __attribute__((ext_vector_type(2)));
__device__ __forceinline__ f32x2 gelu_pk(f32x2 v) {
    const f32x2 av = __builtin_elementwise_abs(v), d = av * 0.2316418882f + 1.0f;
    f32x2 t; t.x = __builtin_amdgcn_rcpf(d.x); t.y = __builtin_amdgcn_rcpf(d.y);
    f32x2 q = t * 0.5307027145f + (-0.7265760135f); q = q * t + 0.7107068705f; q = q * t + (-0.142248368f); q = q * t + 0.127414796f; q = q * t;
    const f32x2 s = (v * v) * (-0.72134752044f);
    f32x2 e; e.x = __builtin_amdgcn_exp2f(s.x); e.y = __builtin_amdgcn_exp2f(s.y);
    const f32x2 m = v * (q * e), r = v - m;
    f32x2 o; o.x = v.x < 0.f ? m.x : r.x; o.y = v.y < 0.f ? m.y : r.y; return o;
}
template <class Epi, class Sched, bool ALIGN_EPI = false, bool SP2 = false>
__device__ __forceinline__ void gemm_phase(PG8_LAS unsigned char* lds, const Gemm g, const Sched& S, const Epi& E) {
    int tid_ = threadIdx.x; asm volatile("" : "+v"(tid_)); const int tid = tid_, wid = __builtin_amdgcn_readfirstlane(tid >> 6), lane = tid & 63, wr = wid >> 2, wc = wid & 3, fr = lane & 15, fq = lane >> 4;
    const int K = g.K, nt = K / BK;
    unsigned voffA[2], voffB[2];
#pragma unroll
    for (int i = 0; i < 2; ++i) { int R, C; stage_rc(tid * 16 + i * 8192, R, C); const int Rb = Epi::PERM ? ((R & ~31) + perm32(R & 31)) : R;
        voffA[i] = (unsigned)(R * K + C) * 2u; voffB[i] = (unsigned)(Rb * K + C) * 2u; }
    const size_t kstep = (size_t)(BK * 2);
    const size_t hstep = (size_t)HALF * K * 2;
    const size_t tstep = 2 * hstep;
    const unsigned ldsw = (unsigned)wid * 1024u;
    const int aoff = lds_byte(wr * 64 + fr, fq * 8), boff = lds_byte(wc * 32 + fr, fq * 8);
#define PG8_SA(b, h) (((b) * 2 + (h)) * HTB)
#define PG8_SB(b, h) ((4 + (b) * 2 + (h)) * HTB)
#define PG8_STAGE(bufoff, gbase, voff) do { _Pragma("unroll") for (int _i = 0; _i < 2; ++_i) \
        __builtin_amdgcn_global_load_lds((const unsigned*)((const char*)(gbase) + (voff)[_i]), (PG8_LAS unsigned*)(lds + (bufoff) + ldsw + _i * 8192), 16, 0, 0); } while (0)
#define PG8_LDA(dst, b, h) do { _Pragma("unroll") for (int m = 0; m < 4; ++m) _Pragma("unroll") for (int k = 0; k < 2; ++k) dst[m][k] = *(const PG8_LAS bf16x8*)(lds + PG8_SA(b, h) + aoff + m * 2048 + k * 1024); } while (0)
#define PG8_LDB(dst, b, h) do { _Pragma("unroll") for (int n = 0; n < 2; ++n) _Pragma("unroll") for (int k = 0; k < 2; ++k) dst[n][k] = *(const PG8_LAS bf16x8*)(lds + PG8_SB(b, h) + boff + n * 2048 + k * 1024); } while (0)
#define PG8_MMA(ai, bj, At, Bt) do { __builtin_amdgcn_s_setprio(1); _Pragma("unroll") for (int m = 0; m < 4; ++m) _Pragma("unroll") for (int n = 0; n < 2; ++n) _Pragma("unroll") for (int k = 0; k < 2; ++k) \
        acc[ai][bj][m][n] = __builtin_amdgcn_mfma_f32_16x16x32_bf16(Bt[n][k], At[m][k], acc[ai][bj][m][n], 0, 0, 0); __builtin_amdgcn_s_setprio(0); } while (0)
#define PG8_WAIT_V(n) asm volatile("s_waitcnt vmcnt(" #n ")" ::: "memory")
#define PG8_WAIT_L(n) asm volatile("s_waitcnt lgkmcnt(" #n ")" ::: "memory")
#define PG8_BAR __builtin_amdgcn_s_barrier()
#define PG8_SCHED __builtin_amdgcn_sched_barrier(0)
    Unit cur, nxt; int ui = 0;
    if (!S.next(0, cur)) return;
    f32x4 acc[2][2][4][2];
#pragma unroll
    for (int a = 0; a < 2; ++a)
#pragma unroll
        for (int b = 0; b < 2; ++b)
#pragma unroll
            for (int m = 0; m < 4; ++m)
#pragma unroll
                for (int n = 0; n < 2; ++n) acc[a][b][m][n] = (f32x4){0.f, 0.f, 0.f, 0.f};
    bf16x8 At[4][2], B0[2][2], B1[2][2];
    const char* cA = (const char*)g.A + (size_t)cur.pm * tstep; const char* cB = (const char*)g.Bt + (size_t)cur.pn * tstep;
    S.a_ready(cur);
    if constexpr (SP2) {
        PG8_STAGE(PG8_SB(0, 0), cB, voffB); PG8_STAGE(PG8_SB(0, 1), cB + hstep, voffB); PG8_STAGE(PG8_SA(0, 0), cA, voffA); PG8_STAGE(PG8_SA(0, 1), cA + hstep, voffA);
        if (wr == 1) PG8_BAR;
        PG8_WAIT_V(2); PG8_BAR;
        PG8_STAGE(PG8_SB(1, 0), cB + kstep, voffB); PG8_STAGE(PG8_SA(1, 0), cA + kstep, voffA); PG8_STAGE(PG8_SB(1, 1), cB + hstep + kstep, voffB);
        PG8_WAIT_V(6); PG8_BAR;
    } else {
        PG8_STAGE(PG8_SB(0, 0), cB, voffB); PG8_STAGE(PG8_SA(0, 0), cA, voffA); PG8_STAGE(PG8_SB(0, 1), cB + hstep, voffB); PG8_STAGE(PG8_SA(0, 1), cA + hstep, voffA);
        if (wr == 1) PG8_BAR;
        PG8_WAIT_V(4); PG8_BAR;
        PG8_STAGE(PG8_SB(1, 0), cB + kstep, voffB); PG8_STAGE(PG8_SA(1, 0), cA + kstep, voffA); PG8_STAGE(PG8_SB(1, 1), cB + hstep + kstep, voffB);
        PG8_WAIT_V(6); PG8_BAR;
    }
    for (;;) {
        const bool has_next = S.next(ui + 1, nxt);
        const char* nA = has_next ? (const char*)g.A + (size_t)nxt.pm * tstep : cA; const char* nB = has_next ? (const char*)g.Bt + (size_t)nxt.pn * tstep : cB;
        for (int t = 0; t < nt; t += 2) {
            const bool last = (t == nt - 2);
            const char* a1 = cA + (size_t)(t + 1) * kstep;
            const char* a2 = last ? nA : cA + (size_t)(t + 2) * kstep; const char* b2 = last ? nB : cB + (size_t)(t + 2) * kstep;
            const char* a3 = a2 + kstep; const char* b3 = b2 + kstep;
            if (last && has_next) S.a_ready(nxt);
            if constexpr (SP2) {
            PG8_LDB(B0, 0, 0); PG8_LDB(B1, 0, 1); PG8_SCHED; PG8_LDA(At, 0, 0); PG8_STAGE(PG8_SA(1, 1), a1 + hstep, voffA);
            PG8_WAIT_V(8); PG8_WAIT_L(0); PG8_BAR; PG8_MMA(0, 0, At, B0); PG8_MMA(0, 1, At, B1); PG8_BAR; PG8_SCHED;
            PG8_LDA(At, 0, 1); PG8_STAGE(PG8_SB(0, 0), b2, voffB); PG8_STAGE(PG8_SB(0, 1), b2 + hstep, voffB); PG8_STAGE(PG8_SA(0, 0), a2, voffA);
            PG8_WAIT_V(8); PG8_WAIT_L(0); PG8_BAR; PG8_MMA(1, 0, At, B0); PG8_MMA(1, 1, At, B1); PG8_BAR; PG8_SCHED;
            PG8_LDB(B0, 1, 0); PG8_LDB(B1, 1, 1); PG8_SCHED; PG8_LDA(At, 1, 0); PG8_STAGE(PG8_SA(0, 1), a2 + hstep, voffA);
            PG8_WAIT_V(8); PG8_WAIT_L(0); PG8_BAR; PG8_MMA(0, 0, At, B0); PG8_MMA(0, 1, At, B1); PG8_BAR; PG8_SCHED;
            PG8_LDA(At, 1, 1); PG8_STAGE(PG8_SB(1, 0), b3, voffB); PG8_STAGE(PG8_SB(1, 1), b3 + hstep, voffB); PG8_STAGE(PG8_SA(1, 0), a3, voffA);
            PG8_WAIT_V(8); PG8_WAIT_L(0); PG8_BAR; PG8_MMA(1, 0, At, B0); PG8_MMA(1, 1, At, B1); PG8_BAR; PG8_SCHED;
            } else {
            PG8_LDB(B0, 0, 0); PG8_SCHED; PG8_LDA(At, 0, 0); PG8_STAGE(PG8_SA(1, 1), a1 + hstep, voffA);
            PG8_WAIT_L(8); PG8_BAR; PG8_WAIT_L(0); PG8_MMA(0, 0, At, B0); PG8_BAR; PG8_SCHED;
            PG8_LDB(B1, 0, 1); PG8_STAGE(PG8_SB(0, 0), b2, voffB);
            PG8_BAR; PG8_WAIT_L(0); PG8_MMA(0, 1, At, B1); PG8_BAR;
            PG8_LDA(At, 0, 1); PG8_STAGE(PG8_SA(0, 0), a2, voffA);
            PG8_BAR; PG8_WAIT_L(0); PG8_MMA(1, 0, At, B0); PG8_BAR; PG8_SCHED;
            PG8_STAGE(PG8_SB(0, 1), b2 + hstep, voffB);
            PG8_WAIT_V(6); PG8_BAR; PG8_MMA(1, 1, At, B1); PG8_BAR;
            PG8_LDB(B0, 1, 0); PG8_SCHED; PG8_LDA(At, 1, 0); PG8_STAGE(PG8_SA(0, 1), a2 + hstep, voffA);
            PG8_WAIT_L(8); PG8_BAR; PG8_WAIT_L(0); PG8_MMA(0, 0, At, B0); PG8_BAR; PG8_SCHED;
            PG8_LDB(B1, 1, 1); PG8_STAGE(PG8_SB(1, 0), b3, voffB);
            PG8_BAR; PG8_WAIT_L(0); PG8_MMA(0, 1, At, B1); PG8_BAR;
            PG8_LDA(At, 1, 1); PG8_STAGE(PG8_SA(1, 0), a3, voffA);
            PG8_BAR; PG8_WAIT_L(0); PG8_MMA(1, 0, At, B0); PG8_BAR; PG8_SCHED;
            PG8_STAGE(PG8_SB(1, 1), b3 + hstep, voffB);
            PG8_WAIT_V(6); PG8_BAR; PG8_MMA(1, 1, At, B1); PG8_BAR;
            }
        }
        if constexpr (ALIGN_EPI) { if (wr == 0) PG8_BAR; }
        if constexpr (!Epi::AFTER_DRAIN) { E(acc, cur, wr, wc, fr, fq); S.done(cur); }
        if (!has_next) break;
#pragma unroll
        for (int a = 0; a < 2; ++a)
#pragma unroll
            for (int b = 0; b < 2; ++b)
#pragma unroll
                for (int m = 0; m < 4; ++m)
#pragma unroll
                    for (int n = 0; n < 2; ++n) acc[a][b][m][n] = (f32x4){0.f, 0.f, 0.f, 0.f};
        cur = nxt; cA = nA; cB = nB; ++ui;
        if constexpr (ALIGN_EPI) { if (wr == 1) PG8_BAR; }
    }
    PG8_WAIT_V(0);
    if constexpr (!ALIGN_EPI) { if (wr == 0) PG8_BAR; }
    PG8_BAR;
    if constexpr (Epi::AFTER_DRAIN) { E.fused(acc, cur, wr, wc, fr, fq, lds, wid, lane); S.done(cur); }
#undef PG8_SA
#undef PG8_SB
#undef PG8_STAGE
#undef PG8_LDA
#undef PG8_LDB
#undef PG8_MMA
#undef PG8_WAIT_V
#undef PG8_WAIT_L
#undef PG8_BAR
#undef PG8_SCHED
}
}

#define GAS __attribute__((address_space(1)))
#define LAS __attribute__((address_space(3)))
typedef unsigned short bf16;
typedef float f32x4 __attribute__((ext_vector_type(4)));
typedef float f32x2 __attribute__((ext_vector_type(2)));
typedef float f32x16 __attribute__((ext_vector_type(16)));
typedef short bf16x8 __attribute__((ext_vector_type(8)));
typedef short s16x4 __attribute__((ext_vector_type(4)));
typedef unsigned u32x4 __attribute__((ext_vector_type(4)));
typedef unsigned u32x2 __attribute__((ext_vector_type(2)));

constexpr int NB = 4, SEQ = 2048, CTX = 256, DM = 2048, DEPTH = 2, FF = 8192;
constexpr int TOK = CTX + SEQ;
constexpr int M = NB * TOK;
constexpr int NZ = 4416, NZP = 4608;
constexpr int NUQ = 1152, NUQP = 1280, NUKV = 1536, RANK = 512;
constexpr int MODW = 6 * DM;
constexpr float EPS = 1e-6f;
constexpr float LOG2E = 1.4426950408889634f;
constexpr float DA_QS = 0.125f * LOG2E;
constexpr float MLA_QS = 0.07216878364870322f * LOG2E;
constexpr int NWAVES = 8, NTHR = 512;

enum { I_X = 0, I_C, I_CTX, I_CCTX, I_WMOD, I_BMOD, I_GMIX, I_GMLP, I_WIN, I_LQ1, I_LK1, I_LQ2, I_LK2, I_GDASUB, I_GGMV, I_WSP, I_BSP,
       I_GMQ, I_WUQ, I_GMKV, I_WUKV, I_WOUT, I_WFC1, I_WFC2, I_GFINAL, N_IN };

constexpr size_t al256(size_t x) { return (x + 255) / 256 * 256; }
constexpr size_t WS_ROPE  = 0;
constexpr size_t WS_SCAL  = WS_ROPE + 8192;
constexpr size_t WS_MOD   = WS_SCAL + 256;
constexpr size_t WS_MODP  = al256(WS_MOD + (size_t)DEPTH * 5 * MODW * 4);
constexpr size_t WS_WIN   = al256(WS_MODP + (size_t)DEPTH * 32 * 5 * MODW * 4);
constexpr size_t WS_WOUT  = al256(WS_WIN + (size_t)DEPTH * NZP * DM * 2);
constexpr size_t WS_WFC1  = al256(WS_WOUT + (size_t)DEPTH * DM * DM * 2);
constexpr size_t WS_WFC2  = al256(WS_WFC1 + (size_t)DEPTH * FF * DM * 2);
constexpr size_t WS_WUQ   = al256(WS_WFC2 + (size_t)DEPTH * DM * FF * 2);
constexpr size_t WS_WUKV  = al256(WS_WUQ + (size_t)DEPTH * NUQP * RANK * 2);
constexpr size_t WS_WSP   = al256(WS_WUKV + (size_t)DEPTH * NUKV * RANK * 2);
constexpr size_t WS_XW    = al256(WS_WSP + (size_t)DEPTH * 4 * 128 * 128 * 2);
constexpr size_t WS_HN    = al256(WS_XW + (size_t)M * DM * 4);
constexpr size_t WS_QDA   = al256(WS_HN + (size_t)M * DM * 2);
constexpr size_t WS_KDA   = al256(WS_QDA + (size_t)M * 768 * 2);
constexpr size_t WS_VDA   = al256(WS_KDA + (size_t)M * 768 * 2);
constexpr size_t WS_U     = al256(WS_VDA + (size_t)M * 768 * 2);
constexpr size_t WS_GV    = al256(WS_U + (size_t)M * 512 * 4);
constexpr size_t WS_GVSS  = al256(WS_GV + (size_t)M * 512 * 4);
constexpr size_t WS_CQSS  = al256(WS_GVSS + (size_t)M * 16 * 4);
constexpr size_t WS_CKVSS = al256(WS_CQSS + (size_t)M * 8 * 4);
constexpr size_t WS_CQ    = al256(WS_CKVSS + (size_t)M * 8 * 4);
constexpr size_t WS_CKV   = al256(WS_CQ + (size_t)M * 512 * 2);
constexpr size_t WS_KMLA  = al256(WS_CKV + (size_t)M * 512 * 2);
constexpr size_t WS_VMLA  = al256(WS_KMLA + (size_t)M * 1152 * 2);
constexpr size_t WS_QMLA  = al256(WS_VMLA + (size_t)M * 768 * 2);
constexpr size_t WS_HEADS = al256(WS_QMLA + (size_t)M * 1152 * 2);
constexpr size_t WS_ACT   = al256(WS_HEADS + (size_t)M * DM * 2);
constexpr size_t WS_STASH = al256(WS_ACT + (size_t)M * FF * 2);
constexpr size_t WS_END   = al256(WS_STASH + (size_t)256 * 64 * 512 * 4);

constexpr int LDS_BYTES = 131072 + 1024;

__device__ __forceinline__ unsigned cvtpk(float lo, float hi) { unsigned r; asm volatile("v_cvt_pk_bf16_f32 %0, %1, %2" : "=v"(r) : "v"(lo), "v"(hi)); return r; }
__device__ __forceinline__ u32x4 pack8(f32x4 a, f32x4 b) { u32x4 w; w.x = cvtpk(a[0], a[1]); w.y = cvtpk(a[2], a[3]); w.z = cvtpk(b[0], b[1]); w.w = cvtpk(b[2], b[3]); return w; }
__device__ __forceinline__ float wave_sum(float v) {
#pragma unroll
    for (int o = 1; o < 64; o <<= 1) v += __shfl_xor(v, o);
    return v;
}
__device__ __forceinline__ float bf2f(unsigned short h) { return __uint_as_float(((unsigned)h) << 16); }

struct Args { const float* in[N_IN]; float* out; unsigned char* ws; int ph_lo, ph_hi; };
struct Frame {
    LAS unsigned char* lds;
    int G, vcu;
    float* out; unsigned char* ws;
};
#define WSP(T, off) ((T*)(F.ws + (off)))
template <int I> __device__ __forceinline__ const float* inp() {
    unsigned long long p; asm volatile("s_load_dwordx2 %0, %1, %2\n\ts_waitcnt lgkmcnt(0)" : "=s"(p) : "s"(__builtin_amdgcn_kernarg_segment_ptr()), "n"(I * 8) : "memory"); return (const float*)p; }

__device__ __forceinline__ const float* xrow_in(const Args& A, const Frame& F, int row) {
    const int b = row / TOK, rr = row - b * TOK;
    return rr < CTX ? inp<I_CTX>() + (size_t)(b * CTX + rr) * DM : inp<I_X>() + (size_t)(b * SEQ + rr - CTX) * DM;
}

__device__ __forceinline__ void p0_transpose_item(const float* W, int K, int N, bf16* WT, const float* kscale, LAS float* scr, int item, int lane) {
    const int nblk = N / 32, kb = item / nblk, nb = item % nblk, k0 = 64 * kb, n0 = 32 * nb;
#pragma unroll 8
    for (int i = 0; i < 32; ++i) { const int kk = 2 * i + (lane >> 5); float v = W[(size_t)(k0 + kk) * N + n0 + (lane & 31)]; if (kscale) v *= kscale[k0 + kk]; scr[kk * 33 + (lane & 31)] = v; }
    asm volatile("s_waitcnt lgkmcnt(0)" ::: "memory");
    const int c = lane & 7;
#pragma unroll
    for (int j = 0; j < 4; ++j) { const int n = (lane >> 3) + 8 * j; const LAS float* s = scr + (8 * c) * 33 + n;
        u32x4 o; o.x = cvtpk(s[0 * 33], s[1 * 33]); o.y = cvtpk(s[2 * 33], s[3 * 33]); o.z = cvtpk(s[4 * 33], s[5 * 33]); o.w = cvtpk(s[6 * 33], s[7 * 33]);
        *(u32x4*)(WT + (size_t)(n0 + n) * K + k0 + 8 * c) = o; }
    asm volatile("s_waitcnt lgkmcnt(0)" ::: "memory");
}
__device__ __forceinline__ float silu_f(float x) { return x / (1.f + __expf(-x)); }

__device__ __forceinline__ void p0_mod_item(const Args& A, const Frame& F, LAS float* scr, int item, int lane) {
    const int l = item / (32 * 48), r = item % (32 * 48), kc = r / 48, nc = r % 48;
    const int k = kc * 64 + lane;
#pragma unroll
    for (int bb = 0; bb < 5; ++bb) { const float cv = bb < 4 ? inp<I_C>()[bb * DM + k] : inp<I_CCTX>()[k]; scr[bb * 64 + lane] = silu_f(cv); }
    asm volatile("s_waitcnt lgkmcnt(0)" ::: "memory");
    const float* W = inp<I_WMOD>() + ((size_t)l * DM + kc * 64) * MODW + nc * 256 + lane * 4;
    f32x4 acc[5];
#pragma unroll
    for (int bb = 0; bb < 5; ++bb) acc[bb] = (f32x4){0.f, 0.f, 0.f, 0.f};
#pragma unroll 8
    for (int kk = 0; kk < 64; ++kk) { const f32x4 w = *(const f32x4*)(W + (size_t)kk * MODW);
#pragma unroll
        for (int bb = 0; bb < 5; ++bb) acc[bb] += w * scr[bb * 64 + kk]; }
    float* P = WSP(float, WS_MODP) + ((size_t)(l * 32 + kc) * 5) * MODW + nc * 256 + lane * 4;
#pragma unroll
    for (int bb = 0; bb < 5; ++bb) *(f32x4*)(P + (size_t)bb * MODW) = acc[bb];
    asm volatile("s_waitcnt lgkmcnt(0)" ::: "memory");
}

__device__ __forceinline__ void p0_prologue(const Args& A, const Frame& F) {
    int tid_ = threadIdx.x; asm volatile("" : "+v"(tid_)); const int ptid = tid_, plane = ptid & 63, pwave = __builtin_amdgcn_readfirstlane(ptid >> 6);
    LAS float* scr = (LAS float*)(F.lds + pwave * 16384);
    const int gw = F.vcu * NWAVES + pwave, NGW = F.G * NWAVES;
    constexpr int I_MOD = DEPTH * 32 * 48;
    constexpr int T_IN = (DM / 64) * (NZ / 32), T_OUT = (DM / 64) * (DM / 32), T_FC1 = (DM / 64) * (FF / 32), T_FC2 = (FF / 64) * (DM / 32), T_UQ = (RANK / 64) * (NUQ / 32), T_UKV = (RANK / 64) * (NUKV / 32);
    constexpr int T_L = T_IN + T_OUT + T_FC1 + T_FC2 + T_UQ + T_UKV;
    constexpr int NITEMS = I_MOD + DEPTH * T_L;
    for (int it = gw; it < NITEMS; it += NGW) {
        if (it < I_MOD) { p0_mod_item(A, F, scr, it, plane); continue; }
        int r = it - I_MOD; const int l = r / T_L; r -= l * T_L;
        if (r < T_IN)  { p0_transpose_item(inp<I_WIN>() + (size_t)l * DM * NZ, DM, NZ, WSP(bf16, WS_WIN) + (size_t)l * NZP * DM, nullptr, scr, r, plane); continue; } r -= T_IN;
        if (r < T_OUT) { p0_transpose_item(inp<I_WOUT>() + (size_t)l * DM * DM, DM, DM, WSP(bf16, WS_WOUT) + (size_t)l * DM * DM, nullptr, scr, r, plane); continue; } r -= T_OUT;
        if (r < T_FC1) { p0_transpose_item(inp<I_WFC1>() + (size_t)l * DM * FF, DM, FF, WSP(bf16, WS_WFC1) + (size_t)l * FF * DM, nullptr, scr, r, plane); continue; } r -= T_FC1;
        if (r < T_FC2) { p0_transpose_item(inp<I_WFC2>() + (size_t)l * FF * DM, FF, DM, WSP(bf16, WS_WFC2) + (size_t)l * DM * FF, nullptr, scr, r, plane); continue; } r -= T_FC2;
        if (r < T_UQ)  { p0_transpose_item(inp<I_WUQ>() + (size_t)l * RANK * NUQ, RANK, NUQ, WSP(bf16, WS_WUQ) + (size_t)l * NUQP * RANK, inp<I_GMQ>() + l * RANK, scr, r, plane); continue; } r -= T_UQ;
        p0_transpose_item(inp<I_WUKV>() + (size_t)l * RANK * NUKV, RANK, NUKV, WSP(bf16, WS_WUKV) + (size_t)l * NUKV * RANK, inp<I_GMKV>() + l * RANK, scr, r, plane);
    }
    const int gt = F.vcu * NTHR + ptid, NGT = F.G * NTHR;
    for (int i = gt; i < DEPTH * (NZP - NZ) * DM / 8; i += NGT) { const int l = i / ((NZP - NZ) * DM / 8), r = i % ((NZP - NZ) * DM / 8);
        *(u32x4*)(WSP(bf16, WS_WIN) + ((size_t)l * NZP + NZ) * DM + (size_t)r * 8) = (u32x4){0u, 0u, 0u, 0u}; }
    for (int i = gt; i < DEPTH * (NUQP - NUQ) * RANK / 8; i += NGT) { const int l = i / ((NUQP - NUQ) * RANK / 8), r = i % ((NUQP - NUQ) * RANK / 8);
        *(u32x4*)(WSP(bf16, WS_WUQ) + ((size_t)l * NUQP + NUQ) * RANK + (size_t)r * 8) = (u32x4){0u, 0u, 0u, 0u}; }
    for (int i = gt; i < DEPTH * 4 * 128 * 128 / 8; i += NGT) { const f32x4 a = *(const f32x4*)(inp<I_WSP>() + (size_t)i * 8), b = *(const f32x4*)(inp<I_WSP>() + (size_t)i * 8 + 4);
        *(u32x4*)(WSP(bf16, WS_WSP) + (size_t)i * 8) = pack8(a, b); }
    if (gt < 64 * 16) { const int pos = gt >> 4, f = gt & 15; const float inv = powf(10000.0f, -(float)f / 16.0f); const float ang = (float)pos * inv;
        WSP(float, WS_ROPE)[gt] = cosf(ang); WSP(float, WS_ROPE)[1024 + gt] = sinf(ang); }
    if (gt < 64 * DEPTH) {
        const int l = gt >> 6; const float a = inp<I_LQ1>()[l * 64 + plane] * inp<I_LK1>()[l * 64 + plane], b = inp<I_LQ2>()[l * 64 + plane] * inp<I_LK2>()[l * 64 + plane];
        const float sa = wave_sum(a), sb = wave_sum(b); const float lam_init = 0.8f - 0.6f * expf(-0.3f * (float)l);
        if (plane == 0) WSP(float, WS_SCAL)[l] = expf(sa) - expf(sb) + lam_init;
    }
}
__device__ __forceinline__ void p0b_modreduce(const Args& A, const Frame& F) {
    int tid_ = threadIdx.x; asm volatile("" : "+v"(tid_)); const int ptid = tid_, plane = ptid & 63, pwave = __builtin_amdgcn_readfirstlane(ptid >> 6);
    const int gt = F.vcu * NTHR + ptid, NGT = F.G * NTHR;
    for (int i = gt; i < DEPTH * 5 * MODW; i += NGT) { const int l = i / (5 * MODW), r = i % (5 * MODW), n = r % MODW;
        float s = inp<I_BMOD>()[l * MODW + n]; const float* P = WSP(float, WS_MODP) + (size_t)l * 32 * 5 * MODW + r;
#pragma unroll 8
        for (int kc = 0; kc < 32; ++kc) s += P[(size_t)kc * 5 * MODW];
        WSP(float, WS_MOD)[i] = s; }
}

__device__ __forceinline__ void norm_phase(const Args& A, const Frame& F, int l, bool from_inputs, const float* g, int shoff) {
    int tid_ = threadIdx.x; asm volatile("" : "+v"(tid_)); const int ptid = tid_, plane = ptid & 63, pwave = __builtin_amdgcn_readfirstlane(ptid >> 6);
    const int gw = F.vcu * NWAVES + pwave, NGW = F.G * NWAVES;
    for (int row = gw; row < M; row += NGW) {
        const int b = row / TOK, rr = row - b * TOK, bsel = rr < CTX ? 4 : b;
        const float* xr = from_inputs ? xrow_in(A, F, row) : WSP(float, WS_XW) + (size_t)row * DM;
        const float* md = WSP(float, WS_MOD) + ((size_t)l * 5 + bsel) * MODW + shoff;
        f32x4 v[8]; float s = 0.f;
#pragma unroll
        for (int j = 0; j < 8; ++j) { v[j] = *(const f32x4*)(xr + 4 * plane + 256 * j); s += (v[j].x * v[j].x + v[j].y * v[j].y) + (v[j].z * v[j].z + v[j].w * v[j].w); }
        const float rstd = 1.0f / sqrtf(wave_sum(s) * (1.f / DM) + EPS);
        bf16* o = WSP(bf16, WS_HN) + (size_t)row * DM;
#pragma unroll
        for (int j = 0; j < 8; ++j) { const int c = 4 * plane + 256 * j; const f32x4 gg = *(const f32x4*)(g + c), sh = *(const f32x4*)(md + c), sc = *(const f32x4*)(md + DM + c);
            const f32x4 y = (v[j] * rstd) * gg * (sc + 1.0f) + sh; u32x2 w; w.x = cvtpk(y.x, y.y); w.y = cvtpk(y.z, y.w); *(u32x2*)(o + c) = w; }
    }
}
__device__ __forceinline__ void final_norm_phase(const Args& A, const Frame& F) {
    int tid_ = threadIdx.x; asm volatile("" : "+v"(tid_)); const int ptid = tid_, plane = ptid & 63, pwave = __builtin_amdgcn_readfirstlane(ptid >> 6);
    const int gw = F.vcu * NWAVES + pwave, NGW = F.G * NWAVES; const float* g = inp<I_GFINAL>();
    for (int r = gw; r < NB * SEQ; r += NGW) {
        const int b = r / SEQ, t = r - b * SEQ; const float* xr = WSP(float, WS_XW) + (size_t)(b * TOK + CTX + t) * DM;
        f32x4 v[8]; float s = 0.f;
#pragma unroll
        for (int j = 0; j < 8; ++j) { v[j] = *(const f32x4*)(xr + 4 * plane + 256 * j); s += (v[j].x * v[j].x + v[j].y * v[j].y) + (v[j].z * v[j].z + v[j].w * v[j].w); }
        const float rstd = 1.0f / sqrtf(wave_sum(s) * (1.f / DM) + EPS);
        float* o = F.out + (size_t)r * DM;
#pragma unroll
        for (int j = 0; j < 8; ++j) { const int c = 4 * plane + 256 * j; const f32x4 gg = *(const f32x4*)(g + c); *(f32x4*)(o + c) = (v[j] * rstd) * gg; }
    }
}

struct TileOrder {
    int nM, nN, nwg, G, c, mode;
    __device__ void init(int N, int G_, int c_, int mode_) { mode = mode_; nM = mode_ == 0 ? 36 : (mode_ == 1 ? 32 : 4); nN = N / 256; nwg = nM * nN; G = G_; c = c_; }
    __device__ bool next(int i, pg8::Unit& u) const {
        const long L = (long)i * G + c; if (L >= nwg) return false;
        int wgid = (int)L; { const int q = nwg / 8, r = nwg % 8, xcd = wgid % 8, off = wgid / 8; wgid = (xcd < r ? xcd * (q + 1) : r * (q + 1) + (xcd - r) * q) + off; }
        const int nig = 8 * nN, gid = wgid / nig, fm = gid * 8, gsz = (nM - fm) < 8 ? (nM - fm) : 8;
        int pm = fm + ((wgid % nig) % gsz); u.pn = (wgid % nig) / gsz;
        if (mode == 1) pm = (pm >> 3) * 9 + 1 + (pm & 7); else if (mode == 2) pm = pm * 9;
        u.pm = pm; return true;
    }
    __device__ __forceinline__ void a_ready(const pg8::Unit&) const {}
    __device__ __forceinline__ void done(const pg8::Unit&) const {}
};

__device__ __forceinline__ void rope8(f32x4& v0, f32x4& v1, const float* ropetab, int pos, int f0) {
    const f32x4 c = *(const f32x4*)(ropetab + pos * 16 + f0), s = *(const f32x4*)(ropetab + 1024 + pos * 16 + f0);
    const f32x4 a = v0, b = v1;
    v0[0] = a[0] * c[0] - a[1] * s[0]; v0[1] = a[0] * s[0] + a[1] * c[0]; v0[2] = a[2] * c[1] - a[3] * s[1]; v0[3] = a[2] * s[1] + a[3] * c[1];
    v1[0] = b[0] * c[2] - b[1] * s[2]; v1[1] = b[0] * s[2] + b[1] * c[2]; v1[2] = b[2] * c[3] - b[3] * s[3]; v1[3] = b[2] * s[3] + b[3] * c[3];
}
__device__ __forceinline__ f32x4 gelu4(f32x4 v) { const f32x2 a = pg8::gelu_pk((f32x2){v[0], v[1]}), b = pg8::gelu_pk((f32x2){v[2], v[3]}); return (f32x4){a.x, a.y, b.x, b.y}; }
__device__ __forceinline__ float ss8(f32x4 a, f32x4 b) { return (a[0] * a[0] + a[1] * a[1]) + (a[2] * a[2] + a[3] * a[3]) + (b[0] * b[0] + b[1] * b[1]) + (b[2] * b[2] + b[3] * b[3]); }

struct EpiZ {
    static constexpr bool PERM = true, AFTER_DRAIN = false;
    unsigned char* ws; const float* ropetab;
    __device__ __forceinline__ void operator()(const f32x4 (&acc)[2][2][4][2], const pg8::Unit& u, int wr, int wc, int fr, int fq) const {
        const int pn = u.pn;
#pragma unroll
        for (int ai = 0; ai < 2; ++ai)
#pragma unroll
            for (int m = 0; m < 4; ++m) {
                const int row = u.pm * 256 + ai * 128 + wr * 64 + m * 16 + fr;
                const int b = row / TOK, rr = row - b * TOK; const bool lat = rr >= CTX; const int t = rr - CTX, prow = (t >> 6) & 31, pcol = t & 63;
                float ssq = 0.f;
#pragma unroll
                for (int bj = 0; bj < 2; ++bj) {
                    const int colt = bj * 128 + wc * 32 + 8 * fq;
                    f32x4 v0 = acc[ai][bj][m][0], v1 = acc[ai][bj][m][1];
                    if (pn < 6) {
                        if (lat) { const int j0 = (colt & 63) >> 1; rope8(v0, v1, ropetab, j0 < 16 ? prow : pcol, j0 & 15); }
                        if (pn < 3) { v0 *= DA_QS; v1 *= DA_QS; *(u32x4*)((bf16*)(ws + WS_QDA) + (size_t)row * 768 + pn * 256 + colt) = pack8(v0, v1); }
                        else *(u32x4*)((bf16*)(ws + WS_KDA) + (size_t)row * 768 + (pn - 3) * 256 + colt) = pack8(v0, v1);
                    } else if (pn < 9) {
                        *(u32x4*)((bf16*)(ws + WS_VDA) + (size_t)row * 768 + (pn - 6) * 256 + colt) = pack8(v0, v1);
                    } else if (pn < 11) {
                        float* o = (float*)(ws + WS_U) + (size_t)row * 512 + (pn - 9) * 256 + colt; *(f32x4*)o = gelu4(v0); *(f32x4*)(o + 4) = gelu4(v1);
                    } else if (pn < 13) {
                        v0 = gelu4(v0); v1 = gelu4(v1);
                        float* o = (float*)(ws + WS_GV) + (size_t)row * 512 + (pn - 11) * 256 + colt; *(f32x4*)o = v0; *(f32x4*)(o + 4) = v1;
                        float s = ss8(v0, v1); s += __shfl_xor(s, 16); s += __shfl_xor(s, 32);
                        if (fq == 0) ((float*)(ws + WS_GVSS))[(size_t)row * 16 + ((pn - 11) * 2 + bj) * 4 + wc] = s;
                    } else if (pn < 15) {
                        *(u32x4*)((bf16*)(ws + WS_CQ) + (size_t)row * 512 + (pn - 13) * 256 + colt) = pack8(v0, v1); ssq += ss8(v0, v1);
                    } else if (pn < 17) {
                        *(u32x4*)((bf16*)(ws + WS_CKV) + (size_t)row * 512 + (pn - 15) * 256 + colt) = pack8(v0, v1); ssq += ss8(v0, v1);
                    } else {
                        if (colt < 64) {
                            if (lat) { const int j0 = colt >> 1; rope8(v0, v1, ropetab, j0 < 16 ? prow : pcol, j0 & 15); }
                            const u32x4 w = pack8(v0, v1); bf16* o = (bf16*)(ws + WS_KMLA) + (size_t)row * 1152 + 128 + colt;
#pragma unroll
                            for (int h = 0; h < 6; ++h) *(u32x4*)(o + h * 192) = w;
                        }
                    }
                }
                if (pn >= 13 && pn < 17) {
                    ssq += __shfl_xor(ssq, 16); ssq += __shfl_xor(ssq, 32);
                    if (fq == 0) { if (pn < 15) ((float*)(ws + WS_CQSS))[(size_t)row * 8 + (pn - 13) * 4 + wc] = ssq; else ((float*)(ws + WS_CKVSS))[(size_t)row * 8 + (pn - 15) * 4 + wc] = ssq; }
                }
            }
    }
};
__device__ __forceinline__ float rstd8(const float* p, float inv_n) { const f32x4 a = *(const f32x4*)p, b = *(const f32x4*)(p + 4); return 1.0f / sqrtf(((a[0] + a[1]) + (a[2] + a[3]) + (b[0] + b[1]) + (b[2] + b[3])) * inv_n + EPS); }

struct EpiKV {
    static constexpr bool PERM = true, AFTER_DRAIN = false;
    unsigned char* ws;
    __device__ __forceinline__ void operator()(const f32x4 (&acc)[2][2][4][2], const pg8::Unit& u, int wr, int wc, int fr, int fq) const {
#pragma unroll
        for (int ai = 0; ai < 2; ++ai)
#pragma unroll
            for (int m = 0; m < 4; ++m) {
                const int row = u.pm * 256 + ai * 128 + wr * 64 + m * 16 + fr;
                const float rs = rstd8((const float*)(ws + WS_CKVSS) + (size_t)row * 8, 1.f / RANK);
                const int c = wc * 32 + 8 * fq;
                *(u32x4*)((bf16*)(ws + WS_KMLA) + (size_t)row * 1152 + u.pn * 192 + c) = pack8(acc[ai][0][m][0] * rs, acc[ai][0][m][1] * rs);
                *(u32x4*)((bf16*)(ws + WS_VMLA) + (size_t)row * 768 + u.pn * 128 + c) = pack8(acc[ai][1][m][0] * rs, acc[ai][1][m][1] * rs);
            }
    }
};
struct EpiQ {
    static constexpr bool PERM = true, AFTER_DRAIN = false;
    unsigned char* ws; const float* ropetab;
    __device__ __forceinline__ void operator()(const f32x4 (&acc)[2][2][4][2], const pg8::Unit& u, int wr, int wc, int fr, int fq) const {
#pragma unroll
        for (int ai = 0; ai < 2; ++ai)
#pragma unroll
            for (int m = 0; m < 4; ++m) {
                const int row = u.pm * 256 + ai * 128 + wr * 64 + m * 16 + fr;
                const int b = row / TOK, rr = row - b * TOK; const bool lat = rr >= CTX; const int t = rr - CTX, prow = (t >> 6) & 31, pcol = t & 63;
                const float rs = rstd8((const float*)(ws + WS_CQSS) + (size_t)row * 8, 1.f / RANK) * MLA_QS;
#pragma unroll
                for (int bj = 0; bj < 2; ++bj) {
                    const int col = u.pn * 256 + bj * 128 + wc * 32 + 8 * fq;
                    if (col < NUQ) {
                        f32x4 v0 = acc[ai][bj][m][0] * rs, v1 = acc[ai][bj][m][1] * rs;
                        const int hd = col / 192, i = col - hd * 192;
                        if (lat && i >= 128) { const int j0 = (i - 128) >> 1; rope8(v0, v1, ropetab, j0 < 16 ? prow : pcol, j0 & 15); }
                        *(u32x4*)((bf16*)(ws + WS_QMLA) + (size_t)row * 1152 + col) = pack8(v0, v1);
                    }
                }
            }
    }
};
struct EpiResid {
    static constexpr bool PERM = true, AFTER_DRAIN = false;
    unsigned char* ws; const float* xin; const float* cin; const float* gate; bool from_inputs;
    __device__ __forceinline__ void operator()(const f32x4 (&acc)[2][2][4][2], const pg8::Unit& u, int wr, int wc, int fr, int fq) const {
        const int b = u.pm / 9; const bool isctx = (u.pm - b * 9) == 0; const int bsel = isctx ? 4 : b;
        const float* gp = gate + (size_t)bsel * MODW + u.pn * 256 + wc * 32 + 8 * fq;
        f32x4 g[2][2];
#pragma unroll
        for (int bj = 0; bj < 2; ++bj) { g[bj][0] = *(const f32x4*)(gp + bj * 128); g[bj][1] = *(const f32x4*)(gp + bj * 128 + 4); }
#pragma unroll
        for (int ai = 0; ai < 2; ++ai)
#pragma unroll
            for (int m = 0; m < 4; ++m) {
                const int row = u.pm * 256 + ai * 128 + wr * 64 + m * 16 + fr; const int rr = row - b * TOK;
                const float* bp = from_inputs ? (isctx ? cin + (size_t)(b * CTX + rr) * DM : xin + (size_t)(b * SEQ + rr - CTX) * DM) : (const float*)(ws + WS_XW) + (size_t)row * DM;
                float* op = (float*)(ws + WS_XW) + (size_t)row * DM;
#pragma unroll
                for (int bj = 0; bj < 2; ++bj) { const int c = u.pn * 256 + bj * 128 + wc * 32 + 8 * fq;
                    const f32x4 b0 = *(const f32x4*)(bp + c), b1 = *(const f32x4*)(bp + c + 4);
                    *(f32x4*)(op + c) = b0 + g[bj][0] * acc[ai][bj][m][0]; *(f32x4*)(op + c + 4) = b1 + g[bj][1] * acc[ai][bj][m][1]; }
            }
    }
};
struct EpiFc1 {
    static constexpr bool PERM = true, AFTER_DRAIN = false;
    unsigned char* ws;
    __device__ __forceinline__ void operator()(const f32x4 (&acc)[2][2][4][2], const pg8::Unit& u, int wr, int wc, int fr, int fq) const {
#pragma unroll
        for (int ai = 0; ai < 2; ++ai)
#pragma unroll
            for (int m = 0; m < 4; ++m) {
                const int row = u.pm * 256 + ai * 128 + wr * 64 + m * 16 + fr;
#pragma unroll
                for (int bj = 0; bj < 2; ++bj) { const int c = u.pn * 256 + bj * 128 + wc * 32 + 8 * fq;
                    f32x4 v0 = __builtin_elementwise_max(acc[ai][bj][m][0], (f32x4){0.f, 0.f, 0.f, 0.f}), v1 = __builtin_elementwise_max(acc[ai][bj][m][1], (f32x4){0.f, 0.f, 0.f, 0.f});
                    *(u32x4*)((bf16*)(ws + WS_ACT) + (size_t)row * FF + c) = pack8(v0 * v0, v1 * v1); }
            }
    }
};

namespace att {
#define SBAR() __builtin_amdgcn_sched_barrier(0)
constexpr int V_TILE = 64 * 128 * 2, K_OFF = 2 * V_TILE, K_TILE_MAX = 64 * 192 * 2, WS_OFF = K_OFF + 2 * K_TILE_MAX;
constexpr float THR = 6.0f;
__device__ __forceinline__ int crow(int r, int hi) { return (r & 3) + 8 * (r >> 2) + 4 * hi; }
__device__ __forceinline__ int v_st(int k, int c) { const int kk = (k & ~0xC) | ((k & 4) << 1) | ((k & 8) >> 1); return ((kk >> 3) * 4 + (c >> 5)) * 512 + ((kk & 7) * 32 + (c & 31)) * 2; }
__device__ __forceinline__ int v_rd_base(int lane) { return ((lane & 3) << 3) | (((lane >> 2) & 3) << 6) | (((lane >> 4) & 1) << 5) | (((lane >> 5) & 1) << 8); }
constexpr int v_rd_off(int d0, int ks, int half) { return d0 * 512 + ks * 4096 + half * 2048; }
template <int OFF> __device__ __forceinline__ s16x4 tr_read(int vb) { s16x4 r; asm volatile("ds_read_b64_tr_b16 %0, %1 offset:%2" : "=&v"(r) : "v"(vb), "i"(OFF) : "memory"); return r; }
template <int D0> __device__ __forceinline__ void pv_one(f32x16& od, int vb, bf16x8 pa0, bf16x8 pa1, bf16x8 pa2, bf16x8 pa3) {
    const s16x4 l0 = tr_read<v_rd_off(D0, 0, 0)>(vb), h0 = tr_read<v_rd_off(D0, 0, 1)>(vb), l1 = tr_read<v_rd_off(D0, 1, 0)>(vb), h1 = tr_read<v_rd_off(D0, 1, 1)>(vb);
    const s16x4 l2 = tr_read<v_rd_off(D0, 2, 0)>(vb), h2 = tr_read<v_rd_off(D0, 2, 1)>(vb), l3 = tr_read<v_rd_off(D0, 3, 0)>(vb), h3 = tr_read<v_rd_off(D0, 3, 1)>(vb);
    asm volatile("s_waitcnt lgkmcnt(0)" ::: "memory"); SBAR();
#define PK(L, H) (bf16x8){L[0], L[1], L[2], L[3], H[0], H[1], H[2], H[3]}
    od = __builtin_amdgcn_mfma_f32_32x32x16_bf16(pa0, PK(l0, h0), od, 0, 0, 0);
    od = __builtin_amdgcn_mfma_f32_32x32x16_bf16(pa1, PK(l1, h1), od, 0, 0, 0);
    od = __builtin_amdgcn_mfma_f32_32x32x16_bf16(pa2, PK(l2, h2), od, 0, 0, 0);
    od = __builtin_amdgcn_mfma_f32_32x32x16_bf16(pa3, PK(l3, h3), od, 0, 0, 0);
#undef PK
}
template <int DQK> __device__ __forceinline__ int k_off(int r, int c) { return r * (DQK * 2) + ((c ^ ((r >> 1) & 7)) << 4); }

template <int DQK>
__device__ __forceinline__ void attn_pass(f32x16 (&o)[4], const bf16* __restrict__ Qw, int ldq, const bf16* __restrict__ Kb, int ldk, const bf16* __restrict__ Vb, int ldv, int NT, LAS unsigned char* lds) {
    constexpr int KT = 64 * DQK * 2, NKC = DQK / 8, NKS = (64 * NKC) / NTHR, ND = DQK / 16;
    int tid_ = threadIdx.x; asm volatile("" : "+v"(tid_)); const int tid = tid_, wid = tid >> 6, lane = tid & 63, r32 = lane & 31, hi = lane >> 5;
    LAS unsigned char* V_lds = lds; LAS unsigned char* K_lds = lds + K_OFF;
    LAS float* wsf = (LAS float*)(lds + WS_OFF) + wid * 64;
    bf16x8 qr[ND];
#pragma unroll
    for (int d0 = 0; d0 < ND; ++d0) qr[d0] = *(const bf16x8*)(Qw + (size_t)r32 * ldq + d0 * 16 + hi * 8);
    int kgo[NKS], klo[NKS];
#pragma unroll
    for (int i = 0; i < NKS; ++i) { const int idx = tid + NTHR * i, r = idx / NKC, c = idx - r * NKC; kgo[i] = r * ldk + c * 8; klo[i] = k_off<DQK>(r, c); }
    const int sr = tid >> 4, sc = (tid & 15) * 8, vst0 = v_st(sr, sc), vst1 = v_st(32 + sr, sc);
    const int vb0 = (int)(uintptr_t)V_lds + v_rd_base(lane);
    bf16x8 ks[NKS], vs0, vs1;
#define SLOAD(k0) do { _Pragma("unroll") for (int i_ = 0; i_ < NKS; ++i_) ks[i_] = *(const bf16x8*)(Kb + (size_t)(k0) * ldk + kgo[i_]); \
        vs0 = *(const bf16x8*)(Vb + (size_t)((k0) + sr) * ldv + sc); vs1 = *(const bf16x8*)(Vb + (size_t)((k0) + 32 + sr) * ldv + sc); } while (0)
#define SWRITE(buf) do { _Pragma("unroll") for (int i_ = 0; i_ < NKS; ++i_) *(LAS bf16x8*)(K_lds + (buf) * KT + klo[i_]) = ks[i_]; \
        *(LAS bf16x8*)(V_lds + (buf) * V_TILE + vst0) = vs0; *(LAS bf16x8*)(V_lds + (buf) * V_TILE + vst1) = vs1; } while (0)
    float m_reg = -1e30f, l_reg = 0.f;
#pragma unroll
    for (int d = 0; d < 4; ++d) o[d] = f32x16{};
    SLOAD(0); SWRITE(0); __syncthreads();
    for (int j = 0; j < NT; ++j) {
        const int buf = j & 1;
        if (j + 1 < NT) SLOAD((j + 1) * 64);
        f32x16 p0 = f32x16{}, p1 = f32x16{};
        { const LAS unsigned char* Kt = K_lds + buf * KT;
#pragma unroll
          for (int d0 = 0; d0 < ND; ++d0) {
              const bf16x8 b0 = *(const LAS bf16x8*)(Kt + k_off<DQK>(r32, 2 * d0 + hi)), b1 = *(const LAS bf16x8*)(Kt + k_off<DQK>(32 + r32, 2 * d0 + hi));
              p0 = __builtin_amdgcn_mfma_f32_32x32x16_bf16(b0, qr[d0], p0, 0, 0, 0);
              p1 = __builtin_amdgcn_mfma_f32_32x32x16_bf16(b1, qr[d0], p1, 0, 0, 0); if ((d0 & 1) == 1) SBAR(); } }
        float pmax = p0[0];
#pragma unroll
        for (int r = 1; r < 16; ++r) pmax = fmaxf(pmax, p0[r]);
#pragma unroll
        for (int r = 0; r < 16; ++r) pmax = fmaxf(pmax, p1[r]);
        { auto rr = __builtin_amdgcn_permlane32_swap(__float_as_uint(pmax), __float_as_uint(pmax), false, false); pmax = fmaxf(__uint_as_float(rr[0]), __uint_as_float(rr[1])); }
        float alpha = 1.f;
        if (!__all(pmax - m_reg <= THR)) { const float mn = fmaxf(m_reg, pmax); alpha = __builtin_amdgcn_exp2f(m_reg - mn); m_reg = mn;
            if (hi == 0) wsf[r32] = alpha; asm volatile("s_waitcnt lgkmcnt(0)" ::: "memory");
#pragma unroll
            for (int r = 0; r < 16; ++r) { const float a = wsf[crow(r, hi)];
#pragma unroll
                for (int d = 0; d < 4; ++d) o[d][r] *= a; }
            asm volatile("s_waitcnt lgkmcnt(0)" ::: "memory"); }
        float ps = 0.f;
#pragma unroll
        for (int r = 0; r < 16; ++r) { p0[r] = __builtin_amdgcn_exp2f(p0[r] - m_reg); p1[r] = __builtin_amdgcn_exp2f(p1[r] - m_reg); ps += p0[r] + p1[r]; }
        { auto rr = __builtin_amdgcn_permlane32_swap(__float_as_uint(ps), __float_as_uint(ps), false, false); ps = __uint_as_float(rr[0]) + __uint_as_float(rr[1]); }
        l_reg = l_reg * alpha + ps;
        bf16x8 pa0, pa1, pa2, pa3;
#define PK4(P, BASE, OUT) do { unsigned a0 = cvtpk(P[BASE + 0], P[BASE + 1]), a1 = cvtpk(P[BASE + 2], P[BASE + 3]); \
        unsigned b0 = cvtpk(P[BASE + 4], P[BASE + 5]), b1 = cvtpk(P[BASE + 6], P[BASE + 7]); \
        auto r0 = __builtin_amdgcn_permlane32_swap(a0, b0, false, false); auto r1 = __builtin_amdgcn_permlane32_swap(a1, b1, false, false); \
        u32x4 w = {r0[0], r1[0], r0[1], r1[1]}; OUT = __builtin_bit_cast(bf16x8, w); } while (0)
        PK4(p0, 0, pa0); PK4(p0, 8, pa1); PK4(p1, 0, pa2); PK4(p1, 8, pa3);
#undef PK4
        SBAR();
        { const int vb = vb0 + buf * V_TILE;
          pv_one<0>(o[0], vb, pa0, pa1, pa2, pa3); pv_one<1>(o[1], vb, pa0, pa1, pa2, pa3); pv_one<2>(o[2], vb, pa0, pa1, pa2, pa3); pv_one<3>(o[3], vb, pa0, pa1, pa2, pa3); }
        if (j + 1 < NT) SWRITE(buf ^ 1);
        __syncthreads();
    }
    if (hi == 0) wsf[32 + r32] = l_reg; asm volatile("s_waitcnt lgkmcnt(0)" ::: "memory");
#pragma unroll
    for (int r = 0; r < 16; ++r) { const float rl = 1.0f / wsf[32 + crow(r, hi)];
#pragma unroll
        for (int d = 0; d < 4; ++d) o[d][r] *= rl; }
    asm volatile("s_waitcnt lgkmcnt(0)" ::: "memory");
#undef SLOAD
#undef SWRITE
}


__device__ __forceinline__ void store_o(const f32x16 (&o)[4], const float (&rs)[16], const float (&gcol)[4], bf16* dst, int ld, LAS unsigned char* lds, int wid, int lane) {
    const int r32 = lane & 31, hi = lane >> 5;
    LAS unsigned short* stg = (LAS unsigned short*)(lds + wid * 8192);
#pragma unroll
    for (int d = 0; d < 4; ++d)
#pragma unroll
        for (int r = 0; r < 16; ++r) stg[crow(r, hi) * 128 + d * 32 + r32] = (unsigned short)(cvtpk(o[d][r] * rs[r] * gcol[d], 0.f) & 0xffffu);
    asm volatile("s_waitcnt lgkmcnt(0)" ::: "memory");
    bf16* p = dst + (size_t)(lane >> 4) * ld + (lane & 15) * 8;
#pragma unroll
    for (int i = 0; i < 8; ++i) { const u32x4 v = *(const LAS u32x4*)(stg + (i * 4 + (lane >> 4)) * 128 + (lane & 15) * 8); *(u32x4*)p = v; p += 4 * (size_t)ld; asm volatile("" : "+v"(p)); }
}

__device__ __forceinline__ void da_unit(const Args& A, const Frame& F, int l, int q0, int k0, int NT, int h) {
    int tid_ = threadIdx.x; asm volatile("" : "+v"(tid_)); const int tid = tid_, wid = tid >> 6, lane = tid & 63, r32 = lane & 31, hi = lane >> 5;
    const bf16* Q = WSP(bf16, WS_QDA); const bf16* K = WSP(bf16, WS_KDA); const bf16* V = WSP(bf16, WS_VDA);
    float* stash = WSP(float, WS_STASH) + ((size_t)blockIdx.x * NTHR + tid) * 64;
    const float lam = WSP(float, WS_SCAL)[l]; const float lam_init = 0.8f - 0.6f * expf(-0.3f * (float)l);
    f32x16 o[4];
    attn_pass<64>(o, Q + (size_t)(q0 + wid * 32) * 768 + (2 * h) * 64, 768, K + (size_t)k0 * 768 + (2 * h) * 64, 768, V + (size_t)k0 * 768 + h * 128, 768, NT, F.lds);
#pragma unroll
    for (int d = 0; d < 4; ++d)
#pragma unroll
        for (int r = 0; r < 16; r += 4) *(f32x4*)(stash + d * 16 + r) = (f32x4){o[d][r], o[d][r + 1], o[d][r + 2], o[d][r + 3]};
    attn_pass<64>(o, Q + (size_t)(q0 + wid * 32) * 768 + (2 * h + 1) * 64, 768, K + (size_t)k0 * 768 + (2 * h + 1) * 64, 768, V + (size_t)k0 * 768 + h * 128, 768, NT, F.lds);
    float ss[16];
#pragma unroll
    for (int r = 0; r < 16; ++r) ss[r] = 0.f;
#pragma unroll
    for (int d = 0; d < 4; ++d) {
#pragma unroll
        for (int r = 0; r < 16; r += 4) { const f32x4 s4 = *(const f32x4*)(stash + d * 16 + r);
#pragma unroll
            for (int e = 0; e < 4; ++e) { const float v = s4[e] - lam * o[d][r + e]; o[d][r + e] = v; ss[r + e] += v * v; } }
        asm volatile("" ::: "memory"); SBAR(); }
#pragma unroll
    for (int r = 0; r < 16; ++r) { float s = ss[r]; s += __shfl_xor(s, 1); s += __shfl_xor(s, 2); s += __shfl_xor(s, 4); s += __shfl_xor(s, 8); s += __shfl_xor(s, 16);
        ss[r] = (1.0f / sqrtf(s * (1.f / 128.f) + EPS)) * (1.f - lam_init); }
    const float* gs = inp<I_GDASUB>() + l * 128;
    float gcol[4];
#pragma unroll
    for (int d = 0; d < 4; ++d) gcol[d] = gs[d * 32 + r32];
    store_o(o, ss, gcol, WSP(bf16, WS_HEADS) + (size_t)(q0 + wid * 32) * DM + h * 128, DM, F.lds, wid, lane);
    __syncthreads();
}
__device__ __forceinline__ void mla_unit(const Args& A, const Frame& F, int q0, int k0, int NT, int h) {
    int tid_ = threadIdx.x; asm volatile("" : "+v"(tid_)); const int tid = tid_, wid = tid >> 6, lane = tid & 63, r32 = lane & 31, hi = lane >> 5;
    f32x16 o[4];
    attn_pass<192>(o, WSP(bf16, WS_QMLA) + (size_t)(q0 + wid * 32) * 1152 + h * 192, 1152, WSP(bf16, WS_KMLA) + (size_t)k0 * 1152 + h * 192, 1152, WSP(bf16, WS_VMLA) + (size_t)k0 * 768 + h * 128, 768, NT, F.lds);
    float rs[16], gcol[4];
#pragma unroll
    for (int r = 0; r < 16; ++r) rs[r] = 1.f;
#pragma unroll
    for (int d = 0; d < 4; ++d) gcol[d] = 1.f;
    store_o(o, rs, gcol, WSP(bf16, WS_HEADS) + (size_t)(q0 + wid * 32) * DM + 1280 + h * 128, DM, F.lds, wid, lane);
    __syncthreads();
}
__device__ __forceinline__ void attn_phase(const Args& A, const Frame& F, int l, bool with_ctx) {
    const int nun = with_ctx ? 432 : 384;
    for (int un = F.vcu; un < nun; un += F.G) {
        if (un < 384) { const int v = un < 192 ? un : un - 192; const int bh = v >> 3, qb = v & 7, b = bh / 6, h = bh - b * 6;

#ifndef NO_DA
            if (un < 192) da_unit(A, F, l, b * TOK + CTX + qb * 256, b * TOK, 36, h);
#endif
#ifndef NO_MLA
            if (un >= 192) mla_unit(A, F, b * TOK + CTX + qb * 256, b * TOK, 36, h);
#endif
        }
        else { const int v = un < 408 ? un - 384 : un - 408; const int b = v / 6, h = v - b * 6;

#ifndef NO_DA
            if (un < 408) da_unit(A, F, l, b * TOK, b * TOK, 4, h);
#endif
#ifndef NO_MLA
            if (un >= 408) mla_unit(A, F, b * TOK, b * TOK, 4, h);
#endif
        }
    }
}

__device__ __forceinline__ void gate_unit(const Args& A, const Frame& F, int l, int ch, int g) {
    int tid_ = threadIdx.x; asm volatile("" : "+v"(tid_)); const int tid = tid_, wid = tid >> 6, lane = tid & 63, r32 = lane & 31, hi = lane >> 5;
    const int r0 = ch * 128;
    LAS unsigned char* img = F.lds;
    { const int sc = (tid & 15) * 8; const float* gain = inp<I_GGMV>() + (l * 4 + g) * 128 + sc; const f32x4 g0 = *(const f32x4*)gain, g1 = *(const f32x4*)(gain + 4);
#pragma unroll
      for (int i = 0; i < 4; ++i) { const int q = (tid >> 4) + 32 * i, row = r0 + q;
          const float* src = WSP(float, WS_GV) + (size_t)row * 512 + g * 128 + sc; const f32x4 a = *(const f32x4*)src, b = *(const f32x4*)(src + 4);
          const f32x4 sq = *(const f32x4*)(WSP(float, WS_GVSS) + (size_t)row * 16 + g * 4); const float rs = 1.0f / sqrtf(((sq[0] + sq[1]) + (sq[2] + sq[3])) * (1.f / 128.f) + EPS);
          *(LAS u32x4*)(img + (q >> 6) * V_TILE + v_st(q & 63, sc)) = pack8(a * rs * g0, b * rs * g1); } }
    __syncthreads();
    const int pb = wid & 3, chh = wid >> 2;
    const bf16* Wsg = WSP(bf16, WS_WSP) + ((size_t)(l * 4 + g) * 128 + pb * 32 + r32) * 128 + hi * 8;
    f32x16 acc0 = f32x16{}, acc1 = f32x16{};
    const int vb0 = (int)(uintptr_t)img + v_rd_base(lane);
#pragma unroll
    for (int t = 0; t < 2; ++t) {
        const bf16x8 a0 = *(const bf16x8*)(Wsg + t * 64), a1 = *(const bf16x8*)(Wsg + t * 64 + 16), a2 = *(const bf16x8*)(Wsg + t * 64 + 32), a3 = *(const bf16x8*)(Wsg + t * 64 + 48);
        const int vb = vb0 + t * V_TILE;
        if (chh == 0) { pv_one<0>(acc0, vb, a0, a1, a2, a3); pv_one<1>(acc1, vb, a0, a1, a2, a3); }
        else          { pv_one<2>(acc0, vb, a0, a1, a2, a3); pv_one<3>(acc1, vb, a0, a1, a2, a3); }
    }
    const float* bs = inp<I_BSP>() + (l * 4 + g) * 128 + pb * 32;
    LAS float* mix = (LAS float*)(F.lds + 2 * V_TILE);
#pragma unroll
    for (int r = 0; r < 16; ++r) { const int p = crow(r, hi); const float bias = bs[p]; LAS float* mp = mix + (pb * 32 + p) * 128 + chh * 64 + r32; mp[0] = acc0[r] + bias; mp[32] = acc1[r] + bias; }
    __syncthreads();
    { const int sc = (tid & 15) * 8; const float* up = WSP(float, WS_U) + (size_t)(r0 + (tid >> 4)) * 512 + g * 128 + sc; bf16* hp = WSP(bf16, WS_HEADS) + (size_t)(r0 + (tid >> 4)) * DM + 768 + g * 128 + sc;
#pragma unroll
      for (int i = 0; i < 4; ++i) { const LAS float* mp = mix + ((tid >> 4) + 32 * i) * 128 + sc; const f32x4 m0 = *(const LAS f32x4*)mp, m1 = *(const LAS f32x4*)(mp + 4);
          const f32x4 u0 = *(const f32x4*)up, u1 = *(const f32x4*)(up + 4); *(u32x4*)hp = pack8(u0 * m0, u1 * m1);
          up += 32 * 512; hp += 32 * (size_t)DM; asm volatile("" : "+v"(up), "+v"(hp)); } }
    __syncthreads();
}
#undef SBAR
}

#ifndef MK_SPLIT
#define MK_SPLIT 0
#endif
constexpr int PH_PER_LAYER = 8, PH_FINAL = 2 + PH_PER_LAYER * DEPTH, N_PHASES = PH_FINAL + 1;

__global__ void __launch_bounds__(NTHR, 2) fwd_kernel(Args args) {
    extern __shared__ __attribute__((aligned(16))) unsigned char lds_raw[];
    cg::grid_group grid = cg::this_grid();
    Frame F;
    F.lds = (LAS unsigned char*)lds_raw;
    F.G = gridDim.x; { const int bx = blockIdx.x; F.vcu = (F.G % 8 == 0) ? (bx % 8) * (F.G / 8) + bx / 8 : bx; }
    const Args& A = args;
    F.out = args.out; F.ws = args.ws;
    const int lo = args.ph_lo, hi = args.ph_hi;
#ifndef PH_MASK
#define PH_MASK 0x7ff
#endif
#define PHM(j) (((PH_MASK) >> (j)) & 1)
#define IN(k) (lo <= (k) && (k) < hi)
#define SEAM(k) do { if (IN(k) && IN((k) + 1)) grid.sync(); } while (0)
    const float* ropetab = WSP(float, WS_ROPE);

    if (PHM(0) && IN(0)) { p0_prologue(A, F); } SEAM(0);
    if (PHM(1) && IN(1)) { p0b_modreduce(A, F); } SEAM(1);

    for (int l = 0; l < DEPTH; ++l) {
        const int pb = 2 + PH_PER_LAYER * l; const bool last = (l == DEPTH - 1); const bool first = (l == 0);
        const float* modl = WSP(float, WS_MOD) + (size_t)l * 5 * MODW;
        if (PHM(2) && IN(pb + 0)) { norm_phase(A, F, l, first, inp<I_GMIX>() + l * DM, 0); } SEAM(pb + 0);
        if (PHM(3) && IN(pb + 1)) {
            pg8::Gemm g{WSP(bf16, WS_HN), WSP(bf16, WS_WIN) + (size_t)l * NZP * DM, M, NZP, DM}; TileOrder S; S.init(NZP, F.G, (int)blockIdx.x, 0);
            EpiZ E{F.ws, ropetab};
            pg8::gemm_phase<EpiZ, TileOrder, true, true>(F.lds, g, S, E);
        } SEAM(pb + 1);
        if (PHM(4) && IN(pb + 2)) {
            { pg8::Gemm g{WSP(bf16, WS_CKV), WSP(bf16, WS_WUKV) + (size_t)l * NUKV * RANK, M, NUKV, RANK}; TileOrder S; S.init(NUKV, F.G, (int)blockIdx.x, 0);
              EpiKV E{F.ws}; pg8::gemm_phase<EpiKV, TileOrder, true, true>(F.lds, g, S, E); }
            { pg8::Gemm g{WSP(bf16, WS_CQ), WSP(bf16, WS_WUQ) + (size_t)l * NUQP * RANK, M, NUQP, RANK}; TileOrder S; S.init(NUQP, F.G, (int)blockIdx.x, last ? 1 : 0);
              EpiQ E{F.ws, ropetab}; pg8::gemm_phase<EpiQ, TileOrder, true, true>(F.lds, g, S, E); }
            for (int un = F.vcu; un < 72 * 4; un += F.G) { const int ch = un >> 2, g = un & 3; if (last && (ch % 18) < 2) continue; att::gate_unit(A, F, l, ch, g); }
        } SEAM(pb + 2);
        if (PHM(5) && IN(pb + 3)) { att::attn_phase(A, F, l, !last); } SEAM(pb + 3);
        if (PHM(6) && IN(pb + 4)) {
            pg8::Gemm g{WSP(bf16, WS_HEADS), WSP(bf16, WS_WOUT) + (size_t)l * DM * DM, M, DM, DM}; TileOrder S; S.init(DM, F.G, (int)blockIdx.x, last ? 1 : 0);
            EpiResid E{F.ws, inp<I_X>(), inp<I_CTX>(), modl + 2 * DM, first};
            pg8::gemm_phase<EpiResid, TileOrder, true, true>(F.lds, g, S, E);
        } SEAM(pb + 4);
        if (PHM(7) && IN(pb + 5)) { norm_phase(A, F, l, false, inp<I_GMLP>() + l * DM, 3 * DM); } SEAM(pb + 5);
        if (PHM(8) && IN(pb + 6)) {
            pg8::Gemm g{WSP(bf16, WS_HN), WSP(bf16, WS_WFC1) + (size_t)l * FF * DM, M, FF, DM}; TileOrder S; S.init(FF, F.G, (int)blockIdx.x, last ? 1 : 0);
            EpiFc1 E{F.ws};
            pg8::gemm_phase<EpiFc1, TileOrder, true, true>(F.lds, g, S, E);
        } SEAM(pb + 6);
        if (PHM(9) && IN(pb + 7)) {
            pg8::Gemm g{WSP(bf16, WS_ACT), WSP(bf16, WS_WFC2) + (size_t)l * DM * FF, M, DM, FF}; TileOrder S; S.init(DM, F.G, (int)blockIdx.x, last ? 1 : 0);
            EpiResid E{F.ws, inp<I_X>(), inp<I_CTX>(), modl + 5 * DM, false};
            pg8::gemm_phase<EpiResid, TileOrder, true, true>(F.lds, g, S, E);
        } SEAM(pb + 7);
    }
    if (PHM(10) && IN(PH_FINAL)) { final_norm_phase(A, F); }
#undef IN
#undef SEAM
}

extern "C" void kernel_launch(void* const* d_in, const int* in_sizes, int n_in, void* d_out, int out_size, void* d_ws, size_t ws_size, hipStream_t stream) {
    static int grid = 0;
    if (grid == 0) {
        if (n_in != N_IN || ws_size < WS_END || out_size != NB * SEQ * DM) { fprintf(stderr, "kernel_launch: unexpected shapes: n_in %d ws %zu (need %zu) out %d\n", n_in, ws_size, (size_t)WS_END, out_size); grid = -1; return; }
        int dev = 0, cus = 0, per_cu = 0;
        if (hipGetDevice(&dev) != hipSuccess || hipDeviceGetAttribute(&cus, hipDeviceAttributeMultiprocessorCount, dev) != hipSuccess) { fprintf(stderr, "kernel_launch: device query failed\n"); grid = -1; return; }
        if (hipFuncSetAttribute((const void*)fwd_kernel, hipFuncAttributeMaxDynamicSharedMemorySize, LDS_BYTES) != hipSuccess) { fprintf(stderr, "kernel_launch: hipFuncSetAttribute failed\n"); grid = -1; return; }
        if (hipOccupancyMaxActiveBlocksPerMultiprocessor(&per_cu, (const void*)fwd_kernel, NTHR, LDS_BYTES) != hipSuccess || per_cu < 1) { fprintf(stderr, "kernel_launch: occupancy query says %d blocks/CU\n", per_cu); (void)hipGetLastError(); per_cu = 1; }
        grid = cus * per_cu; if (grid > 256) grid = 256;
        grid -= grid % 8;
        fprintf(stderr, "kernel_launch: cus %d per_cu %d grid %d\n", cus, per_cu, grid);
    }
    if (grid <= 0) return;
    Args a{};
    for (int i = 0; i < N_IN; ++i) a.in[i] = (const float*)d_in[i];
    a.out = (float*)d_out; a.ws = (unsigned char*)d_ws;
#if MK_SPLIT
    for (int p = 0; p < N_PHASES; ++p) {
        a.ph_lo = p; a.ph_hi = p + 1; void* kargs[] = {&a};
        hipError_t e = hipLaunchCooperativeKernel((const void*)fwd_kernel, dim3(grid), dim3(NTHR), kargs, LDS_BYTES, stream);
        if (e != hipSuccess) { fprintf(stderr, "kernel_launch: launch of phase %d failed: %s\n", p, hipGetErrorString(e)); break; }
    }
#else
    a.ph_lo = 0; a.ph_hi = N_PHASES; void* kargs[] = {&a};
    hipError_t e = hipLaunchCooperativeKernel((const void*)fwd_kernel, dim3(grid), dim3(NTHR), kargs, LDS_BYTES, stream);
    if (e != hipSuccess) fprintf(stderr, "kernel_launch: cooperative launch failed: %s (grid %d)\n", hipGetErrorString(e), grid);
#endif
}
```

```cpp
#include <hip/hip_runtime.h>
#include <hip/hip_cooperative_groups.h>
#include <cstdio>
#include <cstdint>
namespace cg = cooperative_groups;
namespace pg8 {
#define PG8_LAS __attribute__((address_space(3)))
typedef unsigned short bf16_t;
typedef short bf16x8 __attribute__((ext_vector_type(8)));
typedef float f32x4 __attribute__((ext_vector_type(4)));
typedef unsigned u32x4 __attribute__((ext_vector_type(4)));
constexpr int BM = 256, BK = 64, HALF = 128, HTB = HALF * BK * 2  , STAGE_BYTES = 8 * HTB, NXCD = 8, WGM = 8;

__host__ __device__ __forceinline__ int lds_byte(int r, int c) { const int st = (r >> 4) * 2 + (c >> 5), rr = r & 15, cc = c & 31, ob = rr * 64 + cc * 2; return st * 1024 + (ob ^ (((ob >> 9) & 1) << 5)); }
__host__ __device__ __forceinline__ void stage_rc(int b, int& R, int& C) { const int st = b / 1024, sb = b % 1024, swz = sb ^ (((sb >> 9) & 1) << 5); R = (st >> 1) * 16 + swz / 64; C = (st & 1) * 32 + (swz % 64) / 2; }
__host__ __device__ __forceinline__ int perm32(int rho) { const int n = rho >> 4, i = rho & 15; return 8 * (i >> 2) + 4 * n + (i & 3); }

struct Unit { int pm, pn, k0, ks; };
struct Gemm { const bf16_t* A; const bf16_t* Bt; int M, N, K, ld; };

__device__ __forceinline__ unsigned cvt_pk_bf16(float lo, float hi) { unsigned r; asm volatile("v_cvt_pk_bf16_f32 %0, %1, %2" : "=v"(r) : "v"(lo), "v"(hi)); return r; }
typedef float f32x2 __attribute__((ext_vector_type(2)));
__device__ __forceinline__ f32x2 gelu_pk(f32x2 v) {
    const f32x2 av = __builtin_elementwise_abs(v), d = av * 0.2316418882f + 1.0f;
    f32x2 t; t.x = __builtin_amdgcn_rcpf(d.x); t.y = __builtin_amdgcn_rcpf(d.y);
    f32x2 q = t * 0.5307027145f + (-0.7265760135f); q = q * t + 0.7107068705f; q = q * t + (-0.142248368f); q = q * t + 0.127414796f; q = q * t;
    const f32x2 s = (v * v) * (-0.72134752044f);
    f32x2 e; e.x = __builtin_amdgcn_exp2f(s.x); e.y = __builtin_amdgcn_exp2f(s.y);
    const f32x2 m = v * (q * e), r = v - m;
    f32x2 o; o.x = v.x < 0.f ? m.x : r.x; o.y = v.y < 0.f ? m.y : r.y; return o;
}
template <class Epi, class Sched, bool ALIGN_EPI = false, bool SP2 = false>
__device__ __forceinline__ void gemm_phase(PG8_LAS unsigned char* lds, const Gemm g, const Sched& S, const Epi& E) {
    int tid_ = threadIdx.x; asm volatile("" : "+v"(tid_)); const int tid = tid_, wid = __builtin_amdgcn_readfirstlane(tid >> 6), lane = tid & 63, wr = wid >> 2, wc = wid & 3, fr = lane & 15, fq = lane >> 4;
    const int K = g.K, nt = K / BK;
    unsigned voffA[2], voffB[2];
#pragma unroll
    for (int i = 0; i < 2; ++i) { int R, C; stage_rc(tid * 16 + i * 8192, R, C); const int Rb = Epi::PERM ? ((R & ~31) + perm32(R & 31)) : R;
        voffA[i] = (unsigned)(R * g.ld + C) * 2u; voffB[i] = (unsigned)(Rb * g.ld + C) * 2u; }
    const size_t kstep = (size_t)(BK * 2);
    const size_t hstep = (size_t)HALF * g.ld * 2;
    const size_t tstep = 2 * hstep;
    const unsigned ldsw = (unsigned)wid * 1024u;
    const int aoff = lds_byte(wr * 64 + fr, fq * 8), boff = lds_byte(wc * 32 + fr, fq * 8);
#define PG8_SA(b, h) (((b) * 2 + (h)) * HTB)
#define PG8_SB(b, h) ((4 + (b) * 2 + (h)) * HTB)
#define PG8_STAGE(bufoff, gbase, voff) do { _Pragma("unroll") for (int _i = 0; _i < 2; ++_i) \
        __builtin_amdgcn_global_load_lds((const unsigned*)((const char*)(gbase) + (voff)[_i]), (PG8_LAS unsigned*)(lds + (bufoff) + ldsw + _i * 8192), 16, 0, 0); } while (0)
#define PG8_LDA(dst, b, h) do { _Pragma("unroll") for (int m = 0; m < 4; ++m) _Pragma("unroll") for (int k = 0; k < 2; ++k) dst[m][k] = *(const PG8_LAS bf16x8*)(lds + PG8_SA(b, h) + aoff + m * 2048 + k * 1024); } while (0)
#define PG8_LDB(dst, b, h) do { _Pragma("unroll") for (int n = 0; n < 2; ++n) _Pragma("unroll") for (int k = 0; k < 2; ++k) dst[n][k] = *(const PG8_LAS bf16x8*)(lds + PG8_SB(b, h) + boff + n * 2048 + k * 1024); } while (0)
#define PG8_MMA(ai, bj, At, Bt) do { __builtin_amdgcn_s_setprio(1); _Pragma("unroll") for (int m = 0; m < 4; ++m) _Pragma("unroll") for (int n = 0; n < 2; ++n) _Pragma("unroll") for (int k = 0; k < 2; ++k) \
        acc[ai][bj][m][n] = __builtin_amdgcn_mfma_f32_16x16x32_bf16(Bt[n][k], At[m][k], acc[ai][bj][m][n], 0, 0, 0); __builtin_amdgcn_s_setprio(0); } while (0)
#define PG8_WAIT_V(n) asm volatile("s_waitcnt vmcnt(" #n ")" ::: "memory")
#define PG8_WAIT_L(n) asm volatile("s_waitcnt lgkmcnt(" #n ")" ::: "memory")
#define PG8_BAR __builtin_amdgcn_s_barrier()
#define PG8_SCHED __builtin_amdgcn_sched_barrier(0)
    Unit cur, nxt; int ui = 0;
    if (!S.next(0, cur)) return;
    f32x4 acc[2][2][4][2];
#pragma unroll
    for (int a = 0; a < 2; ++a)
#pragma unroll
        for (int b = 0; b < 2; ++b)
#pragma unroll
            for (int m = 0; m < 4; ++m)
#pragma unroll
                for (int n = 0; n < 2; ++n) acc[a][b][m][n] = (f32x4){0.f, 0.f, 0.f, 0.f};
    bf16x8 At[4][2], B0[2][2], B1[2][2];
    const char* cA = (const char*)g.A + (size_t)cur.pm * tstep + (size_t)cur.k0 * 2; const char* cB = (const char*)g.Bt + (size_t)cur.pn * tstep + (size_t)cur.k0 * 2;
    S.a_ready(cur);
    if constexpr (SP2) {
        PG8_STAGE(PG8_SB(0, 0), cB, voffB); PG8_STAGE(PG8_SB(0, 1), cB + hstep, voffB); PG8_STAGE(PG8_SA(0, 0), cA, voffA); PG8_STAGE(PG8_SA(0, 1), cA + hstep, voffA);
        if (wr == 1) PG8_BAR;
        PG8_WAIT_V(2); PG8_BAR;
        PG8_STAGE(PG8_SB(1, 0), cB + kstep, voffB); PG8_STAGE(PG8_SA(1, 0), cA + kstep, voffA); PG8_STAGE(PG8_SB(1, 1), cB + hstep + kstep, voffB);
        PG8_WAIT_V(6); PG8_BAR;
    } else {
        PG8_STAGE(PG8_SB(0, 0), cB, voffB); PG8_STAGE(PG8_SA(0, 0), cA, voffA); PG8_STAGE(PG8_SB(0, 1), cB + hstep, voffB); PG8_STAGE(PG8_SA(0, 1), cA + hstep, voffA);
        if (wr == 1) PG8_BAR;
        PG8_WAIT_V(4); PG8_BAR;
        PG8_STAGE(PG8_SB(1, 0), cB + kstep, voffB); PG8_STAGE(PG8_SA(1, 0), cA + kstep, voffA); PG8_STAGE(PG8_SB(1, 1), cB + hstep + kstep, voffB);
        PG8_WAIT_V(6); PG8_BAR;
    }
    for (;;) {
        const bool has_next = S.next(ui + 1, nxt);
        const char* nA = has_next ? (const char*)g.A + (size_t)nxt.pm * tstep + (size_t)nxt.k0 * 2 : cA; const char* nB = has_next ? (const char*)g.Bt + (size_t)nxt.pn * tstep + (size_t)nxt.k0 * 2 : cB;
        for (int t = 0; t < nt; t += 2) {
            const bool last = (t == nt - 2);
            const char* a1 = cA + (size_t)(t + 1) * kstep;
            const char* a2 = last ? nA : cA + (size_t)(t + 2) * kstep; const char* b2 = last ? nB : cB + (size_t)(t + 2) * kstep;
            const char* a3 = a2 + kstep; const char* b3 = b2 + kstep;
            if (last && has_next) S.a_ready(nxt);
            if constexpr (SP2) {
            PG8_LDB(B0, 0, 0); PG8_LDB(B1, 0, 1); PG8_SCHED; PG8_LDA(At, 0, 0); PG8_STAGE(PG8_SA(1, 1), a1 + hstep, voffA);
            PG8_WAIT_V(8); PG8_WAIT_L(0); PG8_BAR; PG8_MMA(0, 0, At, B0); PG8_MMA(0, 1, At, B1); PG8_BAR; PG8_SCHED;
            PG8_LDA(At, 0, 1); PG8_STAGE(PG8_SB(0, 0), b2, voffB); PG8_STAGE(PG8_SB(0, 1), b2 + hstep, voffB); PG8_STAGE(PG8_SA(0, 0), a2, voffA);
            PG8_WAIT_V(8); PG8_WAIT_L(0); PG8_BAR; PG8_MMA(1, 0, At, B0); PG8_MMA(1, 1, At, B1); PG8_BAR; PG8_SCHED;
            PG8_LDB(B0, 1, 0); PG8_LDB(B1, 1, 1); PG8_SCHED; PG8_LDA(At, 1, 0); PG8_STAGE(PG8_SA(0, 1), a2 + hstep, voffA);
            PG8_WAIT_V(8); PG8_WAIT_L(0); PG8_BAR; PG8_MMA(0, 0, At, B0); PG8_MMA(0, 1, At, B1); PG8_BAR; PG8_SCHED;
            PG8_LDA(At, 1, 1); PG8_STAGE(PG8_SB(1, 0), b3, voffB); PG8_STAGE(PG8_SB(1, 1), b3 + hstep, voffB); PG8_STAGE(PG8_SA(1, 0), a3, voffA);
            PG8_WAIT_V(8); PG8_WAIT_L(0); PG8_BAR; PG8_MMA(1, 0, At, B0); PG8_MMA(1, 1, At, B1); PG8_BAR; PG8_SCHED;
            } else {
            PG8_LDB(B0, 0, 0); PG8_SCHED; PG8_LDA(At, 0, 0); PG8_STAGE(PG8_SA(1, 1), a1 + hstep, voffA);
            PG8_WAIT_L(8); PG8_BAR; PG8_WAIT_L(0); PG8_MMA(0, 0, At, B0); PG8_BAR; PG8_SCHED;
            PG8_LDB(B1, 0, 1); PG8_STAGE(PG8_SB(0, 0), b2, voffB);
            PG8_BAR; PG8_WAIT_L(0); PG8_MMA(0, 1, At, B1); PG8_BAR;
            PG8_LDA(At, 0, 1); PG8_STAGE(PG8_SA(0, 0), a2, voffA);
            PG8_BAR; PG8_WAIT_L(0); PG8_MMA(1, 0, At, B0); PG8_BAR; PG8_SCHED;
            PG8_STAGE(PG8_SB(0, 1), b2 + hstep, voffB);
            PG8_WAIT_V(6); PG8_BAR; PG8_MMA(1, 1, At, B1); PG8_BAR;
            PG8_LDB(B0, 1, 0); PG8_SCHED; PG8_LDA(At, 1, 0); PG8_STAGE(PG8_SA(0, 1), a2 + hstep, voffA);
            PG8_WAIT_L(8); PG8_BAR; PG8_WAIT_L(0); PG8_MMA(0, 0, At, B0); PG8_BAR; PG8_SCHED;
            PG8_LDB(B1, 1, 1); PG8_STAGE(PG8_SB(1, 0), b3, voffB);
            PG8_BAR; PG8_WAIT_L(0); PG8_MMA(0, 1, At, B1); PG8_BAR;
            PG8_LDA(At, 1, 1); PG8_STAGE(PG8_SA(1, 0), a3, voffA);
            PG8_BAR; PG8_WAIT_L(0); PG8_MMA(1, 0, At, B0); PG8_BAR; PG8_SCHED;
            PG8_STAGE(PG8_SB(1, 1), b3 + hstep, voffB);
            PG8_WAIT_V(6); PG8_BAR; PG8_MMA(1, 1, At, B1); PG8_BAR;
            }
        }
        if constexpr (ALIGN_EPI) { if (wr == 0) PG8_BAR; }
        if constexpr (!Epi::AFTER_DRAIN) { E(acc, cur, wr, wc, fr, fq); S.done(cur); }
        if (!has_next) break;
#pragma unroll
        for (int a = 0; a < 2; ++a)
#pragma unroll
            for (int b = 0; b < 2; ++b)
#pragma unroll
                for (int m = 0; m < 4; ++m)
#pragma unroll
                    for (int n = 0; n < 2; ++n) acc[a][b][m][n] = (f32x4){0.f, 0.f, 0.f, 0.f};
        cur = nxt; cA = nA; cB = nB; ++ui;
        if constexpr (ALIGN_EPI) { if (wr == 1) PG8_BAR; }
    }
    PG8_WAIT_V(0);
    if constexpr (!ALIGN_EPI) { if (wr == 0) PG8_BAR; }
    PG8_BAR;
    if constexpr (Epi::AFTER_DRAIN) { E.fused(acc, cur, wr, wc, fr, fq, lds, wid, lane); S.done(cur); }
#undef PG8_SA
#undef PG8_SB
#undef PG8_STAGE
#undef PG8_LDA
#undef PG8_LDB
#undef PG8_MMA
#undef PG8_WAIT_V
#undef PG8_WAIT_L
#undef PG8_BAR
#undef PG8_SCHED
}
}

#define GAS __attribute__((address_space(1)))
#define LAS __attribute__((address_space(3)))
typedef unsigned short bf16;
typedef float f32x4 __attribute__((ext_vector_type(4)));
typedef float f32x2 __attribute__((ext_vector_type(2)));
typedef float f32x16 __attribute__((ext_vector_type(16)));
typedef short bf16x8 __attribute__((ext_vector_type(8)));
typedef short s16x4 __attribute__((ext_vector_type(4)));
typedef unsigned u32x4 __attribute__((ext_vector_type(4)));
typedef unsigned u32x2 __attribute__((ext_vector_type(2)));

constexpr int NB = 4, SEQ = 2048, CTX = 256, DM = 2048, DEPTH = 2, FF = 8192;
constexpr int TOK = CTX + SEQ;
constexpr int M = NB * TOK;
constexpr int NZ = 4416, NZP = 4608;
constexpr int NUQ = 1152, NUQP = 1280, NUKV = 1536, RANK = 512;
constexpr int MODW = 6 * DM;
constexpr float EPS = 1e-6f;
constexpr float LOG2E = 1.4426950408889634f;
constexpr float DA_QS = 0.125f * LOG2E;
constexpr float MLA_QS = 0.07216878364870322f * LOG2E;
constexpr int NWAVES = 8, NTHR = 512;

enum { I_X = 0, I_C, I_CTX, I_CCTX, I_WMOD, I_BMOD, I_GMIX, I_GMLP, I_WIN, I_LQ1, I_LK1, I_LQ2, I_LK2, I_GDASUB, I_GGMV, I_WSP, I_BSP,
       I_GMQ, I_WUQ, I_GMKV, I_WUKV, I_WOUT, I_WFC1, I_WFC2, I_GFINAL, N_IN };

constexpr size_t al256(size_t x) { return (x + 255) / 256 * 256; }
constexpr size_t WS_ROPE  = 0;
constexpr size_t WS_SCAL  = WS_ROPE + 8192;
constexpr size_t WS_MOD   = WS_SCAL + 256;
constexpr size_t WS_MODP  = al256(WS_MOD + (size_t)DEPTH * 5 * MODW * 4);
constexpr size_t WS_WIN   = al256(WS_MODP + (size_t)DEPTH * 32 * 5 * MODW * 4);
constexpr size_t WS_WOUT  = al256(WS_WIN + (size_t)DEPTH * NZP * DM * 2);
constexpr size_t WS_WFC1  = al256(WS_WOUT + (size_t)DEPTH * DM * DM * 2);
constexpr size_t WS_WFC2  = al256(WS_WFC1 + (size_t)DEPTH * FF * DM * 2);
constexpr size_t WS_WUQ   = al256(WS_WFC2 + (size_t)DEPTH * DM * FF * 2);
constexpr size_t WS_WUKV  = al256(WS_WUQ + (size_t)DEPTH * NUQP * RANK * 2);
constexpr size_t WS_WSP   = al256(WS_WUKV + (size_t)DEPTH * NUKV * RANK * 2);
constexpr size_t WS_XW    = al256(WS_WSP + (size_t)DEPTH * 4 * 128 * 128 * 2);
constexpr size_t WS_HN    = al256(WS_XW + (size_t)M * DM * 4);
constexpr size_t WS_QDA   = al256(WS_HN + (size_t)M * DM * 2);
constexpr size_t WS_KDA   = al256(WS_QDA + (size_t)M * 768 * 2);
constexpr size_t WS_VDA   = al256(WS_KDA + (size_t)M * 768 * 2);
constexpr size_t WS_U     = al256(WS_VDA + (size_t)M * 768 * 2);
constexpr size_t WS_GV    = al256(WS_U + (size_t)M * 512 * 4);
constexpr size_t WS_GVSS  = al256(WS_GV + (size_t)M * 512 * 4);
constexpr size_t WS_CQSS  = al256(WS_GVSS + (size_t)M * 16 * 4);
constexpr size_t WS_CKVSS = al256(WS_CQSS + (size_t)M * 8 * 4);
constexpr size_t WS_CQ    = al256(WS_CKVSS + (size_t)M * 8 * 4);
constexpr size_t WS_CKV   = al256(WS_CQ + (size_t)M * 512 * 2);
constexpr size_t WS_KMLA  = al256(WS_CKV + (size_t)M * 512 * 2);
constexpr size_t WS_VMLA  = al256(WS_KMLA + (size_t)M * 1152 * 2);
constexpr size_t WS_QMLA  = al256(WS_VMLA + (size_t)M * 768 * 2);
constexpr size_t WS_HEADS = al256(WS_QMLA + (size_t)M * 1152 * 2);
constexpr size_t WS_ACT   = al256(WS_HEADS + (size_t)M * DM * 2);
constexpr size_t WS_STASH = al256(WS_ACT + (size_t)M * FF * 2);
constexpr size_t WS_SLAB  = al256(WS_STASH + (size_t)256 * 64 * 512 * 4);
constexpr size_t WS_END   = al256(WS_SLAB + (size_t)8 * 1024 * DM * 4);

constexpr int LDS_BYTES = 131072 + 1024;

__device__ __forceinline__ unsigned cvtpk(float lo, float hi) { unsigned r; asm volatile("v_cvt_pk_bf16_f32 %0, %1, %2" : "=v"(r) : "v"(lo), "v"(hi)); return r; }
__device__ __forceinline__ u32x4 pack8(f32x4 a, f32x4 b) { u32x4 w; w.x = cvtpk(a[0], a[1]); w.y = cvtpk(a[2], a[3]); w.z = cvtpk(b[0], b[1]); w.w = cvtpk(b[2], b[3]); return w; }
__device__ __forceinline__ float wave_sum(float v) {
#pragma unroll
    for (int o = 1; o < 64; o <<= 1) v += __shfl_xor(v, o);
    return v;
}
__device__ __forceinline__ float bf2f(unsigned short h) { return __uint_as_float(((unsigned)h) << 16); }

struct Args { const float* in[N_IN]; float* out; unsigned char* ws; int ph_lo, ph_hi; };
struct Frame {
    LAS unsigned char* lds;
    int G, vcu;
    float* out; unsigned char* ws;
};
#define WSP(T, off) ((T*)(F.ws + (off)))
template <int I> __device__ __forceinline__ const float* inp() {
    unsigned long long p; asm volatile("s_load_dwordx2 %0, %1, %2\n\ts_waitcnt lgkmcnt(0)" : "=s"(p) : "s"(__builtin_amdgcn_kernarg_segment_ptr()), "n"(I * 8) : "memory"); return (const float*)p; }

__device__ __forceinline__ const float* xrow_in(const Args& A, const Frame& F, int row) {
    const int b = row / TOK, rr = row - b * TOK;
    return rr < CTX ? inp<I_CTX>() + (size_t)(b * CTX + rr) * DM : inp<I_X>() + (size_t)(b * SEQ + rr - CTX) * DM;
}

__device__ __forceinline__ void p0_transpose_item(const float* W, int K, int N, bf16* WT, const float* kscale, LAS float* scr, int item, int lane) {
    const int nblk = N / 32, kb = item / nblk, nb = item % nblk, k0 = 64 * kb, n0 = 32 * nb;
    { const int r8 = lane >> 3, c4 = (lane & 7) * 4; f32x4 v[8];
#pragma unroll
      for (int i = 0; i < 8; ++i) v[i] = *(const f32x4*)(W + (size_t)(k0 + r8 + 8 * i) * N + n0 + c4);
#pragma unroll
      for (int i = 0; i < 8; ++i) { const int kk = r8 + 8 * i; const float s = kscale ? kscale[k0 + kk] : 1.f; LAS float* d = scr + kk * 33 + c4;
          d[0] = v[i][0] * s; d[1] = v[i][1] * s; d[2] = v[i][2] * s; d[3] = v[i][3] * s; } }
    asm volatile("s_waitcnt lgkmcnt(0)" ::: "memory");
    const int c = lane & 7;
#pragma unroll
    for (int j = 0; j < 4; ++j) { const int n = (lane >> 3) + 8 * j; const LAS float* s = scr + (8 * c) * 33 + n;
        u32x4 o; o.x = cvtpk(s[0 * 33], s[1 * 33]); o.y = cvtpk(s[2 * 33], s[3 * 33]); o.z = cvtpk(s[4 * 33], s[5 * 33]); o.w = cvtpk(s[6 * 33], s[7 * 33]);
        *(u32x4*)(WT + (size_t)(n0 + n) * K + k0 + 8 * c) = o; }
    asm volatile("s_waitcnt lgkmcnt(0)" ::: "memory");
}
__device__ __forceinline__ float silu_f(float x) { return x / (1.f + __expf(-x)); }

__device__ __forceinline__ void p0_mod_item(const Args& A, const Frame& F, LAS float* scr, int item, int lane) {
    const int l = item / (32 * 48), r = item % (32 * 48), kc = r / 48, nc = r % 48;
    const int k = kc * 64 + lane;
#pragma unroll
    for (int bb = 0; bb < 5; ++bb) { const float cv = bb < 4 ? inp<I_C>()[bb * DM + k] : inp<I_CCTX>()[k]; scr[bb * 64 + lane] = silu_f(cv); }
    asm volatile("s_waitcnt lgkmcnt(0)" ::: "memory");
    const float* W = inp<I_WMOD>() + ((size_t)l * DM + kc * 64) * MODW + nc * 256 + lane * 4;
    f32x4 acc[5];
#pragma unroll
    for (int bb = 0; bb < 5; ++bb) acc[bb] = (f32x4){0.f, 0.f, 0.f, 0.f};
#pragma unroll 8
    for (int kk = 0; kk < 64; ++kk) { const f32x4 w = *(const f32x4*)(W + (size_t)kk * MODW);
#pragma unroll
        for (int bb = 0; bb < 5; ++bb) acc[bb] += w * scr[bb * 64 + kk]; }
    float* P = WSP(float, WS_MODP) + ((size_t)(l * 32 + kc) * 5) * MODW + nc * 256 + lane * 4;
#pragma unroll
    for (int bb = 0; bb < 5; ++bb) *(f32x4*)(P + (size_t)bb * MODW) = acc[bb];
    asm volatile("s_waitcnt lgkmcnt(0)" ::: "memory");
}

__device__ __forceinline__ void p0_prologue(const Args& A, const Frame& F) {
    int tid_ = threadIdx.x; asm volatile("" : "+v"(tid_)); const int ptid = tid_, plane = ptid & 63, pwave = __builtin_amdgcn_readfirstlane(ptid >> 6);
    LAS float* scr = (LAS float*)(F.lds + pwave * 16384);
    const int gw = F.vcu * NWAVES + pwave, NGW = F.G * NWAVES;
    constexpr int I_MOD = DEPTH * 32 * 48;
    constexpr int T_IN = (DM / 64) * (NZ / 32), T_OUT = (DM / 64) * (DM / 32), T_FC1 = (DM / 64) * (FF / 32), T_FC2 = (FF / 64) * (DM / 32), T_UQ = (RANK / 64) * (NUQ / 32), T_UKV = (RANK / 64) * (NUKV / 32);
    constexpr int T_L = T_IN + T_OUT + T_FC1 + T_FC2 + T_UQ + T_UKV;
    constexpr int NITEMS = I_MOD + DEPTH * T_L;
    for (int it = gw; it < NITEMS; it += NGW) {
        if (it < I_MOD) { p0_mod_item(A, F, scr, it, plane); continue; }
        int r = it - I_MOD; const int l = r / T_L; r -= l * T_L;
        if (r < T_IN)  { p0_transpose_item(inp<I_WIN>() + (size_t)l * DM * NZ, DM, NZ, WSP(bf16, WS_WIN) + (size_t)l * NZP * DM, nullptr, scr, r, plane); continue; } r -= T_IN;
        if (r < T_OUT) { p0_transpose_item(inp<I_WOUT>() + (size_t)l * DM * DM, DM, DM, WSP(bf16, WS_WOUT) + (size_t)l * DM * DM, nullptr, scr, r, plane); continue; } r -= T_OUT;
        if (r < T_FC1) { p0_transpose_item(inp<I_WFC1>() + (size_t)l * DM * FF, DM, FF, WSP(bf16, WS_WFC1) + (size_t)l * FF * DM, nullptr, scr, r, plane); continue; } r -= T_FC1;
        if (r < T_FC2) { p0_transpose_item(inp<I_WFC2>() + (size_t)l * FF * DM, FF, DM, WSP(bf16, WS_WFC2) + (size_t)l * DM * FF, nullptr, scr, r, plane); continue; } r -= T_FC2;
        if (r < T_UQ)  { p0_transpose_item(inp<I_WUQ>() + (size_t)l * RANK * NUQ, RANK, NUQ, WSP(bf16, WS_WUQ) + (size_t)l * NUQP * RANK, inp<I_GMQ>() + l * RANK, scr, r, plane); continue; } r -= T_UQ;
        p0_transpose_item(inp<I_WUKV>() + (size_t)l * RANK * NUKV, RANK, NUKV, WSP(bf16, WS_WUKV) + (size_t)l * NUKV * RANK, inp<I_GMKV>() + l * RANK, scr, r, plane);
    }
    const int gt = F.vcu * NTHR + ptid, NGT = F.G * NTHR;
    for (int i = gt; i < DEPTH * (NZP - NZ) * DM / 8; i += NGT) { const int l = i / ((NZP - NZ) * DM / 8), r = i % ((NZP - NZ) * DM / 8);
        *(u32x4*)(WSP(bf16, WS_WIN) + ((size_t)l * NZP + NZ) * DM + (size_t)r * 8) = (u32x4){0u, 0u, 0u, 0u}; }
    for (int i = gt; i < DEPTH * (NUQP - NUQ) * RANK / 8; i += NGT) { const int l = i / ((NUQP - NUQ) * RANK / 8), r = i % ((NUQP - NUQ) * RANK / 8);
        *(u32x4*)(WSP(bf16, WS_WUQ) + ((size_t)l * NUQP + NUQ) * RANK + (size_t)r * 8) = (u32x4){0u, 0u, 0u, 0u}; }
    for (int i = gt; i < DEPTH * 4 * 128 * 128 / 8; i += NGT) { const f32x4 a = *(const f32x4*)(inp<I_WSP>() + (size_t)i * 8), b = *(const f32x4*)(inp<I_WSP>() + (size_t)i * 8 + 4);
        *(u32x4*)(WSP(bf16, WS_WSP) + (size_t)i * 8) = pack8(a, b); }
    if (gt < 64 * 16) { const int pos = gt >> 4, f = gt & 15; const float inv = powf(10000.0f, -(float)f / 16.0f); const float ang = (float)pos * inv;
        WSP(float, WS_ROPE)[gt] = cosf(ang); WSP(float, WS_ROPE)[1024 + gt] = sinf(ang); }
    if (gt < 64 * DEPTH) {
        const int l = gt >> 6; const float a = inp<I_LQ1>()[l * 64 + plane] * inp<I_LK1>()[l * 64 + plane], b = inp<I_LQ2>()[l * 64 + plane] * inp<I_LK2>()[l * 64 + plane];
        const float sa = wave_sum(a), sb = wave_sum(b); const float lam_init = 0.8f - 0.6f * expf(-0.3f * (float)l);
        if (plane == 0) WSP(float, WS_SCAL)[l] = expf(sa) - expf(sb) + lam_init;
    }
}
__device__ __forceinline__ void p0b_modreduce(const Args& A, const Frame& F) {
    int tid_ = threadIdx.x; asm volatile("" : "+v"(tid_)); const int ptid = tid_, plane = ptid & 63, pwave = __builtin_amdgcn_readfirstlane(ptid >> 6);
    const int gt = F.vcu * NTHR + ptid, NGT = F.G * NTHR;
    for (int i = gt; i < DEPTH * 5 * MODW; i += NGT) { const int l = i / (5 * MODW), r = i % (5 * MODW), n = r % MODW;
        float s = inp<I_BMOD>()[l * MODW + n]; const float* P = WSP(float, WS_MODP) + (size_t)l * 32 * 5 * MODW + r;
#pragma unroll 8
        for (int kc = 0; kc < 32; ++kc) s += P[(size_t)kc * 5 * MODW];
        WSP(float, WS_MOD)[i] = s; }
}

__device__ __forceinline__ void norm_phase(const Args& A, const Frame& F, int l, int src_mode, const float* g, int shoff, const float* slab, bool skip_ctx) {
    int tid_ = threadIdx.x; asm volatile("" : "+v"(tid_)); const int ptid = tid_, plane = ptid & 63, pwave = __builtin_amdgcn_readfirstlane(ptid >> 6);
    const int gw = F.vcu * NWAVES + pwave, NGW = F.G * NWAVES;
    for (int row = gw; row < M; row += NGW) {
        const int b = row / TOK, rr = row - b * TOK; const bool isctx = rr < CTX; const int bsel = isctx ? 4 : b;
        if (isctx && skip_ctx) continue;
        const bool from_in = src_mode == 1 || (src_mode == 2 && isctx);
        const float* xr = from_in ? xrow_in(A, F, row) : WSP(float, WS_XW) + (size_t)row * DM;
        const float* md = WSP(float, WS_MOD) + ((size_t)l * 5 + bsel) * MODW + shoff;
        f32x4 v[8]; float s = 0.f;
#pragma unroll
        for (int j = 0; j < 8; ++j) v[j] = *(const f32x4*)(xr + 4 * plane + 256 * j);
        if (isctx && slab) {
            const float* sp = slab + (size_t)(b * CTX + rr) * DM + 4 * plane;
            for (int ks = 0; ks < 8; ++ks) {
#pragma unroll
                for (int j = 0; j < 8; ++j) v[j] += *(const f32x4*)(sp + (size_t)ks * 1024 * DM + 256 * j); }
            float* xo = WSP(float, WS_XW) + (size_t)row * DM + 4 * plane;
#pragma unroll
            for (int j = 0; j < 8; ++j) *(f32x4*)(xo + 256 * j) = v[j];
        }
#pragma unroll
        for (int j = 0; j < 8; ++j) s += (v[j].x * v[j].x + v[j].y * v[j].y) + (v[j].z * v[j].z + v[j].w * v[j].w);
        const float rstd = 1.0f / sqrtf(wave_sum(s) * (1.f / DM) + EPS);
        bf16* o = WSP(bf16, WS_HN) + (size_t)row * DM;
#pragma unroll
        for (int j = 0; j < 8; ++j) { const int c = 4 * plane + 256 * j; const f32x4 gg = *(const f32x4*)(g + c), sh = *(const f32x4*)(md + c), sc = *(const f32x4*)(md + DM + c);
            const f32x4 y = (v[j] * rstd) * gg * (sc + 1.0f) + sh; u32x2 w; w.x = cvtpk(y.x, y.y); w.y = cvtpk(y.z, y.w); *(u32x2*)(o + c) = w; }
    }
}
__device__ __forceinline__ void final_norm_phase(const Args& A, const Frame& F) {
    int tid_ = threadIdx.x; asm volatile("" : "+v"(tid_)); const int ptid = tid_, plane = ptid & 63, pwave = __builtin_amdgcn_readfirstlane(ptid >> 6);
    const int gw = F.vcu * NWAVES + pwave, NGW = F.G * NWAVES; const float* g = inp<I_GFINAL>();
    for (int r = gw; r < NB * SEQ; r += NGW) {
        const int b = r / SEQ, t = r - b * SEQ; const float* xr = WSP(float, WS_XW) + (size_t)(b * TOK + CTX + t) * DM;
        f32x4 v[8]; float s = 0.f;
#pragma unroll
        for (int j = 0; j < 8; ++j) { v[j] = *(const f32x4*)(xr + 4 * plane + 256 * j); s += (v[j].x * v[j].x + v[j].y * v[j].y) + (v[j].z * v[j].z + v[j].w * v[j].w); }
        const float rstd = 1.0f / sqrtf(wave_sum(s) * (1.f / DM) + EPS);
        float* o = F.out + (size_t)r * DM;
#pragma unroll
        for (int j = 0; j < 8; ++j) { const int c = 4 * plane + 256 * j; const f32x4 gg = *(const f32x4*)(g + c); *(f32x4*)(o + c) = (v[j] * rstd) * gg; }
    }
}

struct TileOrder {
    int nM, nN, nwg, G, c, mode, nsplit, kslice;
    __device__ void init(int N, int G_, int c_, int mode_, int nsplit_ = 1, int kslice_ = 0) { mode = mode_; nsplit = nsplit_; kslice = kslice_; nM = mode_ == 0 ? 36 : (mode_ == 1 ? 32 : 4); nN = N / 256; nwg = nM * nN * nsplit_; G = G_; c = c_; }
    __device__ bool next(int i, pg8::Unit& u) const {
        const long L = (long)i * G + c; if (L >= nwg) return false;
        int wgid = (int)L; { const int q = nwg / 8, r = nwg % 8, xcd = wgid % 8, off = wgid / 8; wgid = (xcd < r ? xcd * (q + 1) : r * (q + 1) + (xcd - r) * q) + off; }
        if (mode == 3) {
            const int per = 4 * nN, ks = wgid / per, rem = wgid - ks * per; u.ks = ks; u.k0 = ks * kslice; u.pn = rem >> 2; u.pm = (rem & 3) * 9; return true; }
        const int nig = 8 * nN, gid = wgid / nig, fm = gid * 8, gsz = (nM - fm) < 8 ? (nM - fm) : 8;
        int pm = fm + ((wgid % nig) % gsz); u.pn = (wgid % nig) / gsz;
        if (mode == 1) pm = (pm >> 3) * 9 + 1 + (pm & 7); else if (mode == 2) pm = pm * 9;
        u.pm = pm; u.k0 = 0; u.ks = 0; return true;
    }
    __device__ __forceinline__ void a_ready(const pg8::Unit&) const {}
    __device__ __forceinline__ void done(const pg8::Unit&) const {}
};

__device__ __forceinline__ void rope8(f32x4& v0, f32x4& v1, const float* ropetab, int pos, int f0) {
    const f32x4 c = *(const f32x4*)(ropetab + pos * 16 + f0), s = *(const f32x4*)(ropetab + 1024 + pos * 16 + f0);
    const f32x4 a = v0, b = v1;
    v0[0] = a[0] * c[0] - a[1] * s[0]; v0[1] = a[0] * s[0] + a[1] * c[0]; v0[2] = a[2] * c[1] - a[3] * s[1]; v0[3] = a[2] * s[1] + a[3] * c[1];
    v1[0] = b[0] * c[2] - b[1] * s[2]; v1[1] = b[0] * s[2] + b[1] * c[2]; v1[2] = b[2] * c[3] - b[3] * s[3]; v1[3] = b[2] * s[3] + b[3] * c[3];
}
__device__ __forceinline__ f32x4 gelu4(f32x4 v) { const f32x2 a = pg8::gelu_pk((f32x2){v[0], v[1]}), b = pg8::gelu_pk((f32x2){v[2], v[3]}); return (f32x4){a.x, a.y, b.x, b.y}; }
__device__ __forceinline__ float ss8(f32x4 a, f32x4 b) { return (a[0] * a[0] + a[1] * a[1]) + (a[2] * a[2] + a[3] * a[3]) + (b[0] * b[0] + b[1] * b[1]) + (b[2] * b[2] + b[3] * b[3]); }

struct EpiZ {
    static constexpr bool PERM = true, AFTER_DRAIN = false;
    unsigned char* ws; const float* ropetab;
    __device__ __forceinline__ void operator()(const f32x4 (&acc)[2][2][4][2], const pg8::Unit& u, int wr, int wc, int fr, int fq) const {
        const int pn = u.pn;
#pragma unroll
        for (int ai = 0; ai < 2; ++ai)
#pragma unroll
            for (int m = 0; m < 4; ++m) {
                const int row = u.pm * 256 + ai * 128 + wr * 64 + m * 16 + fr;
                const int b = row / TOK, rr = row - b * TOK; const bool lat = rr >= CTX; const int t = rr - CTX, prow = (t >> 6) & 31, pcol = t & 63;
                float ssq = 0.f;
#pragma unroll
                for (int bj = 0; bj < 2; ++bj) {
                    const int colt = bj * 128 + wc * 32 + 8 * fq;
                    f32x4 v0 = acc[ai][bj][m][0], v1 = acc[ai][bj][m][1];
                    if (pn < 6) {
                        if (lat) { const int j0 = (colt & 63) >> 1; rope8(v0, v1, ropetab, j0 < 16 ? prow : pcol, j0 & 15); }
                        if (pn < 3) { v0 *= DA_QS; v1 *= DA_QS; *(u32x4*)((bf16*)(ws + WS_QDA) + (size_t)row * 768 + pn * 256 + colt) = pack8(v0, v1); }
                        else *(u32x4*)((bf16*)(ws + WS_KDA) + (size_t)row * 768 + (pn - 3) * 256 + colt) = pack8(v0, v1);
                    } else if (pn < 9) {
                        *(u32x4*)((bf16*)(ws + WS_VDA) + (size_t)row * 768 + (pn - 6) * 256 + colt) = pack8(v0, v1);
                    } else if (pn < 11) {
                        float* o = (float*)(ws + WS_U) + (size_t)row * 512 + (pn - 9) * 256 + colt; *(f32x4*)o = gelu4(v0); *(f32x4*)(o + 4) = gelu4(v1);
                    } else if (pn < 13) {
                        v0 = gelu4(v0); v1 = gelu4(v1);
                        float* o = (float*)(ws + WS_GV) + (size_t)row * 512 + (pn - 11) * 256 + colt; *(f32x4*)o = v0; *(f32x4*)(o + 4) = v1;
                        float s = ss8(v0, v1); s += __shfl_xor(s, 16); s += __shfl_xor(s, 32);
                        if (fq == 0) ((float*)(ws + WS_GVSS))[(size_t)row * 16 + ((pn - 11) * 2 + bj) * 4 + wc] = s;
                    } else if (pn < 15) {
                        *(u32x4*)((bf16*)(ws + WS_CQ) + (size_t)row * 512 + (pn - 13) * 256 + colt) = pack8(v0, v1); ssq += ss8(v0, v1);
                    } else if (pn < 17) {
                        *(u32x4*)((bf16*)(ws + WS_CKV) + (size_t)row * 512 + (pn - 15) * 256 + colt) = pack8(v0, v1); ssq += ss8(v0, v1);
                    } else {
                        if (colt < 64) {
                            if (lat) { const int j0 = colt >> 1; rope8(v0, v1, ropetab, j0 < 16 ? prow : pcol, j0 & 15); }
                            const u32x4 w = pack8(v0, v1); bf16* o = (bf16*)(ws + WS_KMLA) + (size_t)row * 1152 + 128 + colt;
#pragma unroll
                            for (int h = 0; h < 6; ++h) *(u32x4*)(o + h * 192) = w;
                        }
                    }
                }
                if (pn >= 13 && pn < 17) {
                    ssq += __shfl_xor(ssq, 16); ssq += __shfl_xor(ssq, 32);
                    if (fq == 0) { if (pn < 15) ((float*)(ws + WS_CQSS))[(size_t)row * 8 + (pn - 13) * 4 + wc] = ssq; else ((float*)(ws + WS_CKVSS))[(size_t)row * 8 + (pn - 15) * 4 + wc] = ssq; }
                }
            }
    }
};
__device__ __forceinline__ float rstd8(const float* p, float inv_n) { const f32x4 a = *(const f32x4*)p, b = *(const f32x4*)(p + 4); return 1.0f / sqrtf(((a[0] + a[1]) + (a[2] + a[3]) + (b[0] + b[1]) + (b[2] + b[3])) * inv_n + EPS); }

struct EpiKV {
    static constexpr bool PERM = true, AFTER_DRAIN = false;
    unsigned char* ws;
    __device__ __forceinline__ void operator()(const f32x4 (&acc)[2][2][4][2], const pg8::Unit& u, int wr, int wc, int fr, int fq) const {
#pragma unroll
        for (int ai = 0; ai < 2; ++ai)
#pragma unroll
            for (int m = 0; m < 4; ++m) {
                const int row = u.pm * 256 + ai * 128 + wr * 64 + m * 16 + fr;
                const float rs = rstd8((const float*)(ws + WS_CKVSS) + (size_t)row * 8, 1.f / RANK);
                const int c = wc * 32 + 8 * fq;
                *(u32x4*)((bf16*)(ws + WS_KMLA) + (size_t)row * 1152 + u.pn * 192 + c) = pack8(acc[ai][0][m][0] * rs, acc[ai][0][m][1] * rs);
                *(u32x4*)((bf16*)(ws + WS_VMLA) + (size_t)row * 768 + u.pn * 128 + c) = pack8(acc[ai][1][m][0] * rs, acc[ai][1][m][1] * rs);
            }
    }
};
struct EpiQ {
    static constexpr bool PERM = true, AFTER_DRAIN = false;
    unsigned char* ws; const float* ropetab;
    __device__ __forceinline__ void operator()(const f32x4 (&acc)[2][2][4][2], const pg8::Unit& u, int wr, int wc, int fr, int fq) const {
#pragma unroll
        for (int ai = 0; ai < 2; ++ai)
#pragma unroll
            for (int m = 0; m < 4; ++m) {
                const int row = u.pm * 256 + ai * 128 + wr * 64 + m * 16 + fr;
                const int b = row / TOK, rr = row - b * TOK; const bool lat = rr >= CTX; const int t = rr - CTX, prow = (t >> 6) & 31, pcol = t & 63;
                const float rs = rstd8((const float*)(ws + WS_CQSS) + (size_t)row * 8, 1.f / RANK) * MLA_QS;
#pragma unroll
                for (int bj = 0; bj < 2; ++bj) {
                    const int col = u.pn * 256 + bj * 128 + wc * 32 + 8 * fq;
                    if (col < NUQ) {
                        f32x4 v0 = acc[ai][bj][m][0] * rs, v1 = acc[ai][bj][m][1] * rs;
                        const int hd = col / 192, i = col - hd * 192;
                        if (lat && i >= 128) { const int j0 = (i - 128) >> 1; rope8(v0, v1, ropetab, j0 < 16 ? prow : pcol, j0 & 15); }
                        *(u32x4*)((bf16*)(ws + WS_QMLA) + (size_t)row * 1152 + col) = pack8(v0, v1);
                    }
                }
            }
    }
};
struct EpiResid {
    static constexpr bool PERM = true, AFTER_DRAIN = false;
    unsigned char* ws; const float* xin; const float* cin; const float* gate; bool from_inputs;
    __device__ __forceinline__ void operator()(const f32x4 (&acc)[2][2][4][2], const pg8::Unit& u, int wr, int wc, int fr, int fq) const {
        const int b = u.pm / 9; const bool isctx = (u.pm - b * 9) == 0; const int bsel = isctx ? 4 : b;
        const float* gp = gate + (size_t)bsel * MODW + u.pn * 256 + wc * 32 + 8 * fq;
        f32x4 g[2][2];
#pragma unroll
        for (int bj = 0; bj < 2; ++bj) { g[bj][0] = *(const f32x4*)(gp + bj * 128); g[bj][1] = *(const f32x4*)(gp + bj * 128 + 4); }
#pragma unroll
        for (int ai = 0; ai < 2; ++ai)
#pragma unroll
            for (int m = 0; m < 4; ++m) {
                const int row = u.pm * 256 + ai * 128 + wr * 64 + m * 16 + fr; const int rr = row - b * TOK;
                const float* bp = from_inputs ? (isctx ? cin + (size_t)(b * CTX + rr) * DM : xin + (size_t)(b * SEQ + rr - CTX) * DM) : (const float*)(ws + WS_XW) + (size_t)row * DM;
                float* op = (float*)(ws + WS_XW) + (size_t)row * DM;
#pragma unroll
                for (int bj = 0; bj < 2; ++bj) { const int c = u.pn * 256 + bj * 128 + wc * 32 + 8 * fq;
                    const f32x4 b0 = *(const f32x4*)(bp + c), b1 = *(const f32x4*)(bp + c + 4);
                    *(f32x4*)(op + c) = b0 + g[bj][0] * acc[ai][bj][m][0]; *(f32x4*)(op + c + 4) = b1 + g[bj][1] * acc[ai][bj][m][1]; }
            }
    }
};
struct EpiSlab {
    static constexpr bool PERM = true, AFTER_DRAIN = false;
    float* slab; const float* gate;
    __device__ __forceinline__ void operator()(const f32x4 (&acc)[2][2][4][2], const pg8::Unit& u, int wr, int wc, int fr, int fq) const {
        const int b = u.pm / 9; const float* gp = gate + u.pn * 256 + wc * 32 + 8 * fq;
        f32x4 g[2][2];
#pragma unroll
        for (int bj = 0; bj < 2; ++bj) { g[bj][0] = *(const f32x4*)(gp + bj * 128); g[bj][1] = *(const f32x4*)(gp + bj * 128 + 4); }
#pragma unroll
        for (int ai = 0; ai < 2; ++ai)
#pragma unroll
            for (int m = 0; m < 4; ++m) {
                const int crow_ = b * CTX + ai * 128 + wr * 64 + m * 16 + fr;
                float* op = slab + ((size_t)u.ks * 1024 + crow_) * DM + u.pn * 256 + wc * 32 + 8 * fq;
#pragma unroll
                for (int bj = 0; bj < 2; ++bj) { *(f32x4*)(op + bj * 128) = g[bj][0] * acc[ai][bj][m][0]; *(f32x4*)(op + bj * 128 + 4) = g[bj][1] * acc[ai][bj][m][1]; }
            }
    }
};
struct EpiFc1 {
    static constexpr bool PERM = true, AFTER_DRAIN = false;
    unsigned char* ws;
    __device__ __forceinline__ void operator()(const f32x4 (&acc)[2][2][4][2], const pg8::Unit& u, int wr, int wc, int fr, int fq) const {
#pragma unroll
        for (int ai = 0; ai < 2; ++ai)
#pragma unroll
            for (int m = 0; m < 4; ++m) {
                const int row = u.pm * 256 + ai * 128 + wr * 64 + m * 16 + fr;
#pragma unroll
                for (int bj = 0; bj < 2; ++bj) { const int c = u.pn * 256 + bj * 128 + wc * 32 + 8 * fq;
                    f32x4 v0 = __builtin_elementwise_max(acc[ai][bj][m][0], (f32x4){0.f, 0.f, 0.f, 0.f}), v1 = __builtin_elementwise_max(acc[ai][bj][m][1], (f32x4){0.f, 0.f, 0.f, 0.f});
                    *(u32x4*)((bf16*)(ws + WS_ACT) + (size_t)row * FF + c) = pack8(v0 * v0, v1 * v1); }
            }
    }
};

namespace att {
#define SBAR() __builtin_amdgcn_sched_barrier(0)
constexpr int V_TILE = 64 * 128 * 2, K_OFF = 2 * V_TILE, K_TILE_MAX = 64 * 192 * 2, WS_OFF = K_OFF + 2 * K_TILE_MAX;
constexpr float THR = 6.0f;
__device__ __forceinline__ int crow(int r, int hi) { return (r & 3) + 8 * (r >> 2) + 4 * hi; }
__device__ __forceinline__ int v_st(int k, int c) { const int kk = (k & ~0xC) | ((k & 4) << 1) | ((k & 8) >> 1); return ((kk >> 3) * 4 + (c >> 5)) * 512 + ((kk & 7) * 32 + (c & 31)) * 2; }
__device__ __forceinline__ int v_rd_base(int lane) { return ((lane & 3) << 3) | (((lane >> 2) & 3) << 6) | (((lane >> 4) & 1) << 5) | (((lane >> 5) & 1) << 8); }
constexpr int v_rd_off(int d0, int ks, int half) { return d0 * 512 + ks * 4096 + half * 2048; }
template <int OFF> __device__ __forceinline__ s16x4 tr_read(int vb) { s16x4 r; asm volatile("ds_read_b64_tr_b16 %0, %1 offset:%2" : "=&v"(r) : "v"(vb), "i"(OFF) : "memory"); return r; }
template <int D0> __device__ __forceinline__ void pv_one(f32x16& od, int vb, bf16x8 pa0, bf16x8 pa1, bf16x8 pa2, bf16x8 pa3) {
    const s16x4 l0 = tr_read<v_rd_off(D0, 0, 0)>(vb), h0 = tr_read<v_rd_off(D0, 0, 1)>(vb), l1 = tr_read<v_rd_off(D0, 1, 0)>(vb), h1 = tr_read<v_rd_off(D0, 1, 1)>(vb);
    const s16x4 l2 = tr_read<v_rd_off(D0, 2, 0)>(vb), h2 = tr_read<v_rd_off(D0, 2, 1)>(vb), l3 = tr_read<v_rd_off(D0, 3, 0)>(vb), h3 = tr_read<v_rd_off(D0, 3, 1)>(vb);
    asm volatile("s_waitcnt lgkmcnt(0)" ::: "memory"); SBAR();
#define PK(L, H) (bf16x8){L[0], L[1], L[2], L[3], H[0], H[1], H[2], H[3]}
    od = __builtin_amdgcn_mfma_f32_32x32x16_bf16(pa0, PK(l0, h0), od, 0, 0, 0);
    od = __builtin_amdgcn_mfma_f32_32x32x16_bf16(pa1, PK(l1, h1), od, 0, 0, 0);
    od = __builtin_amdgcn_mfma_f32_32x32x16_bf16(pa2, PK(l2, h2), od, 0, 0, 0);
    od = __builtin_amdgcn_mfma_f32_32x32x16_bf16(pa3, PK(l3, h3), od, 0, 0, 0);
#undef PK
}
template <int DQK> __device__ __forceinline__ int k_off(int r, int c) { return r * (DQK * 2) + ((c ^ ((r >> 1) & 7)) << 4); }

template <int DQK>
__device__ __forceinline__ void attn_pass(f32x16 (&o)[4], const bf16* __restrict__ Qw, int ldq, const bf16* __restrict__ Kb, int ldk, const bf16* __restrict__ Vb, int ldv, int NT, LAS unsigned char* lds) {
    constexpr int KT = 64 * DQK * 2, NKC = DQK / 8, NKS = (64 * NKC) / NTHR, ND = DQK / 16;
    int tid_ = threadIdx.x; asm volatile("" : "+v"(tid_)); const int tid = tid_, wid = tid >> 6, lane = tid & 63, r32 = lane & 31, hi = lane >> 5;
    LAS unsigned char* V_lds = lds; LAS unsigned char* K_lds = lds + K_OFF;
    LAS float* wsf = (LAS float*)(lds + WS_OFF) + wid * 64;
    bf16x8 qr[ND];
#pragma unroll
    for (int d0 = 0; d0 < ND; ++d0) qr[d0] = *(const bf16x8*)(Qw + (size_t)r32 * ldq + d0 * 16 + hi * 8);
    int kgo[NKS], klo[NKS];
#pragma unroll
    for (int i = 0; i < NKS; ++i) { const int idx = tid + NTHR * i, r = idx / NKC, c = idx - r * NKC; kgo[i] = r * ldk + c * 8; klo[i] = k_off<DQK>(r, c); }
    const int sr = tid >> 4, sc = (tid & 15) * 8, vst0 = v_st(sr, sc), vst1 = v_st(32 + sr, sc);
    const int vb0 = (int)(uintptr_t)V_lds + v_rd_base(lane);
    bf16x8 ks[NKS], vs0, vs1;
#define SLOAD(k0) do { _Pragma("unroll") for (int i_ = 0; i_ < NKS; ++i_) ks[i_] = *(const bf16x8*)(Kb + (size_t)(k0) * ldk + kgo[i_]); \
        vs0 = *(const bf16x8*)(Vb + (size_t)((k0) + sr) * ldv + sc); vs1 = *(const bf16x8*)(Vb + (size_t)((k0) + 32 + sr) * ldv + sc); } while (0)
#define SWRITE(buf) do { _Pragma("unroll") for (int i_ = 0; i_ < NKS; ++i_) *(LAS bf16x8*)(K_lds + (buf) * KT + klo[i_]) = ks[i_]; \
        *(LAS bf16x8*)(V_lds + (buf) * V_TILE + vst0) = vs0; *(LAS bf16x8*)(V_lds + (buf) * V_TILE + vst1) = vs1; } while (0)
    float m_reg = -1e30f, l_reg = 0.f;
#pragma unroll
    for (int d = 0; d < 4; ++d) o[d] = f32x16{};
    SLOAD(0); SWRITE(0); __syncthreads();
    for (int j = 0; j < NT; ++j) {
        const int buf = j & 1;
        if (j + 1 < NT) SLOAD((j + 1) * 64);
        f32x16 p0 = f32x16{}, p1 = f32x16{};
        { const LAS unsigned char* Kt = K_lds + buf * KT;
#pragma unroll
          for (int d0 = 0; d0 < ND; ++d0) {
              const bf16x8 b0 = *(const LAS bf16x8*)(Kt + k_off<DQK>(r32, 2 * d0 + hi)), b1 = *(const LAS bf16x8*)(Kt + k_off<DQK>(32 + r32, 2 * d0 + hi));
              p0 = __builtin_amdgcn_mfma_f32_32x32x16_bf16(b0, qr[d0], p0, 0, 0, 0);
              p1 = __builtin_amdgcn_mfma_f32_32x32x16_bf16(b1, qr[d0], p1, 0, 0, 0); if ((d0 & 1) == 1) SBAR(); } }
        float pmax = p0[0];
#pragma unroll
        for (int r = 1; r < 16; ++r) pmax = fmaxf(pmax, p0[r]);
#pragma unroll
        for (int r = 0; r < 16; ++r) pmax = fmaxf(pmax, p1[r]);
        { auto rr = __builtin_amdgcn_permlane32_swap(__float_as_uint(pmax), __float_as_uint(pmax), false, false); pmax = fmaxf(__uint_as_float(rr[0]), __uint_as_float(rr[1])); }
        float alpha = 1.f;
        if (!__all(pmax - m_reg <= THR)) { const float mn = fmaxf(m_reg, pmax); alpha = __builtin_amdgcn_exp2f(m_reg - mn); m_reg = mn;
            if (hi == 0) wsf[r32] = alpha; asm volatile("s_waitcnt lgkmcnt(0)" ::: "memory");
#pragma unroll
            for (int r = 0; r < 16; ++r) { const float a = wsf[crow(r, hi)];
#pragma unroll
                for (int d = 0; d < 4; ++d) o[d][r] *= a; }
            asm volatile("s_waitcnt lgkmcnt(0)" ::: "memory"); }
        float ps = 0.f;
#pragma unroll
        for (int r = 0; r < 16; ++r) { p0[r] = __builtin_amdgcn_exp2f(p0[r] - m_reg); p1[r] = __builtin_amdgcn_exp2f(p1[r] - m_reg); ps += p0[r] + p1[r]; }
        { auto rr = __builtin_amdgcn_permlane32_swap(__float_as_uint(ps), __float_as_uint(ps), false, false); ps = __uint_as_float(rr[0]) + __uint_as_float(rr[1]); }
        l_reg = l_reg * alpha + ps;
        bf16x8 pa0, pa1, pa2, pa3;
#define PK4(P, BASE, OUT) do { unsigned a0 = cvtpk(P[BASE + 0], P[BASE + 1]), a1 = cvtpk(P[BASE + 2], P[BASE + 3]); \
        unsigned b0 = cvtpk(P[BASE + 4], P[BASE + 5]), b1 = cvtpk(P[BASE + 6], P[BASE + 7]); \
        auto r0 = __builtin_amdgcn_permlane32_swap(a0, b0, false, false); auto r1 = __builtin_amdgcn_permlane32_swap(a1, b1, false, false); \
        u32x4 w = {r0[0], r1[0], r0[1], r1[1]}; OUT = __builtin_bit_cast(bf16x8, w); } while (0)
        PK4(p0, 0, pa0); PK4(p0, 8, pa1); PK4(p1, 0, pa2); PK4(p1, 8, pa3);
#undef PK4
        SBAR();
        { const int vb = vb0 + buf * V_TILE;
          pv_one<0>(o[0], vb, pa0, pa1, pa2, pa3); pv_one<1>(o[1], vb, pa0, pa1, pa2, pa3); pv_one<2>(o[2], vb, pa0, pa1, pa2, pa3); pv_one<3>(o[3], vb, pa0, pa1, pa2, pa3); }
        if (j + 1 < NT) SWRITE(buf ^ 1);
        __syncthreads();
    }
    if (hi == 0) wsf[32 + r32] = l_reg; asm volatile("s_waitcnt lgkmcnt(0)" ::: "memory");
#pragma unroll
    for (int r = 0; r < 16; ++r) { const float rl = 1.0f / wsf[32 + crow(r, hi)];
#pragma unroll
        for (int d = 0; d < 4; ++d) o[d][r] *= rl; }
    asm volatile("s_waitcnt lgkmcnt(0)" ::: "memory");
#undef SLOAD
#undef SWRITE
}


__device__ __forceinline__ void store_o(const f32x16 (&o)[4], const float (&rs)[16], const float (&gcol)[4], bf16* dst, int ld, LAS unsigned char* lds, int wid, int lane) {
    const int r32 = lane & 31, hi = lane >> 5;
    LAS unsigned short* stg = (LAS unsigned short*)(lds + wid * 8192);
#pragma unroll
    for (int d = 0; d < 4; ++d)
#pragma unroll
        for (int r = 0; r < 16; ++r) stg[crow(r, hi) * 128 + d * 32 + r32] = (unsigned short)(cvtpk(o[d][r] * rs[r] * gcol[d], 0.f) & 0xffffu);
    asm volatile("s_waitcnt lgkmcnt(0)" ::: "memory");
    bf16* p = dst + (size_t)(lane >> 4) * ld + (lane & 15) * 8;
#pragma unroll
    for (int i = 0; i < 8; ++i) { const u32x4 v = *(const LAS u32x4*)(stg + (i * 4 + (lane >> 4)) * 128 + (lane & 15) * 8); *(u32x4*)p = v; p += 4 * (size_t)ld; asm volatile("" : "+v"(p)); }
}

__device__ __forceinline__ void da_unit(const Args& A, const Frame& F, int l, int q0, int k0, int NT, int h) {
    int tid_ = threadIdx.x; asm volatile("" : "+v"(tid_)); const int tid = tid_, wid = tid >> 6, lane = tid & 63, r32 = lane & 31, hi = lane >> 5;
    const bf16* Q = WSP(bf16, WS_QDA); const bf16* K = WSP(bf16, WS_KDA); const bf16* V = WSP(bf16, WS_VDA);
    float* stash = WSP(float, WS_STASH) + ((size_t)blockIdx.x * NTHR + tid) * 64;
    const float lam = WSP(float, WS_SCAL)[l]; const float lam_init = 0.8f - 0.6f * expf(-0.3f * (float)l);
    f32x16 o[4];
    attn_pass<64>(o, Q + (size_t)(q0 + wid * 32) * 768 + (2 * h) * 64, 768, K + (size_t)k0 * 768 + (2 * h) * 64, 768, V + (size_t)k0 * 768 + h * 128, 768, NT, F.lds);
#pragma unroll
    for (int d = 0; d < 4; ++d)
#pragma unroll
        for (int r = 0; r < 16; r += 4) *(f32x4*)(stash + d * 16 + r) = (f32x4){o[d][r], o[d][r + 1], o[d][r + 2], o[d][r + 3]};
    attn_pass<64>(o, Q + (size_t)(q0 + wid * 32) * 768 + (2 * h + 1) * 64, 768, K + (size_t)k0 * 768 + (2 * h + 1) * 64, 768, V + (size_t)k0 * 768 + h * 128, 768, NT, F.lds);
    float ss[16];
#pragma unroll
    for (int r = 0; r < 16; ++r) ss[r] = 0.f;
#pragma unroll
    for (int d = 0; d < 4; ++d) {
#pragma unroll
        for (int r = 0; r < 16; r += 4) { const f32x4 s4 = *(const f32x4*)(stash + d * 16 + r);
#pragma unroll
            for (int e = 0; e < 4; ++e) { const float v = s4[e] - lam * o[d][r + e]; o[d][r + e] = v; ss[r + e] += v * v; } }
        asm volatile("" ::: "memory"); SBAR(); }
#pragma unroll
    for (int r = 0; r < 16; ++r) { float s = ss[r]; s += __shfl_xor(s, 1); s += __shfl_xor(s, 2); s += __shfl_xor(s, 4); s += __shfl_xor(s, 8); s += __shfl_xor(s, 16);
        ss[r] = (1.0f / sqrtf(s * (1.f / 128.f) + EPS)) * (1.f - lam_init); }
    const float* gs = inp<I_GDASUB>() + l * 128;
    float gcol[4];
#pragma unroll
    for (int d = 0; d < 4; ++d) gcol[d] = gs[d * 32 + r32];
    store_o(o, ss, gcol, WSP(bf16, WS_HEADS) + (size_t)(q0 + wid * 32) * DM + h * 128, DM, F.lds, wid, lane);
    __syncthreads();
}
__device__ __forceinline__ void mla_unit(const Args& A, const Frame& F, int q0, int k0, int NT, int h) {
    int tid_ = threadIdx.x; asm volatile("" : "+v"(tid_)); const int tid = tid_, wid = tid >> 6, lane = tid & 63, r32 = lane & 31, hi = lane >> 5;
    f32x16 o[4];
    attn_pass<192>(o, WSP(bf16, WS_QMLA) + (size_t)(q0 + wid * 32) * 1152 + h * 192, 1152, WSP(bf16, WS_KMLA) + (size_t)k0 * 1152 + h * 192, 1152, WSP(bf16, WS_VMLA) + (size_t)k0 * 768 + h * 128, 768, NT, F.lds);
    float rs[16], gcol[4];
#pragma unroll
    for (int r = 0; r < 16; ++r) rs[r] = 1.f;
#pragma unroll
    for (int d = 0; d < 4; ++d) gcol[d] = 1.f;
    store_o(o, rs, gcol, WSP(bf16, WS_HEADS) + (size_t)(q0 + wid * 32) * DM + 1280 + h * 128, DM, F.lds, wid, lane);
    __syncthreads();
}
__device__ __forceinline__ void attn_phase(const Args& A, const Frame& F, int l, bool with_ctx) {
    const int nun = with_ctx ? 432 : 384;
    for (int un = F.vcu; un < nun; un += F.G) {
        if (un < 384) { const int v = un < 192 ? un : un - 192; const int bh = v >> 3, qb = v & 7, b = bh / 6, h = bh - b * 6;

#ifndef NO_DA
            if (un < 192) da_unit(A, F, l, b * TOK + CTX + qb * 256, b * TOK, 36, h);
#endif
#ifndef NO_MLA
            if (un >= 192) mla_unit(A, F, b * TOK + CTX + qb * 256, b * TOK, 36, h);
#endif
        }
        else { const int v = un < 408 ? un - 384 : un - 408; const int b = v / 6, h = v - b * 6;

#ifndef NO_DA
            if (un < 408) da_unit(A, F, l, b * TOK, b * TOK, 4, h);
#endif
#ifndef NO_MLA
            if (un >= 408) mla_unit(A, F, b * TOK, b * TOK, 4, h);
#endif
        }
    }
}

__device__ __forceinline__ void gate_unit(const Args& A, const Frame& F, int l, int ch, int g) {
    int tid_ = threadIdx.x; asm volatile("" : "+v"(tid_)); const int tid = tid_, wid = tid >> 6, lane = tid & 63, r32 = lane & 31, hi = lane >> 5;
    const int r0 = ch * 128;
    LAS unsigned char* img = F.lds;
    { const int sc = (tid & 15) * 8; const float* gain = inp<I_GGMV>() + (l * 4 + g) * 128 + sc; const f32x4 g0 = *(const f32x4*)gain, g1 = *(const f32x4*)(gain + 4);
#pragma unroll
      for (int i = 0; i < 4; ++i) { const int q = (tid >> 4) + 32 * i, row = r0 + q;
          const float* src = WSP(float, WS_GV) + (size_t)row * 512 + g * 128 + sc; const f32x4 a = *(const f32x4*)src, b = *(const f32x4*)(src + 4);
          const f32x4 sq = *(const f32x4*)(WSP(float, WS_GVSS) + (size_t)row * 16 + g * 4); const float rs = 1.0f / sqrtf(((sq[0] + sq[1]) + (sq[2] + sq[3])) * (1.f / 128.f) + EPS);
          *(LAS u32x4*)(img + (q >> 6) * V_TILE + v_st(q & 63, sc)) = pack8(a * rs * g0, b * rs * g1); } }
    __syncthreads();
    const int pb = wid & 3, chh = wid >> 2;
    const bf16* Wsg = WSP(bf16, WS_WSP) + ((size_t)(l * 4 + g) * 128 + pb * 32 + r32) * 128 + hi * 8;
    f32x16 acc0 = f32x16{}, acc1 = f32x16{};
    const int vb0 = (int)(uintptr_t)img + v_rd_base(lane);
#pragma unroll
    for (int t = 0; t < 2; ++t) {
        const bf16x8 a0 = *(const bf16x8*)(Wsg + t * 64), a1 = *(const bf16x8*)(Wsg + t * 64 + 16), a2 = *(const bf16x8*)(Wsg + t * 64 + 32), a3 = *(const bf16x8*)(Wsg + t * 64 + 48);
        const int vb = vb0 + t * V_TILE;
        if (chh == 0) { pv_one<0>(acc0, vb, a0, a1, a2, a3); pv_one<1>(acc1, vb, a0, a1, a2, a3); }
        else          { pv_one<2>(acc0, vb, a0, a1, a2, a3); pv_one<3>(acc1, vb, a0, a1, a2, a3); }
    }
    const float* bs = inp<I_BSP>() + (l * 4 + g) * 128 + pb * 32;
    LAS float* mix = (LAS float*)(F.lds + 2 * V_TILE);
#pragma unroll
    for (int r = 0; r < 16; ++r) { const int p = crow(r, hi); const float bias = bs[p]; LAS float* mp = mix + (pb * 32 + p) * 128 + chh * 64 + r32; mp[0] = acc0[r] + bias; mp[32] = acc1[r] + bias; }
    __syncthreads();
    { const int sc = (tid & 15) * 8; const float* up = WSP(float, WS_U) + (size_t)(r0 + (tid >> 4)) * 512 + g * 128 + sc; bf16* hp = WSP(bf16, WS_HEADS) + (size_t)(r0 + (tid >> 4)) * DM + 768 + g * 128 + sc;
#pragma unroll
      for (int i = 0; i < 4; ++i) { const LAS float* mp = mix + ((tid >> 4) + 32 * i) * 128 + sc; const f32x4 m0 = *(const LAS f32x4*)mp, m1 = *(const LAS f32x4*)(mp + 4);
          const f32x4 u0 = *(const f32x4*)up, u1 = *(const f32x4*)(up + 4); *(u32x4*)hp = pack8(u0 * m0, u1 * m1);
          up += 32 * 512; hp += 32 * (size_t)DM; asm volatile("" : "+v"(up), "+v"(hp)); } }
    __syncthreads();
}
#undef SBAR
}

#ifndef MK_SPLIT
#define MK_SPLIT 0
#endif
constexpr int PH_PER_LAYER = 8, PH_FINAL = 2 + PH_PER_LAYER * DEPTH, N_PHASES = PH_FINAL + 1;

__global__ void __launch_bounds__(NTHR, 2) fwd_kernel(Args args) {
    extern __shared__ __attribute__((aligned(16))) unsigned char lds_raw[];
    cg::grid_group grid = cg::this_grid();
    Frame F;
    F.lds = (LAS unsigned char*)lds_raw;
    F.G = gridDim.x; { const int bx = blockIdx.x; F.vcu = (F.G % 8 == 0) ? (bx % 8) * (F.G / 8) + bx / 8 : bx; }
    const Args& A = args;
    F.out = args.out; F.ws = args.ws;
    const int lo = args.ph_lo, hi = args.ph_hi;
#ifndef PH_MASK
#define PH_MASK 0x7ff
#endif
#define PHM(j) (((PH_MASK) >> (j)) & 1)
#define IN(k) (lo <= (k) && (k) < hi)
#define SEAM(k) do { if (IN(k) && IN((k) + 1)) grid.sync(); } while (0)
    const float* ropetab = WSP(float, WS_ROPE);

    if (PHM(0) && IN(0)) { p0_prologue(A, F); } SEAM(0);
    if (PHM(1) && IN(1)) { p0b_modreduce(A, F); } SEAM(1);

    for (int l = 0; l < DEPTH; ++l) {
        const int pb = 2 + PH_PER_LAYER * l; const bool last = (l == DEPTH - 1); const bool first = (l == 0);
        const float* modl = WSP(float, WS_MOD) + (size_t)l * 5 * MODW;
        if (PHM(2) && IN(pb + 0)) { norm_phase(A, F, l, first ? 1 : 0, inp<I_GMIX>() + l * DM, 0, first ? nullptr : WSP(float, WS_SLAB), false); } SEAM(pb + 0);
        if (PHM(3) && IN(pb + 1)) {
            pg8::Gemm g{WSP(bf16, WS_HN), WSP(bf16, WS_WIN) + (size_t)l * NZP * DM, M, NZP, DM, DM}; TileOrder S; S.init(NZP, F.G, (int)blockIdx.x, 0);
            EpiZ E{F.ws, ropetab};
            pg8::gemm_phase<EpiZ, TileOrder, true, true>(F.lds, g, S, E);
        } SEAM(pb + 1);
        if (PHM(4) && IN(pb + 2)) {
            { pg8::Gemm g{WSP(bf16, WS_CKV), WSP(bf16, WS_WUKV) + (size_t)l * NUKV * RANK, M, NUKV, RANK, RANK}; TileOrder S; S.init(NUKV, F.G, (int)blockIdx.x, 0);
              EpiKV E{F.ws}; pg8::gemm_phase<EpiKV, TileOrder, true, true>(F.lds, g, S, E); }
            { pg8::Gemm g{WSP(bf16, WS_CQ), WSP(bf16, WS_WUQ) + (size_t)l * NUQP * RANK, M, NUQP, RANK, RANK}; TileOrder S; S.init(NUQP, F.G, (int)blockIdx.x, last ? 1 : 0);
              EpiQ E{F.ws, ropetab}; pg8::gemm_phase<EpiQ, TileOrder, true, true>(F.lds, g, S, E); }
            for (int un = F.vcu; un < 72 * 4; un += F.G) { const int ch = un >> 2, g = un & 3; if (last && (ch % 18) < 2) continue; att::gate_unit(A, F, l, ch, g); }
        } SEAM(pb + 2);
        if (PHM(5) && IN(pb + 3)) { att::attn_phase(A, F, l, !last); } SEAM(pb + 3);
        if (PHM(6) && IN(pb + 4)) {
            { pg8::Gemm g{WSP(bf16, WS_HEADS), WSP(bf16, WS_WOUT) + (size_t)l * DM * DM, M, DM, DM, DM}; TileOrder S; S.init(DM, F.G, (int)blockIdx.x, 1);
              EpiResid E{F.ws, inp<I_X>(), inp<I_CTX>(), modl + 2 * DM, first};
              pg8::gemm_phase<EpiResid, TileOrder, true, true>(F.lds, g, S, E); }
            if (!last) {
              pg8::Gemm g{WSP(bf16, WS_HEADS), WSP(bf16, WS_WOUT) + (size_t)l * DM * DM, M, DM, DM / 8, DM}; TileOrder S; S.init(DM, F.G, (int)blockIdx.x, 3, 8, DM / 8);
              EpiSlab E{WSP(float, WS_SLAB), modl + 4 * MODW + 2 * DM};
              pg8::gemm_phase<EpiSlab, TileOrder, true, true>(F.lds, g, S, E); }
        } SEAM(pb + 4);
        if (PHM(7) && IN(pb + 5)) { norm_phase(A, F, l, first ? 2 : 0, inp<I_GMLP>() + l * DM, 3 * DM, last ? nullptr : WSP(float, WS_SLAB), last); } SEAM(pb + 5);
        if (PHM(8) && IN(pb + 6)) {
            pg8::Gemm g{WSP(bf16, WS_HN), WSP(bf16, WS_WFC1) + (size_t)l * FF * DM, M, FF, DM, DM}; TileOrder S; S.init(FF, F.G, (int)blockIdx.x, last ? 1 : 0);
            EpiFc1 E{F.ws};
            pg8::gemm_phase<EpiFc1, TileOrder, true, true>(F.lds, g, S, E);
        } SEAM(pb + 6);
        if (PHM(9) && IN(pb + 7)) {
            { pg8::Gemm g{WSP(bf16, WS_ACT), WSP(bf16, WS_WFC2) + (size_t)l * DM * FF, M, DM, FF, FF}; TileOrder S; S.init(DM, F.G, (int)blockIdx.x, 1);
              EpiResid E{F.ws, inp<I_X>(), inp<I_CTX>(), modl + 5 * DM, false};
              pg8::gemm_phase<EpiResid, TileOrder, true, true>(F.lds, g, S, E); }
            if (!last) {
              pg8::Gemm g{WSP(bf16, WS_ACT), WSP(bf16, WS_WFC2) + (size_t)l * DM * FF, M, DM, FF / 8, FF}; TileOrder S; S.init(DM, F.G, (int)blockIdx.x, 3, 8, FF / 8);
              EpiSlab E{WSP(float, WS_SLAB), modl + 4 * MODW + 5 * DM};
              pg8::gemm_phase<EpiSlab, TileOrder, true, true>(F.lds, g, S, E); }
        } SEAM(pb + 7);
    }
    if (PHM(10) && IN(PH_FINAL)) { final_norm_phase(A, F); }
#undef IN
#undef SEAM
}

extern "C" void kernel_launch(void* const* d_in, const int* in_sizes, int n_in, void* d_out, int out_size, void* d_ws, size_t ws_size, hipStream_t stream) {
    static int grid = 0;
    if (grid == 0) {
        if (n_in != N_IN || ws_size < WS_END || out_size != NB * SEQ * DM) { fprintf(stderr, "kernel_launch: unexpected shapes: n_in %d ws %zu (need %zu) out %d\n", n_in, ws_size, (size_t)WS_END, out_size); grid = -1; return; }
        int dev = 0, cus = 0, per_cu = 0;
        if (hipGetDevice(&dev) != hipSuccess || hipDeviceGetAttribute(&cus, hipDeviceAttributeMultiprocessorCount, dev) != hipSuccess) { fprintf(stderr, "kernel_launch: device query failed\n"); grid = -1; return; }
        if (hipFuncSetAttribute((const void*)fwd_kernel, hipFuncAttributeMaxDynamicSharedMemorySize, LDS_BYTES) != hipSuccess) { fprintf(stderr, "kernel_launch: hipFuncSetAttribute failed\n"); grid = -1; return; }
        if (hipOccupancyMaxActiveBlocksPerMultiprocessor(&per_cu, (const void*)fwd_kernel, NTHR, LDS_BYTES) != hipSuccess || per_cu < 1) { fprintf(stderr, "kernel_launch: occupancy query says %d blocks/CU\n", per_cu); (void)hipGetLastError(); per_cu = 1; }
        grid = cus * per_cu; if (grid > 256) grid = 256;
        grid -= grid % 8;
        fprintf(stderr, "kernel_launch: cus %d per_cu %d grid %d\n", cus, per_cu, grid);
    }
    if (grid <= 0) return;
    Args a{};
    for (int i = 0; i < N_IN; ++i) a.in[i] = (const float*)d_in[i];
    a.out = (float*)d_out; a.ws = (unsigned char*)d_ws;
#if MK_SPLIT
    for (int p = 0; p < N_PHASES; ++p) {
        a.ph_lo = p; a.ph_hi = p + 1; void* kargs[] = {&a};
        hipError_t e = hipLaunchCooperativeKernel((const void*)fwd_kernel, dim3(grid), dim3(NTHR), kargs, LDS_BYTES, stream);
        if (e != hipSuccess) { fprintf(stderr, "kernel_launch: launch of phase %d failed: %s\n", p, hipGetErrorString(e)); break; }
    }
#else
    a.ph_lo = 0; a.ph_hi = N_PHASES; void* kargs[] = {&a};
    hipError_t e = hipLaunchCooperativeKernel((const void*)fwd_kernel, dim3(grid), dim3(NTHR), kargs, LDS_BYTES, stream);
    if (e != hipSuccess) fprintf(stderr, "kernel_launch: cooperative launch failed: %s (grid %d)\n", hipGetErrorString(e), grid);
#endif
}
```

```cpp
#include <hip/hip_runtime.h>
#include <hip/hip_cooperative_groups.h>
#include <cstdio>
#include <cstdint>
namespace cg = cooperative_groups;
namespace pg8 {
#define PG8_LAS __attribute__((address_space(3)))
typedef unsigned short bf16_t;
typedef short bf16x8 __attribute__((ext_vector_type(8)));
typedef float f32x4 __attribute__((ext_vector_type(4)));
typedef unsigned u32x4 __attribute__((ext_vector_type(4)));
constexpr int BM = 256, BK = 64, HALF = 128, HTB = HALF * BK * 2  , STAGE_BYTES = 8 * HTB, NXCD = 8, WGM = 8;

__host__ __device__ __forceinline__ int lds_byte(int r, int c) { const int st = (r >> 4) * 2 + (c >> 5), rr = r & 15, cc = c & 31, ob = rr * 64 + cc * 2; return st * 1024 + (ob ^ (((ob >> 9) & 1) << 5)); }
__host__ __device__ __forceinline__ void stage_rc(int b, int& R, int& C) { const int st = b / 1024, sb = b % 1024, swz = sb ^ (((sb >> 9) & 1) << 5); R = (st >> 1) * 16 + swz / 64; C = (st & 1) * 32 + (swz % 64) / 2; }
__host__ __device__ __forceinline__ int perm32(int rho) { const int n = rho >> 4, i = rho & 15; return 8 * (i >> 2) + 4 * n + (i & 3); }

struct Unit { int pm, pn, k0, ks; };
struct Gemm { const bf16_t* A; const bf16_t* Bt; int M, N, K, ld; };

__device__ __forceinline__ unsigned cvt_pk_bf16(float lo, float hi) { unsigned r; asm volatile("v_cvt_pk_bf16_f32 %0, %1, %2" : "=v"(r) : "v"(lo), "v"(hi)); return r; }
typedef float f32x2 __attribute__((ext_vector_type(2)));
__device__ __forceinline__ f32x2 gelu_pk(f32x2 v) {
    const f32x2 av = __builtin_elementwise_abs(v), d = av * 0.2316418882f + 1.0f;
    f32x2 t; t.x = __builtin_amdgcn_rcpf(d.x); t.y = __builtin_amdgcn_rcpf(d.y);
    f32x2 q = t * 0.5307027145f + (-0.7265760135f); q = q * t + 0.7107068705f; q = q * t + (-0.142248368f); q = q * t + 0.127414796f; q = q * t;
    const f32x2 s = (v * v) * (-0.72134752044f);
    f32x2 e; e.x = __builtin_amdgcn_exp2f(s.x); e.y = __builtin_amdgcn_exp2f(s.y);
    const f32x2 m = v * (q * e), r = v - m;
    f32x2 o; o.x = v.x < 0.f ? m.x : r.x; o.y = v.y < 0.f ? m.y : r.y; return o;
}
template <class Epi, class Sched, bool ALIGN_EPI = false, bool SP2 = false>
__device__ __forceinline__ void gemm_phase(PG8_LAS unsigned char* lds, const Gemm g, const Sched& S, const Epi& E) {
    int tid_ = threadIdx.x; asm volatile("" : "+v"(tid_)); const int tid = tid_, wid = __builtin_amdgcn_readfirstlane(tid >> 6), lane = tid & 63, wr = wid >> 2, wc = wid & 3, fr = lane & 15, fq = lane >> 4;
    const int K = g.K, nt = K / BK;
    unsigned voffA[2], voffB[2];
#pragma unroll
    for (int i = 0; i < 2; ++i) { int R, C; stage_rc(tid * 16 + i * 8192, R, C); const int Rb = Epi::PERM ? ((R & ~31) + perm32(R & 31)) : R;
        voffA[i] = (unsigned)(R * g.ld + C) * 2u; voffB[i] = (unsigned)(Rb * g.ld + C) * 2u; }
    const size_t kstep = (size_t)(BK * 2);
    const size_t hstep = (size_t)HALF * g.ld * 2;
    const size_t tstep = 2 * hstep;
    const unsigned ldsw = (unsigned)wid * 1024u;
    const int aoff = lds_byte(wr * 64 + fr, fq * 8), boff = lds_byte(wc * 32 + fr, fq * 8);
#define PG8_SA(b, h) (((b) * 2 + (h)) * HTB)
#define PG8_SB(b, h) ((4 + (b) * 2 + (h)) * HTB)
#define PG8_STAGE(bufoff, gbase, voff) do { _Pragma("unroll") for (int _i = 0; _i < 2; ++_i) \
        __builtin_amdgcn_global_load_lds((const unsigned*)((const char*)(gbase) + (voff)[_i]), (PG8_LAS unsigned*)(lds + (bufoff) + ldsw + _i * 8192), 16, 0, 0); } while (0)
#define PG8_LDA(dst, b, h) do { _Pragma("unroll") for (int m = 0; m < 4; ++m) _Pragma("unroll") for (int k = 0; k < 2; ++k) dst[m][k] = *(const PG8_LAS bf16x8*)(lds + PG8_SA(b, h) + aoff + m * 2048 + k * 1024); } while (0)
#define PG8_LDB(dst, b, h) do { _Pragma("unroll") for (int n = 0; n < 2; ++n) _Pragma("unroll") for (int k = 0; k < 2; ++k) dst[n][k] = *(const PG8_LAS bf16x8*)(lds + PG8_SB(b, h) + boff + n * 2048 + k * 1024); } while (0)
#define PG8_MMA(ai, bj, At, Bt) do { __builtin_amdgcn_s_setprio(1); _Pragma("unroll") for (int m = 0; m < 4; ++m) _Pragma("unroll") for (int n = 0; n < 2; ++n) _Pragma("unroll") for (int k = 0; k < 2; ++k) \
        acc[ai][bj][m][n] = __builtin_amdgcn_mfma_f32_16x16x32_bf16(Bt[n][k], At[m][k], acc[ai][bj][m][n], 0, 0, 0); __builtin_amdgcn_s_setprio(0); } while (0)
#define PG8_WAIT_V(n) asm volatile("s_waitcnt vmcnt(" #n ")" ::: "memory")
#define PG8_WAIT_L(n) asm volatile("s_waitcnt lgkmcnt(" #n ")" ::: "memory")
#define PG8_BAR __builtin_amdgcn_s_barrier()
#define PG8_SCHED __builtin_amdgcn_sched_barrier(0)
    Unit cur, nxt; int ui = 0;
    if (!S.next(0, cur)) return;
    f32x4 acc[2][2][4][2];
#pragma unroll
    for (int a = 0; a < 2; ++a)
#pragma unroll
        for (int b = 0; b < 2; ++b)
#pragma unroll
            for (int m = 0; m < 4; ++m)
#pragma unroll
                for (int n = 0; n < 2; ++n) acc[a][b][m][n] = (f32x4){0.f, 0.f, 0.f, 0.f};
    bf16x8 At[4][2], B0[2][2], B1[2][2];
    const char* cA = (const char*)g.A + (size_t)cur.pm * tstep + (size_t)cur.k0 * 2; const char* cB = (const char*)g.Bt + (size_t)cur.pn * tstep + (size_t)cur.k0 * 2;
    S.a_ready(cur);
    if constexpr (SP2) {
        PG8_STAGE(PG8_SB(0, 0), cB, voffB); PG8_STAGE(PG8_SB(0, 1), cB + hstep, voffB); PG8_STAGE(PG8_SA(0, 0), cA, voffA); PG8_STAGE(PG8_SA(0, 1), cA + hstep, voffA);
        if (wr == 1) PG8_BAR;
        PG8_WAIT_V(2); PG8_BAR;
        PG8_STAGE(PG8_SB(1, 0), cB + kstep, voffB); PG8_STAGE(PG8_SA(1, 0), cA + kstep, voffA); PG8_STAGE(PG8_SB(1, 1), cB + hstep + kstep, voffB);
        PG8_WAIT_V(6); PG8_BAR;
    } else {
        PG8_STAGE(PG8_SB(0, 0), cB, voffB); PG8_STAGE(PG8_SA(0, 0), cA, voffA); PG8_STAGE(PG8_SB(0, 1), cB + hstep, voffB); PG8_STAGE(PG8_SA(0, 1), cA + hstep, voffA);
        if (wr == 1) PG8_BAR;
        PG8_WAIT_V(4); PG8_BAR;
        PG8_STAGE(PG8_SB(1, 0), cB + kstep, voffB); PG8_STAGE(PG8_SA(1, 0), cA + kstep, voffA); PG8_STAGE(PG8_SB(1, 1), cB + hstep + kstep, voffB);
        PG8_WAIT_V(6); PG8_BAR;
    }
    for (;;) {
        const bool has_next = S.next(ui + 1, nxt);
        const char* nA = has_next ? (const char*)g.A + (size_t)nxt.pm * tstep + (size_t)nxt.k0 * 2 : cA; const char* nB = has_next ? (const char*)g.Bt + (size_t)nxt.pn * tstep + (size_t)nxt.k0 * 2 : cB;
        for (int t = 0; t < nt; t += 2) {
            const bool last = (t == nt - 2);
            const char* a1 = cA + (size_t)(t + 1) * kstep;
            const char* a2 = last ? nA : cA + (size_t)(t + 2) * kstep; const char* b2 = last ? nB : cB + (size_t)(t + 2) * kstep;
            const char* a3 = a2 + kstep; const char* b3 = b2 + kstep;
            if (last && has_next) S.a_ready(nxt);
            if constexpr (SP2) {
            PG8_LDB(B0, 0, 0); PG8_LDB(B1, 0, 1); PG8_SCHED; PG8_LDA(At, 0, 0); PG8_STAGE(PG8_SA(1, 1), a1 + hstep, voffA);
            PG8_WAIT_V(8); PG8_WAIT_L(0); PG8_BAR; PG8_MMA(0, 0, At, B0); PG8_MMA(0, 1, At, B1); PG8_BAR; PG8_SCHED;
            PG8_LDA(At, 0, 1); PG8_STAGE(PG8_SB(0, 0), b2, voffB); PG8_STAGE(PG8_SB(0, 1), b2 + hstep, voffB); PG8_STAGE(PG8_SA(0, 0), a2, voffA);
            PG8_WAIT_V(8); PG8_WAIT_L(0); PG8_BAR; PG8_MMA(1, 0, At, B0); PG8_MMA(1, 1, At, B1); PG8_BAR; PG8_SCHED;
            PG8_LDB(B0, 1, 0); PG8_LDB(B1, 1, 1); PG8_SCHED; PG8_LDA(At, 1, 0); PG8_STAGE(PG8_SA(0, 1), a2 + hstep, voffA);
            PG8_WAIT_V(8); PG8_WAIT_L(0); PG8_BAR; PG8_MMA(0, 0, At, B0); PG8_MMA(0, 1, At, B1); PG8_BAR; PG8_SCHED;
            PG8_LDA(At, 1, 1); PG8_STAGE(PG8_SB(1, 0), b3, voffB); PG8_STAGE(PG8_SB(1, 1), b3 + hstep, voffB); PG8_STAGE(PG8_SA(1, 0), a3, voffA);
            PG8_WAIT_V(8); PG8_WAIT_L(0); PG8_BAR; PG8_MMA(1, 0, At, B0); PG8_MMA(1, 1, At, B1); PG8_BAR; PG8_SCHED;
            } else {
            PG8_LDB(B0, 0, 0); PG8_SCHED; PG8_LDA(At, 0, 0); PG8_STAGE(PG8_SA(1, 1), a1 + hstep, voffA);
            PG8_WAIT_L(8); PG8_BAR; PG8_WAIT_L(0); PG8_MMA(0, 0, At, B0); PG8_BAR; PG8_SCHED;
            PG8_LDB(B1, 0, 1); PG8_STAGE(PG8_SB(0, 0), b2, voffB);
            PG8_BAR; PG8_WAIT_L(0); PG8_MMA(0, 1, At, B1); PG8_BAR;
            PG8_LDA(At, 0, 1); PG8_STAGE(PG8_SA(0, 0), a2, voffA);
            PG8_BAR; PG8_WAIT_L(0); PG8_MMA(1, 0, At, B0); PG8_BAR; PG8_SCHED;
            PG8_STAGE(PG8_SB(0, 1), b2 + hstep, voffB);
            PG8_WAIT_V(6); PG8_BAR; PG8_MMA(1, 1, At, B1); PG8_BAR;
            PG8_LDB(B0, 1, 0); PG8_SCHED; PG8_LDA(At, 1, 0); PG8_STAGE(PG8_SA(0, 1), a2 + hstep, voffA);
            PG8_WAIT_L(8); PG8_BAR; PG8_WAIT_L(0); PG8_MMA(0, 0, At, B0); PG8_BAR; PG8_SCHED;
            PG8_LDB(B1, 1, 1); PG8_STAGE(PG8_SB(1, 0), b3, voffB);
            PG8_BAR; PG8_WAIT_L(0); PG8_MMA(0, 1, At, B1); PG8_BAR;
            PG8_LDA(At, 1, 1); PG8_STAGE(PG8_SA(1, 0), a3, voffA);
            PG8_BAR; PG8_WAIT_L(0); PG8_MMA(1, 0, At, B0); PG8_BAR; PG8_SCHED;
            PG8_STAGE(PG8_SB(1, 1), b3 + hstep, voffB);
            PG8_WAIT_V(6); PG8_BAR; PG8_MMA(1, 1, At, B1); PG8_BAR;
            }
        }
        if constexpr (ALIGN_EPI) { if (wr == 0) PG8_BAR; }
        if constexpr (!Epi::AFTER_DRAIN) { E(acc, cur, wr, wc, fr, fq); S.done(cur); }
        if (!has_next) break;
#pragma unroll
        for (int a = 0; a < 2; ++a)
#pragma unroll
            for (int b = 0; b < 2; ++b)
#pragma unroll
                for (int m = 0; m < 4; ++m)
#pragma unroll
                    for (int n = 0; n < 2; ++n) acc[a][b][m][n] = (f32x4){0.f, 0.f, 0.f, 0.f};
        cur = nxt; cA = nA; cB = nB; ++ui;
        if constexpr (ALIGN_EPI) { if (wr == 1) PG8_BAR; }
    }
    PG8_WAIT_V(0);
    if constexpr (!ALIGN_EPI) { if (wr == 0) PG8_BAR; }
    PG8_BAR;
    if constexpr (Epi::AFTER_DRAIN) { E.fused(acc, cur, wr, wc, fr, fq, lds, wid, lane); S.done(cur); }
#undef PG8_SA
#undef PG8_SB
#undef PG8_STAGE
#undef PG8_LDA
#undef PG8_LDB
#undef PG8_MMA
#undef PG8_WAIT_V
#undef PG8_WAIT_L
#undef PG8_BAR
#undef PG8_SCHED
}
}

#define GAS __attribute__((address_space(1)))
#define LAS __attribute__((address_space(3)))
typedef unsigned short bf16;
typedef float f32x4 __attribute__((ext_vector_type(4)));
typedef float f32x2 __attribute__((ext_vector_type(2)));
typedef float f32x16 __attribute__((ext_vector_type(16)));
typedef short bf16x8 __attribute__((ext_vector_type(8)));
typedef short s16x4 __attribute__((ext_vector_type(4)));
typedef unsigned u32x4 __attribute__((ext_vector_type(4)));
typedef unsigned u32x2 __attribute__((ext_vector_type(2)));

constexpr int NB = 4, SEQ = 2048, CTX = 256, DM = 2048, DEPTH = 2, FF = 8192;
constexpr int TOK = CTX + SEQ;
constexpr int M = NB * TOK;
constexpr int NZ = 4416, NZP = 4608;
constexpr int NUQ = 1152, NUQP = 1280, NUKV = 1536, RANK = 512;
constexpr int MODW = 6 * DM;
constexpr float EPS = 1e-6f;
constexpr float LOG2E = 1.4426950408889634f;
constexpr float DA_QS = 0.125f * LOG2E;
constexpr float MLA_QS = 0.07216878364870322f * LOG2E;
constexpr int NWAVES = 8, NTHR = 512;

enum { I_X = 0, I_C, I_CTX, I_CCTX, I_WMOD, I_BMOD, I_GMIX, I_GMLP, I_WIN, I_LQ1, I_LK1, I_LQ2, I_LK2, I_GDASUB, I_GGMV, I_WSP, I_BSP,
       I_GMQ, I_WUQ, I_GMKV, I_WUKV, I_WOUT, I_WFC1, I_WFC2, I_GFINAL, N_IN };

constexpr size_t al256(size_t x) { return (x + 255) / 256 * 256; }
constexpr size_t WS_ROPE  = 0;
constexpr size_t WS_SCAL  = WS_ROPE + 8192;
constexpr size_t WS_BAR   = WS_SCAL + 256;
constexpr size_t WS_MOD   = WS_BAR + 16384;
constexpr size_t WS_MODP  = al256(WS_MOD + (size_t)DEPTH * 5 * MODW * 4);
constexpr size_t WS_WIN   = al256(WS_MODP + (size_t)DEPTH * 32 * 5 * MODW * 4);
constexpr size_t WS_WOUT  = al256(WS_WIN + (size_t)DEPTH * NZP * DM * 2);
constexpr size_t WS_WFC1  = al256(WS_WOUT + (size_t)DEPTH * DM * DM * 2);
constexpr size_t WS_WFC2  = al256(WS_WFC1 + (size_t)DEPTH * FF * DM * 2);
constexpr size_t WS_WUQ   = al256(WS_WFC2 + (size_t)DEPTH * DM * FF * 2);
constexpr size_t WS_WUKV  = al256(WS_WUQ + (size_t)DEPTH * NUQP * RANK * 2);
constexpr size_t WS_WSP   = al256(WS_WUKV + (size_t)DEPTH * NUKV * RANK * 2);
constexpr size_t WS_XW    = al256(WS_WSP + (size_t)DEPTH * 4 * 128 * 128 * 2);
constexpr size_t WS_HN    = al256(WS_XW + (size_t)M * DM * 4);
constexpr size_t WS_QDA   = al256(WS_HN + (size_t)M * DM * 2);
constexpr size_t WS_KDA   = al256(WS_QDA + (size_t)M * 768 * 2);
constexpr size_t WS_VDA   = al256(WS_KDA + (size_t)M * 768 * 2);
constexpr size_t WS_U     = al256(WS_VDA + (size_t)M * 768 * 2);
constexpr size_t WS_GV    = al256(WS_U + (size_t)M * 512 * 4);
constexpr size_t WS_GVSS  = al256(WS_GV + (size_t)M * 512 * 4);
constexpr size_t WS_CQSS  = al256(WS_GVSS + (size_t)M * 16 * 4);
constexpr size_t WS_CKVSS = al256(WS_CQSS + (size_t)M * 8 * 4);
constexpr size_t WS_CQ    = al256(WS_CKVSS + (size_t)M * 8 * 4);
constexpr size_t WS_CKV   = al256(WS_CQ + (size_t)M * 512 * 2);
constexpr size_t WS_KMLA  = al256(WS_CKV + (size_t)M * 512 * 2);
constexpr size_t WS_VMLA  = al256(WS_KMLA + (size_t)M * 1152 * 2);
constexpr size_t WS_QMLA  = al256(WS_VMLA + (size_t)M * 768 * 2);
constexpr size_t WS_HEADS = al256(WS_QMLA + (size_t)M * 1152 * 2);
constexpr size_t WS_ACT   = al256(WS_HEADS + (size_t)M * DM * 2);
constexpr size_t WS_STASH = al256(WS_ACT + (size_t)M * FF * 2);
constexpr size_t WS_SLAB  = al256(WS_STASH + (size_t)256 * 64 * 512 * 4);
constexpr size_t WS_END   = al256(WS_SLAB + (size_t)8 * 1024 * DM * 4);

constexpr int LDS_BYTES = 131072 + 1024;

__device__ __forceinline__ unsigned cvtpk(float lo, float hi) { unsigned r; asm volatile("v_cvt_pk_bf16_f32 %0, %1, %2" : "=v"(r) : "v"(lo), "v"(hi)); return r; }
__device__ __forceinline__ u32x4 pack8(f32x4 a, f32x4 b) { u32x4 w; w.x = cvtpk(a[0], a[1]); w.y = cvtpk(a[2], a[3]); w.z = cvtpk(b[0], b[1]); w.w = cvtpk(b[2], b[3]); return w; }
__device__ __forceinline__ float wave_sum(float v) {
#pragma unroll
    for (int o = 1; o < 64; o <<= 1) v += __shfl_xor(v, o);
    return v;
}
__device__ __forceinline__ float bf2f(unsigned short h) { return __uint_as_float(((unsigned)h) << 16); }

struct Args { const float* in[N_IN]; float* out; unsigned char* ws; int ph_lo, ph_hi; };
struct Frame {
    LAS unsigned char* lds;
    int G, vcu;
    float* out; unsigned char* ws;
};
#define WSP(T, off) ((T*)(F.ws + (off)))
template <int I> __device__ __forceinline__ const float* inp() {
    unsigned long long p; asm volatile("s_load_dwordx2 %0, %1, %2\n\ts_waitcnt lgkmcnt(0)" : "=s"(p) : "s"(__builtin_amdgcn_kernarg_segment_ptr()), "n"(I * 8) : "memory"); return (const float*)p; }

__device__ __forceinline__ const float* xrow_in(const Args& A, const Frame& F, int row) {
    const int b = row / TOK, rr = row - b * TOK;
    return rr < CTX ? inp<I_CTX>() + (size_t)(b * CTX + rr) * DM : inp<I_X>() + (size_t)(b * SEQ + rr - CTX) * DM;
}

__device__ __forceinline__ void p0_transpose_item(const float* W, int K, int N, bf16* WT, const float* kscale, LAS float* scr, int item, int lane) {
    const int nblk = N / 32, kb = item / nblk, nb = item % nblk, k0 = 64 * kb, n0 = 32 * nb;
    { const int r8 = lane >> 3, c4 = (lane & 7) * 4; f32x4 v[8];
#pragma unroll
      for (int i = 0; i < 8; ++i) v[i] = *(const f32x4*)(W + (size_t)(k0 + r8 + 8 * i) * N + n0 + c4);
#pragma unroll
      for (int i = 0; i < 8; ++i) { const int kk = r8 + 8 * i; const float s = kscale ? kscale[k0 + kk] : 1.f; LAS float* d = scr + kk * 33 + c4;
          d[0] = v[i][0] * s; d[1] = v[i][1] * s; d[2] = v[i][2] * s; d[3] = v[i][3] * s; } }
    asm volatile("s_waitcnt lgkmcnt(0)" ::: "memory");
    const int c = lane & 7;
#pragma unroll
    for (int j = 0; j < 4; ++j) { const int n = (lane >> 3) + 8 * j; const LAS float* s = scr + (8 * c) * 33 + n;
        u32x4 o; o.x = cvtpk(s[0 * 33], s[1 * 33]); o.y = cvtpk(s[2 * 33], s[3 * 33]); o.z = cvtpk(s[4 * 33], s[5 * 33]); o.w = cvtpk(s[6 * 33], s[7 * 33]);
        *(u32x4*)(WT + (size_t)(n0 + n) * K + k0 + 8 * c) = o; }
    asm volatile("s_waitcnt lgkmcnt(0)" ::: "memory");
}
__device__ __forceinline__ float silu_f(float x) { return x / (1.f + __expf(-x)); }

__device__ __forceinline__ void p0_mod_item(const Args& A, const Frame& F, LAS float* scr, int item, int lane) {
    const int l = item / (32 * 48), r = item % (32 * 48), kc = r / 48, nc = r % 48;
    const int k = kc * 64 + lane;
#pragma unroll
    for (int bb = 0; bb < 5; ++bb) { const float cv = bb < 4 ? inp<I_C>()[bb * DM + k] : inp<I_CCTX>()[k]; scr[bb * 64 + lane] = silu_f(cv); }
    asm volatile("s_waitcnt lgkmcnt(0)" ::: "memory");
    const float* W = inp<I_WMOD>() + ((size_t)l * DM + kc * 64) * MODW + nc * 256 + lane * 4;
    f32x4 acc[5];
#pragma unroll
    for (int bb = 0; bb < 5; ++bb) acc[bb] = (f32x4){0.f, 0.f, 0.f, 0.f};
#pragma unroll 8
    for (int kk = 0; kk < 64; ++kk) { const f32x4 w = *(const f32x4*)(W + (size_t)kk * MODW);
#pragma unroll
        for (int bb = 0; bb < 5; ++bb) acc[bb] += w * scr[bb * 64 + kk]; }
    float* P = WSP(float, WS_MODP) + ((size_t)(l * 32 + kc) * 5) * MODW + nc * 256 + lane * 4;
#pragma unroll
    for (int bb = 0; bb < 5; ++bb) *(f32x4*)(P + (size_t)bb * MODW) = acc[bb];
    asm volatile("s_waitcnt lgkmcnt(0)" ::: "memory");
}

__device__ __forceinline__ void p0_prologue(const Args& A, const Frame& F) {
    int tid_ = threadIdx.x; asm volatile("" : "+v"(tid_)); const int ptid = tid_, plane = ptid & 63, pwave = __builtin_amdgcn_readfirstlane(ptid >> 6);
    LAS float* scr = (LAS float*)(F.lds + pwave * 16384);
    const int gw = F.vcu * NWAVES + pwave, NGW = F.G * NWAVES;
    constexpr int I_MOD = DEPTH * 32 * 48;
    constexpr int T_IN = (DM / 64) * (NZ / 32), T_OUT = (DM / 64) * (DM / 32), T_FC1 = (DM / 64) * (FF / 32), T_FC2 = (FF / 64) * (DM / 32), T_UQ = (RANK / 64) * (NUQ / 32), T_UKV = (RANK / 64) * (NUKV / 32);
    constexpr int T_L = T_IN + T_OUT + T_FC1 + T_FC2 + T_UQ + T_UKV;
    constexpr int NITEMS = I_MOD + DEPTH * T_L;
    for (int it = gw; it < NITEMS; it += NGW) {
        if (it < I_MOD) { p0_mod_item(A, F, scr, it, plane); continue; }
        int r = it - I_MOD; const int l = r / T_L; r -= l * T_L;
        if (r < T_IN)  { p0_transpose_item(inp<I_WIN>() + (size_t)l * DM * NZ, DM, NZ, WSP(bf16, WS_WIN) + (size_t)l * NZP * DM, nullptr, scr, r, plane); continue; } r -= T_IN;
        if (r < T_OUT) { p0_transpose_item(inp<I_WOUT>() + (size_t)l * DM * DM, DM, DM, WSP(bf16, WS_WOUT) + (size_t)l * DM * DM, nullptr, scr, r, plane); continue; } r -= T_OUT;
        if (r < T_FC1) { p0_transpose_item(inp<I_WFC1>() + (size_t)l * DM * FF, DM, FF, WSP(bf16, WS_WFC1) + (size_t)l * FF * DM, nullptr, scr, r, plane); continue; } r -= T_FC1;
        if (r < T_FC2) { p0_transpose_item(inp<I_WFC2>() + (size_t)l * FF * DM, FF, DM, WSP(bf16, WS_WFC2) + (size_t)l * DM * FF, nullptr, scr, r, plane); continue; } r -= T_FC2;
        if (r < T_UQ)  { p0_transpose_item(inp<I_WUQ>() + (size_t)l * RANK * NUQ, RANK, NUQ, WSP(bf16, WS_WUQ) + (size_t)l * NUQP * RANK, inp<I_GMQ>() + l * RANK, scr, r, plane); continue; } r -= T_UQ;
        p0_transpose_item(inp<I_WUKV>() + (size_t)l * RANK * NUKV, RANK, NUKV, WSP(bf16, WS_WUKV) + (size_t)l * NUKV * RANK, inp<I_GMKV>() + l * RANK, scr, r, plane);
    }
    const int gt = F.vcu * NTHR + ptid, NGT = F.G * NTHR;
    for (int i = gt; i < DEPTH * (NZP - NZ) * DM / 8; i += NGT) { const int l = i / ((NZP - NZ) * DM / 8), r = i % ((NZP - NZ) * DM / 8);
        *(u32x4*)(WSP(bf16, WS_WIN) + ((size_t)l * NZP + NZ) * DM + (size_t)r * 8) = (u32x4){0u, 0u, 0u, 0u}; }
    for (int i = gt; i < DEPTH * (NUQP - NUQ) * RANK / 8; i += NGT) { const int l = i / ((NUQP - NUQ) * RANK / 8), r = i % ((NUQP - NUQ) * RANK / 8);
        *(u32x4*)(WSP(bf16, WS_WUQ) + ((size_t)l * NUQP + NUQ) * RANK + (size_t)r * 8) = (u32x4){0u, 0u, 0u, 0u}; }
    for (int i = gt; i < DEPTH * 4 * 128 * 128 / 8; i += NGT) { const f32x4 a = *(const f32x4*)(inp<I_WSP>() + (size_t)i * 8), b = *(const f32x4*)(inp<I_WSP>() + (size_t)i * 8 + 4);
        *(u32x4*)(WSP(bf16, WS_WSP) + (size_t)i * 8) = pack8(a, b); }
    if (gt < 64 * 16) { const int pos = gt >> 4, f = gt & 15; const float inv = powf(10000.0f, -(float)f / 16.0f); const float ang = (float)pos * inv;
        WSP(float, WS_ROPE)[gt] = cosf(ang); WSP(float, WS_ROPE)[1024 + gt] = sinf(ang); }
    if (gt < 64 * DEPTH) {
        const int l = gt >> 6; const float a = inp<I_LQ1>()[l * 64 + plane] * inp<I_LK1>()[l * 64 + plane], b = inp<I_LQ2>()[l * 64 + plane] * inp<I_LK2>()[l * 64 + plane];
        const float sa = wave_sum(a), sb = wave_sum(b); const float lam_init = 0.8f - 0.6f * expf(-0.3f * (float)l);
        if (plane == 0) WSP(float, WS_SCAL)[l] = expf(sa) - expf(sb) + lam_init;
    }
}
__device__ __forceinline__ void p0b_modreduce(const Args& A, const Frame& F) {
    int tid_ = threadIdx.x; asm volatile("" : "+v"(tid_)); const int ptid = tid_, plane = ptid & 63, pwave = __builtin_amdgcn_readfirstlane(ptid >> 6);
    const int gt = F.vcu * NTHR + ptid, NGT = F.G * NTHR;
    for (int i = gt; i < DEPTH * 5 * MODW; i += NGT) { const int l = i / (5 * MODW), r = i % (5 * MODW), n = r % MODW;
        float s = inp<I_BMOD>()[l * MODW + n]; const float* P = WSP(float, WS_MODP) + (size_t)l * 32 * 5 * MODW + r;
#pragma unroll 8
        for (int kc = 0; kc < 32; ++kc) s += P[(size_t)kc * 5 * MODW];
        WSP(float, WS_MOD)[i] = s; }
}

__device__ __forceinline__ void norm_phase(const Args& A, const Frame& F, int l, int src_mode, const float* g, int shoff, const float* slab, bool skip_ctx) {
    int tid_ = threadIdx.x; asm volatile("" : "+v"(tid_)); const int ptid = tid_, plane = ptid & 63, pwave = __builtin_amdgcn_readfirstlane(ptid >> 6);
    const int gw = F.vcu * NWAVES + pwave, NGW = F.G * NWAVES;
    for (int row = gw; row < M; row += NGW) {
        const int b = row / TOK, rr = row - b * TOK; const bool isctx = rr < CTX; const int bsel = isctx ? 4 : b;
        if (isctx && skip_ctx) continue;
        const bool from_in = src_mode == 1 || (src_mode == 2 && isctx);
        const float* xr = from_in ? xrow_in(A, F, row) : WSP(float, WS_XW) + (size_t)row * DM;
        const float* md = WSP(float, WS_MOD) + ((size_t)l * 5 + bsel) * MODW + shoff;
        f32x4 v[8]; float s = 0.f;
#pragma unroll
        for (int j = 0; j < 8; ++j) v[j] = *(const f32x4*)(xr + 4 * plane + 256 * j);
        if (isctx && slab) {
            const float* sp = slab + (size_t)(b * CTX + rr) * DM + 4 * plane;
            for (int ks = 0; ks < 8; ++ks) {
#pragma unroll
                for (int j = 0; j < 8; ++j) v[j] += *(const f32x4*)(sp + (size_t)ks * 1024 * DM + 256 * j); }
            float* xo = WSP(float, WS_XW) + (size_t)row * DM + 4 * plane;
#pragma unroll
            for (int j = 0; j < 8; ++j) *(f32x4*)(xo + 256 * j) = v[j];
        }
#pragma unroll
        for (int j = 0; j < 8; ++j) s += (v[j].x * v[j].x + v[j].y * v[j].y) + (v[j].z * v[j].z + v[j].w * v[j].w);
        const float rstd = 1.0f / sqrtf(wave_sum(s) * (1.f / DM) + EPS);
        bf16* o = WSP(bf16, WS_HN) + (size_t)row * DM;
#pragma unroll
        for (int j = 0; j < 8; ++j) { const int c = 4 * plane + 256 * j; const f32x4 gg = *(const f32x4*)(g + c), sh = *(const f32x4*)(md + c), sc = *(const f32x4*)(md + DM + c);
            const f32x4 y = (v[j] * rstd) * gg * (sc + 1.0f) + sh; u32x2 w; w.x = cvtpk(y.x, y.y); w.y = cvtpk(y.z, y.w); *(u32x2*)(o + c) = w; }
    }
}
__device__ __forceinline__ void final_norm_phase(const Args& A, const Frame& F) {
    int tid_ = threadIdx.x; asm volatile("" : "+v"(tid_)); const int ptid = tid_, plane = ptid & 63, pwave = __builtin_amdgcn_readfirstlane(ptid >> 6);
    const int gw = F.vcu * NWAVES + pwave, NGW = F.G * NWAVES; const float* g = inp<I_GFINAL>();
    for (int r = gw; r < NB * SEQ; r += NGW) {
        const int b = r / SEQ, t = r - b * SEQ; const float* xr = WSP(float, WS_XW) + (size_t)(b * TOK + CTX + t) * DM;
        f32x4 v[8]; float s = 0.f;
#pragma unroll
        for (int j = 0; j < 8; ++j) { v[j] = *(const f32x4*)(xr + 4 * plane + 256 * j); s += (v[j].x * v[j].x + v[j].y * v[j].y) + (v[j].z * v[j].z + v[j].w * v[j].w); }
        const float rstd = 1.0f / sqrtf(wave_sum(s) * (1.f / DM) + EPS);
        float* o = F.out + (size_t)r * DM;
#pragma unroll
        for (int j = 0; j < 8; ++j) { const int c = 4 * plane + 256 * j; const f32x4 gg = *(const f32x4*)(g + c); *(f32x4*)(o + c) = (v[j] * rstd) * gg; }
    }
}

struct TileOrder {
    int nM, nN, nwg, G, c, mode, nsplit, kslice;
    __device__ void init(int N, int G_, int c_, int mode_, int nsplit_ = 1, int kslice_ = 0) { mode = mode_; nsplit = nsplit_; kslice = kslice_; nM = mode_ == 0 ? 36 : (mode_ == 1 ? 32 : 4); nN = N / 256; nwg = nM * nN * nsplit_; G = G_; c = c_; }
    __device__ bool next(int i, pg8::Unit& u) const {
        const long L = (long)i * G + c; if (L >= nwg) return false;
        int wgid = (int)L; { const int q = nwg / 8, r = nwg % 8, xcd = wgid % 8, off = wgid / 8; wgid = (xcd < r ? xcd * (q + 1) : r * (q + 1) + (xcd - r) * q) + off; }
        if (mode == 3) {
            const int per = 4 * nN, ks = wgid / per, rem = wgid - ks * per; u.ks = ks; u.k0 = ks * kslice; u.pn = rem >> 2; u.pm = (rem & 3) * 9; return true; }
        const int nig = 8 * nN, gid = wgid / nig, fm = gid * 8, gsz = (nM - fm) < 8 ? (nM - fm) : 8;
        int pm = fm + ((wgid % nig) % gsz); u.pn = (wgid % nig) / gsz;
        if (mode == 1) pm = (pm >> 3) * 9 + 1 + (pm & 7); else if (mode == 2) pm = pm * 9;
        u.pm = pm; u.k0 = 0; u.ks = 0; return true;
    }
    __device__ __forceinline__ void a_ready(const pg8::Unit&) const {}
    __device__ __forceinline__ void done(const pg8::Unit&) const {}
};

__device__ __forceinline__ void rope8(f32x4& v0, f32x4& v1, const float* ropetab, int pos, int f0) {
    const f32x4 c = *(const f32x4*)(ropetab + pos * 16 + f0), s = *(const f32x4*)(ropetab + 1024 + pos * 16 + f0);
    const f32x4 a = v0, b = v1;
    v0[0] = a[0] * c[0] - a[1] * s[0]; v0[1] = a[0] * s[0] + a[1] * c[0]; v0[2] = a[2] * c[1] - a[3] * s[1]; v0[3] = a[2] * s[1] + a[3] * c[1];
    v1[0] = b[0] * c[2] - b[1] * s[2]; v1[1] = b[0] * s[2] + b[1] * c[2]; v1[2] = b[2] * c[3] - b[3] * s[3]; v1[3] = b[2] * s[3] + b[3] * c[3];
}
__device__ __forceinline__ f32x4 gelu4(f32x4 v) { const f32x2 a = pg8::gelu_pk((f32x2){v[0], v[1]}), b = pg8::gelu_pk((f32x2){v[2], v[3]}); return (f32x4){a.x, a.y, b.x, b.y}; }
__device__ __forceinline__ float ss8(f32x4 a, f32x4 b) { return (a[0] * a[0] + a[1] * a[1]) + (a[2] * a[2] + a[3] * a[3]) + (b[0] * b[0] + b[1] * b[1]) + (b[2] * b[2] + b[3] * b[3]); }

struct EpiZ {
    static constexpr bool PERM = true, AFTER_DRAIN = false;
    unsigned char* ws; const float* ropetab;
    __device__ __forceinline__ void operator()(const f32x4 (&acc)[2][2][4][2], const pg8::Unit& u, int wr, int wc, int fr, int fq) const {
        const int pn = u.pn;
#pragma unroll
        for (int ai = 0; ai < 2; ++ai)
#pragma unroll
            for (int m = 0; m < 4; ++m) {
                const int row = u.pm * 256 + ai * 128 + wr * 64 + m * 16 + fr;
                const int b = row / TOK, rr = row - b * TOK; const bool lat = rr >= CTX; const int t = rr - CTX, prow = (t >> 6) & 31, pcol = t & 63;
                float ssq = 0.f;
#pragma unroll
                for (int bj = 0; bj < 2; ++bj) {
                    const int colt = bj * 128 + wc * 32 + 8 * fq;
                    f32x4 v0 = acc[ai][bj][m][0], v1 = acc[ai][bj][m][1];
                    if (pn < 6) {
                        if (lat) { const int j0 = (colt & 63) >> 1; rope8(v0, v1, ropetab, j0 < 16 ? prow : pcol, j0 & 15); }
                        if (pn < 3) { v0 *= DA_QS; v1 *= DA_QS; *(u32x4*)((bf16*)(ws + WS_QDA) + (size_t)row * 768 + pn * 256 + colt) = pack8(v0, v1); }
                        else *(u32x4*)((bf16*)(ws + WS_KDA) + (size_t)row * 768 + (pn - 3) * 256 + colt) = pack8(v0, v1);
                    } else if (pn < 9) {
                        *(u32x4*)((bf16*)(ws + WS_VDA) + (size_t)row * 768 + (pn - 6) * 256 + colt) = pack8(v0, v1);
                    } else if (pn < 11) {
                        float* o = (float*)(ws + WS_U) + (size_t)row * 512 + (pn - 9) * 256 + colt; *(f32x4*)o = gelu4(v0); *(f32x4*)(o + 4) = gelu4(v1);
                    } else if (pn < 13) {
                        v0 = gelu4(v0); v1 = gelu4(v1);
                        float* o = (float*)(ws + WS_GV) + (size_t)row * 512 + (pn - 11) * 256 + colt; *(f32x4*)o = v0; *(f32x4*)(o + 4) = v1;
                        float s = ss8(v0, v1); s += __shfl_xor(s, 16); s += __shfl_xor(s, 32);
                        if (fq == 0) ((float*)(ws + WS_GVSS))[(size_t)row * 16 + ((pn - 11) * 2 + bj) * 4 + wc] = s;
                    } else if (pn < 15) {
                        *(u32x4*)((bf16*)(ws + WS_CQ) + (size_t)row * 512 + (pn - 13) * 256 + colt) = pack8(v0, v1); ssq += ss8(v0, v1);
                    } else if (pn < 17) {
                        *(u32x4*)((bf16*)(ws + WS_CKV) + (size_t)row * 512 + (pn - 15) * 256 + colt) = pack8(v0, v1); ssq += ss8(v0, v1);
                    } else {
                        if (colt < 64) {
                            if (lat) { const int j0 = colt >> 1; rope8(v0, v1, ropetab, j0 < 16 ? prow : pcol, j0 & 15); }
                            const u32x4 w = pack8(v0, v1); bf16* o = (bf16*)(ws + WS_KMLA) + (size_t)row * 1152 + 128 + colt;
#pragma unroll
                            for (int h = 0; h < 6; ++h) *(u32x4*)(o + h * 192) = w;
                        }
                    }
                }
                if (pn >= 13 && pn < 17) {
                    ssq += __shfl_xor(ssq, 16); ssq += __shfl_xor(ssq, 32);
                    if (fq == 0) { if (pn < 15) ((float*)(ws + WS_CQSS))[(size_t)row * 8 + (pn - 13) * 4 + wc] = ssq; else ((float*)(ws + WS_CKVSS))[(size_t)row * 8 + (pn - 15) * 4 + wc] = ssq; }
                }
            }
    }
};
__device__ __forceinline__ float rstd8(const float* p, float inv_n) { const f32x4 a = *(const f32x4*)p, b = *(const f32x4*)(p + 4); return 1.0f / sqrtf(((a[0] + a[1]) + (a[2] + a[3]) + (b[0] + b[1]) + (b[2] + b[3])) * inv_n + EPS); }

struct EpiKV {
    static constexpr bool PERM = true, AFTER_DRAIN = false;
    unsigned char* ws;
    __device__ __forceinline__ void operator()(const f32x4 (&acc)[2][2][4][2], const pg8::Unit& u, int wr, int wc, int fr, int fq) const {
#pragma unroll
        for (int ai = 0; ai < 2; ++ai)
#pragma unroll
            for (int m = 0; m < 4; ++m) {
                const int row = u.pm * 256 + ai * 128 + wr * 64 + m * 16 + fr;
                const float rs = rstd8((const float*)(ws + WS_CKVSS) + (size_t)row * 8, 1.f / RANK);
                const int c = wc * 32 + 8 * fq;
                *(u32x4*)((bf16*)(ws + WS_KMLA) + (size_t)row * 1152 + u.pn * 192 + c) = pack8(acc[ai][0][m][0] * rs, acc[ai][0][m][1] * rs);
                *(u32x4*)((bf16*)(ws + WS_VMLA) + (size_t)row * 768 + u.pn * 128 + c) = pack8(acc[ai][1][m][0] * rs, acc[ai][1][m][1] * rs);
            }
    }
};
struct EpiQ {
    static constexpr bool PERM = true, AFTER_DRAIN = false;
    unsigned char* ws; const float* ropetab;
    __device__ __forceinline__ void operator()(const f32x4 (&acc)[2][2][4][2], const pg8::Unit& u, int wr, int wc, int fr, int fq) const {
#pragma unroll
        for (int ai = 0; ai < 2; ++ai)
#pragma unroll
            for (int m = 0; m < 4; ++m) {
                const int row = u.pm * 256 + ai * 128 + wr * 64 + m * 16 + fr;
                const int b = row / TOK, rr = row - b * TOK; const bool lat = rr >= CTX; const int t = rr - CTX, prow = (t >> 6) & 31, pcol = t & 63;
                const float rs = rstd8((const float*)(ws + WS_CQSS) + (size_t)row * 8, 1.f / RANK) * MLA_QS;
#pragma unroll
                for (int bj = 0; bj < 2; ++bj) {
                    const int col = u.pn * 256 + bj * 128 + wc * 32 + 8 * fq;
                    if (col < NUQ) {
                        f32x4 v0 = acc[ai][bj][m][0] * rs, v1 = acc[ai][bj][m][1] * rs;
                        const int hd = col / 192, i = col - hd * 192;
                        if (lat && i >= 128) { const int j0 = (i - 128) >> 1; rope8(v0, v1, ropetab, j0 < 16 ? prow : pcol, j0 & 15); }
                        *(u32x4*)((bf16*)(ws + WS_QMLA) + (size_t)row * 1152 + col) = pack8(v0, v1);
                    }
                }
            }
    }
};
struct EpiResid {
    static constexpr bool PERM = true, AFTER_DRAIN = false;
    unsigned char* ws; const float* xin; const float* cin; const float* gate; bool from_inputs;
    __device__ __forceinline__ void operator()(const f32x4 (&acc)[2][2][4][2], const pg8::Unit& u, int wr, int wc, int fr, int fq) const {
        const int b = u.pm / 9; const bool isctx = (u.pm - b * 9) == 0; const int bsel = isctx ? 4 : b;
        const float* gp = gate + (size_t)bsel * MODW + u.pn * 256 + wc * 32 + 8 * fq;
        f32x4 g[2][2];
#pragma unroll
        for (int bj = 0; bj < 2; ++bj) { g[bj][0] = *(const f32x4*)(gp + bj * 128); g[bj][1] = *(const f32x4*)(gp + bj * 128 + 4); }
#pragma unroll
        for (int ai = 0; ai < 2; ++ai)
#pragma unroll
            for (int m = 0; m < 4; ++m) {
                const int row = u.pm * 256 + ai * 128 + wr * 64 + m * 16 + fr; const int rr = row - b * TOK;
                const float* bp = from_inputs ? (isctx ? cin + (size_t)(b * CTX + rr) * DM : xin + (size_t)(b * SEQ + rr - CTX) * DM) : (const float*)(ws + WS_XW) + (size_t)row * DM;
                float* op = (float*)(ws + WS_XW) + (size_t)row * DM;
#pragma unroll
                for (int bj = 0; bj < 2; ++bj) { const int c = u.pn * 256 + bj * 128 + wc * 32 + 8 * fq;
                    const f32x4 b0 = *(const f32x4*)(bp + c), b1 = *(const f32x4*)(bp + c + 4);
                    *(f32x4*)(op + c) = b0 + g[bj][0] * acc[ai][bj][m][0]; *(f32x4*)(op + c + 4) = b1 + g[bj][1] * acc[ai][bj][m][1]; }
            }
    }
};
struct EpiSlab {
    static constexpr bool PERM = true, AFTER_DRAIN = false;
    float* slab; const float* gate;
    __device__ __forceinline__ void operator()(const f32x4 (&acc)[2][2][4][2], const pg8::Unit& u, int wr, int wc, int fr, int fq) const {
        const int b = u.pm / 9; const float* gp = gate + u.pn * 256 + wc * 32 + 8 * fq;
        f32x4 g[2][2];
#pragma unroll
        for (int bj = 0; bj < 2; ++bj) { g[bj][0] = *(const f32x4*)(gp + bj * 128); g[bj][1] = *(const f32x4*)(gp + bj * 128 + 4); }
#pragma unroll
        for (int ai = 0; ai < 2; ++ai)
#pragma unroll
            for (int m = 0; m < 4; ++m) {
                const int crow_ = b * CTX + ai * 128 + wr * 64 + m * 16 + fr;
                float* op = slab + ((size_t)u.ks * 1024 + crow_) * DM + u.pn * 256 + wc * 32 + 8 * fq;
#pragma unroll
                for (int bj = 0; bj < 2; ++bj) { *(f32x4*)(op + bj * 128) = g[bj][0] * acc[ai][bj][m][0]; *(f32x4*)(op + bj * 128 + 4) = g[bj][1] * acc[ai][bj][m][1]; }
            }
    }
};
struct EpiFc1 {
    static constexpr bool PERM = true, AFTER_DRAIN = false;
    unsigned char* ws;
    __device__ __forceinline__ void operator()(const f32x4 (&acc)[2][2][4][2], const pg8::Unit& u, int wr, int wc, int fr, int fq) const {
#pragma unroll
        for (int ai = 0; ai < 2; ++ai)
#pragma unroll
            for (int m = 0; m < 4; ++m) {
                const int row = u.pm * 256 + ai * 128 + wr * 64 + m * 16 + fr;
#pragma unroll
                for (int bj = 0; bj < 2; ++bj) { const int c = u.pn * 256 + bj * 128 + wc * 32 + 8 * fq;
                    f32x4 v0 = __builtin_elementwise_max(acc[ai][bj][m][0], (f32x4){0.f, 0.f, 0.f, 0.f}), v1 = __builtin_elementwise_max(acc[ai][bj][m][1], (f32x4){0.f, 0.f, 0.f, 0.f});
                    *(u32x4*)((bf16*)(ws + WS_ACT) + (size_t)row * FF + c) = pack8(v0 * v0, v1 * v1); }
            }
    }
};
#define XB_TMO      128
#define XB_XCNT(j)  (256  + 64 * (j))
#define XB_XSUB(j)  (1280 + 64 * (j))
#define XB_XGEN(j)  (2304 + 64 * (j))
#define XB_TOP      3328
#define XB_TOPGEN   3392
#define XCD_BAR_WORDS 3456
#define XB_SPIN_CAP (1u << 18)

__device__ __forceinline__ unsigned xb_ld(unsigned* p)              { return __hip_atomic_load(p, __ATOMIC_RELAXED, __HIP_MEMORY_SCOPE_AGENT); }
__device__ __forceinline__ unsigned xb_add(unsigned* p, unsigned v) { return __hip_atomic_fetch_add(p, v, __ATOMIC_RELAXED, __HIP_MEMORY_SCOPE_AGENT); }
__device__ __forceinline__ unsigned xb_xcc_id() { return (unsigned)__builtin_amdgcn_s_getreg((3 << 11) | 20) & 0xFu; }
#define XB_SPIN(cond, bar) do { unsigned _sp = 0; while (cond) { __builtin_amdgcn_s_sleep(1); \
    if ((++_sp & 255u) == 0u) { if (xb_ld(&(bar)[XB_TMO])) break; if (_sp > XB_SPIN_CAP) { atomicAdd(&(bar)[XB_TMO], 1u); break; } } } } while (0)

struct XcdBarrier {
    unsigned* bar; unsigned x;
    volatile LAS unsigned* st;
};

__device__ __forceinline__ XcdBarrier xcd_barrier_post(unsigned* bar, volatile LAS unsigned* st) {
    XcdBarrier b; b.bar = bar; b.x = xb_xcc_id(); b.st = st;
    if (threadIdx.x == 0) (void)xb_add(&bar[XB_XCNT(b.x)], 1u);
    return b;
}
__device__ __forceinline__ void xcd_barrier_complete(unsigned* bar, unsigned x, unsigned& nloc, unsigned& nx) {
    const unsigned G = gridDim.x * gridDim.y * gridDim.z;
    unsigned sum, cnt, mine, sp = 0u;
    for (;;) {
        sum = 0u; cnt = 0u; mine = 0u;
#pragma unroll
        for (unsigned j = 0; j < 16; ++j) { const unsigned c = xb_ld(&bar[XB_XCNT(j)]); sum += c; cnt += (c > 0u) ? 1u : 0u; mine = (j == x) ? c : mine; }
        if (sum == G) break;
        __builtin_amdgcn_s_sleep(1);
        if ((++sp & 255u) == 0u) { if (xb_ld(&bar[XB_TMO])) break; if (sp > XB_SPIN_CAP) { atomicAdd(&bar[XB_TMO], 1u); break; } }
    }
    nloc = mine > 0u ? mine : 1u; nx = cnt > 0u ? cnt : 1u;
}

__device__ __forceinline__ void xcd_barrier(const XcdBarrier& b) {
    asm volatile("s_waitcnt vmcnt(0)" ::: "memory");
    __syncthreads();
    if (threadIdx.x == 0) {
        unsigned* bar = b.bar;
        __builtin_amdgcn_s_waitcnt(0);
        unsigned nloc = b.st[0], nx = b.st[1];
        if (nloc == 0u) { xcd_barrier_complete(bar, b.x, nloc, nx); b.st[0] = nloc; b.st[1] = nx; }
        const unsigned old = xb_add(&bar[XB_XSUB(b.x)], 1u);
        const unsigned gen = old / nloc;
        if (old + 1u == (gen + 1u) * nloc) {
            __builtin_amdgcn_fence(__ATOMIC_RELEASE, "agent");
            asm volatile("s_waitcnt vmcnt(0)" ::: "memory");
            const unsigned og = xb_add(&bar[XB_TOP], 1u);
            const unsigned tg = og / nx;
            if (og + 1u == (tg + 1u) * nx) xb_add(&bar[XB_TOPGEN], 1u);
            else XB_SPIN(xb_ld(&bar[XB_TOPGEN]) == tg, bar);
            __builtin_amdgcn_fence(__ATOMIC_ACQUIRE, "agent");
            xb_add(&bar[XB_XGEN(b.x)], 1u);
            asm volatile("s_waitcnt vmcnt(0)" ::: "memory");
        } else {
            XB_SPIN(xb_ld(&bar[XB_XGEN(b.x)]) == gen, bar);
            __builtin_amdgcn_fence(__ATOMIC_ACQUIRE, "agent");
            asm volatile("s_waitcnt vmcnt(0)" ::: "memory");
        }
    }
    __syncthreads();
}

namespace att {
#define SBAR() __builtin_amdgcn_sched_barrier(0)
constexpr int V_TILE = 64 * 128 * 2, K_OFF = 2 * V_TILE, K_TILE_MAX = 64 * 192 * 2, WS_OFF = K_OFF + 2 * K_TILE_MAX;
constexpr float THR = 6.0f;
__device__ __forceinline__ int crow(int r, int hi) { return (r & 3) + 8 * (r >> 2) + 4 * hi; }
__device__ __forceinline__ int v_st(int k, int c) { const int kk = (k & ~0xC) | ((k & 4) << 1) | ((k & 8) >> 1); return ((kk >> 3) * 4 + (c >> 5)) * 512 + ((kk & 7) * 32 + (c & 31)) * 2; }
__device__ __forceinline__ int v_rd_base(int lane) { return ((lane & 3) << 3) | (((lane >> 2) & 3) << 6) | (((lane >> 4) & 1) << 5) | (((lane >> 5) & 1) << 8); }
constexpr int v_rd_off(int d0, int ks, int half) { return d0 * 512 + ks * 4096 + half * 2048; }
template <int OFF> __device__ __forceinline__ s16x4 tr_read(int vb) { s16x4 r; asm volatile("ds_read_b64_tr_b16 %0, %1 offset:%2" : "=&v"(r) : "v"(vb), "i"(OFF) : "memory"); return r; }
template <int D0> __device__ __forceinline__ void pv_one(f32x16& od, int vb, bf16x8 pa0, bf16x8 pa1, bf16x8 pa2, bf16x8 pa3) {
    const s16x4 l0 = tr_read<v_rd_off(D0, 0, 0)>(vb), h0 = tr_read<v_rd_off(D0, 0, 1)>(vb), l1 = tr_read<v_rd_off(D0, 1, 0)>(vb), h1 = tr_read<v_rd_off(D0, 1, 1)>(vb);
    const s16x4 l2 = tr_read<v_rd_off(D0, 2, 0)>(vb), h2 = tr_read<v_rd_off(D0, 2, 1)>(vb), l3 = tr_read<v_rd_off(D0, 3, 0)>(vb), h3 = tr_read<v_rd_off(D0, 3, 1)>(vb);
    asm volatile("s_waitcnt lgkmcnt(0)" ::: "memory"); SBAR();
#define PK(L, H) (bf16x8){L[0], L[1], L[2], L[3], H[0], H[1], H[2], H[3]}
    od = __builtin_amdgcn_mfma_f32_32x32x16_bf16(pa0, PK(l0, h0), od, 0, 0, 0);
    od = __builtin_amdgcn_mfma_f32_32x32x16_bf16(pa1, PK(l1, h1), od, 0, 0, 0);
    od = __builtin_amdgcn_mfma_f32_32x32x16_bf16(pa2, PK(l2, h2), od, 0, 0, 0);
    od = __builtin_amdgcn_mfma_f32_32x32x16_bf16(pa3, PK(l3, h3), od, 0, 0, 0);
#undef PK
}
template <int DQK> __device__ __forceinline__ int k_off(int r, int c) { return r * (DQK * 2) + ((c ^ ((r >> 1) & 7)) << 4); }

template <int DQK>
__device__ __forceinline__ void attn_pass(f32x16 (&o)[4], const bf16* __restrict__ Qw, int ldq, const bf16* __restrict__ Kb, int ldk, const bf16* __restrict__ Vb, int ldv, int NT, LAS unsigned char* lds) {
    constexpr int KT = 64 * DQK * 2, NKC = DQK / 8, NKS = (64 * NKC) / NTHR, ND = DQK / 16;
    int tid_ = threadIdx.x; asm volatile("" : "+v"(tid_)); const int tid = tid_, wid = tid >> 6, lane = tid & 63, r32 = lane & 31, hi = lane >> 5;
    LAS unsigned char* V_lds = lds; LAS unsigned char* K_lds = lds + K_OFF;
    LAS float* wsf = (LAS float*)(lds + WS_OFF) + wid * 64;
    bf16x8 qr[ND];
#pragma unroll
    for (int d0 = 0; d0 < ND; ++d0) qr[d0] = *(const bf16x8*)(Qw + (size_t)r32 * ldq + d0 * 16 + hi * 8);
    int kgo[NKS], klo[NKS];
#pragma unroll
    for (int i = 0; i < NKS; ++i) { const int idx = tid + NTHR * i, r = idx / NKC, c = idx - r * NKC; kgo[i] = r * ldk + c * 8; klo[i] = k_off<DQK>(r, c); }
    const int sr = tid >> 4, sc = (tid & 15) * 8, vst0 = v_st(sr, sc), vst1 = v_st(32 + sr, sc);
    const int vb0 = (int)(uintptr_t)V_lds + v_rd_base(lane);
    bf16x8 ksA[NKS], vsA0, vsA1, ksB[NKS], vsB0, vsB1;
#define SLOAD(S, k0) do { _Pragma("unroll") for (int i_ = 0; i_ < NKS; ++i_) ks##S[i_] = *(const bf16x8*)(Kb + (size_t)(k0) * ldk + kgo[i_]); \
        vs##S##0 = *(const bf16x8*)(Vb + (size_t)((k0) + sr) * ldv + sc); vs##S##1 = *(const bf16x8*)(Vb + (size_t)((k0) + 32 + sr) * ldv + sc); } while (0)
#define SWRITE(S, buf) do { _Pragma("unroll") for (int i_ = 0; i_ < NKS; ++i_) *(LAS bf16x8*)(K_lds + (buf) * KT + klo[i_]) = ks##S[i_]; \
        *(LAS bf16x8*)(V_lds + (buf) * V_TILE + vst0) = vs##S##0; *(LAS bf16x8*)(V_lds + (buf) * V_TILE + vst1) = vs##S##1; } while (0)
    float m_reg = -1e30f, l_reg = 0.f;
#pragma unroll
    for (int d = 0; d < 4; ++d) o[d] = f32x16{};
#define TILE(buf) do { \
        f32x16 p0 = f32x16{}, p1 = f32x16{}; \
        { const LAS unsigned char* Kt = K_lds + (buf) * KT; \
          _Pragma("unroll") for (int d0 = 0; d0 < ND; ++d0) { \
              const bf16x8 b0 = *(const LAS bf16x8*)(Kt + k_off<DQK>(r32, 2 * d0 + hi)), b1 = *(const LAS bf16x8*)(Kt + k_off<DQK>(32 + r32, 2 * d0 + hi)); \
              p0 = __builtin_amdgcn_mfma_f32_32x32x16_bf16(b0, qr[d0], p0, 0, 0, 0); \
              p1 = __builtin_amdgcn_mfma_f32_32x32x16_bf16(b1, qr[d0], p1, 0, 0, 0); } } \
        float pmax = p0[0]; \
        _Pragma("unroll") for (int r = 1; r < 16; ++r) pmax = fmaxf(pmax, p0[r]); \
        _Pragma("unroll") for (int r = 0; r < 16; ++r) pmax = fmaxf(pmax, p1[r]); \
        { auto rr = __builtin_amdgcn_permlane32_swap(__float_as_uint(pmax), __float_as_uint(pmax), false, false); pmax = fmaxf(__uint_as_float(rr[0]), __uint_as_float(rr[1])); } \
        float alpha = 1.f; \
        if (!__all(pmax - m_reg <= THR)) { const float mn = fmaxf(m_reg, pmax); alpha = __builtin_amdgcn_exp2f(m_reg - mn); m_reg = mn; \
            if (hi == 0) wsf[r32] = alpha; asm volatile("s_waitcnt lgkmcnt(0)" ::: "memory"); \
            _Pragma("unroll") for (int r = 0; r < 16; ++r) { const float a = wsf[crow(r, hi)]; \
                _Pragma("unroll") for (int d = 0; d < 4; ++d) o[d][r] *= a; } \
            asm volatile("s_waitcnt lgkmcnt(0)" ::: "memory"); } \
        float ps = 0.f; \
        _Pragma("unroll") for (int r = 0; r < 16; ++r) { p0[r] = __builtin_amdgcn_exp2f(p0[r] - m_reg); p1[r] = __builtin_amdgcn_exp2f(p1[r] - m_reg); ps += p0[r] + p1[r]; } \
        { auto rr = __builtin_amdgcn_permlane32_swap(__float_as_uint(ps), __float_as_uint(ps), false, false); ps = __uint_as_float(rr[0]) + __uint_as_float(rr[1]); } \
        l_reg = l_reg * alpha + ps; \
        bf16x8 pa0, pa1, pa2, pa3; \
        PK4(p0, 0, pa0); PK4(p0, 8, pa1); PK4(p1, 0, pa2); PK4(p1, 8, pa3); \
        SBAR(); \
        { const int vb = vb0 + (buf) * V_TILE; \
          pv_one<0>(o[0], vb, pa0, pa1, pa2, pa3); pv_one<1>(o[1], vb, pa0, pa1, pa2, pa3); pv_one<2>(o[2], vb, pa0, pa1, pa2, pa3); pv_one<3>(o[3], vb, pa0, pa1, pa2, pa3); } \
    } while (0)
#define PK4(P, BASE, OUT) do { unsigned a0 = cvtpk(P[BASE + 0], P[BASE + 1]), a1 = cvtpk(P[BASE + 2], P[BASE + 3]); \
        unsigned b0 = cvtpk(P[BASE + 4], P[BASE + 5]), b1 = cvtpk(P[BASE + 6], P[BASE + 7]); \
        auto r0 = __builtin_amdgcn_permlane32_swap(a0, b0, false, false); auto r1 = __builtin_amdgcn_permlane32_swap(a1, b1, false, false); \
        u32x4 w = {r0[0], r1[0], r0[1], r1[1]}; OUT = __builtin_bit_cast(bf16x8, w); } while (0)
    if constexpr (DQK == 64) {
    SLOAD(A, 0); SLOAD(B, 64); SWRITE(A, 0); __syncthreads();
    for (int j = 0; j < NT; j += 2) {
        if (j + 2 < NT) SLOAD(A, (j + 2) * 64);
        TILE(0);
        SWRITE(B, 1);
        __syncthreads();
        if (j + 3 < NT) SLOAD(B, (j + 3) * 64);
        TILE(1);
        if (j + 2 < NT) SWRITE(A, 0);
        __syncthreads();
    }
    } else {
    SLOAD(A, 0); SWRITE(A, 0); __syncthreads();
    for (int j = 0; j < NT; j += 2) {
        SLOAD(A, (j + 1) * 64);
        TILE(0);
        SWRITE(A, 1);
        __syncthreads();
        if (j + 2 < NT) SLOAD(A, (j + 2) * 64);
        TILE(1);
        if (j + 2 < NT) SWRITE(A, 0);
        __syncthreads();
    }
    }
#undef PK4
#undef TILE
    if (hi == 0) wsf[32 + r32] = l_reg; asm volatile("s_waitcnt lgkmcnt(0)" ::: "memory");
#pragma unroll
    for (int r = 0; r < 16; ++r) { const float rl = 1.0f / wsf[32 + crow(r, hi)];
#pragma unroll
        for (int d = 0; d < 4; ++d) o[d][r] *= rl; }
    asm volatile("s_waitcnt lgkmcnt(0)" ::: "memory");
#undef SLOAD
#undef SWRITE
}


__device__ __forceinline__ void store_o(const f32x16 (&o)[4], const float (&rs)[16], const float (&gcol)[4], bf16* dst, int ld, LAS unsigned char* lds, int wid, int lane) {
    const int r32 = lane & 31, hi = lane >> 5;
    LAS unsigned short* stg = (LAS unsigned short*)(lds + wid * 8192);
#pragma unroll
    for (int d = 0; d < 4; ++d)
#pragma unroll
        for (int r = 0; r < 16; ++r) stg[crow(r, hi) * 128 + d * 32 + r32] = (unsigned short)(cvtpk(o[d][r] * rs[r] * gcol[d], 0.f) & 0xffffu);
    asm volatile("s_waitcnt lgkmcnt(0)" ::: "memory");
    bf16* p = dst + (size_t)(lane >> 4) * ld + (lane & 15) * 8;
#pragma unroll
    for (int i = 0; i < 8; ++i) { const u32x4 v = *(const LAS u32x4*)(stg + (i * 4 + (lane >> 4)) * 128 + (lane & 15) * 8); *(u32x4*)p = v; p += 4 * (size_t)ld; asm volatile("" : "+v"(p)); }
}

__device__ __forceinline__ void da_unit(const Args& A, const Frame& F, int l, int q0, int k0, int NT, int h) {
    int tid_ = threadIdx.x; asm volatile("" : "+v"(tid_)); const int tid = tid_, wid = tid >> 6, lane = tid & 63, r32 = lane & 31, hi = lane >> 5;
    const bf16* Q = WSP(bf16, WS_QDA); const bf16* K = WSP(bf16, WS_KDA); const bf16* V = WSP(bf16, WS_VDA);
    float* stash = WSP(float, WS_STASH) + ((size_t)blockIdx.x * NTHR + tid) * 64;
    const float lam = WSP(float, WS_SCAL)[l]; const float lam_init = 0.8f - 0.6f * expf(-0.3f * (float)l);
    f32x16 o[4];
    attn_pass<64>(o, Q + (size_t)(q0 + wid * 32) * 768 + (2 * h) * 64, 768, K + (size_t)k0 * 768 + (2 * h) * 64, 768, V + (size_t)k0 * 768 + h * 128, 768, NT, F.lds);
#pragma unroll
    for (int d = 0; d < 4; ++d)
#pragma unroll
        for (int r = 0; r < 16; r += 4) *(f32x4*)(stash + d * 16 + r) = (f32x4){o[d][r], o[d][r + 1], o[d][r + 2], o[d][r + 3]};
    attn_pass<64>(o, Q + (size_t)(q0 + wid * 32) * 768 + (2 * h + 1) * 64, 768, K + (size_t)k0 * 768 + (2 * h + 1) * 64, 768, V + (size_t)k0 * 768 + h * 128, 768, NT, F.lds);
    float ss[16];
#pragma unroll
    for (int r = 0; r < 16; ++r) ss[r] = 0.f;
#pragma unroll
    for (int d = 0; d < 4; ++d) {
#pragma unroll
        for (int r = 0; r < 16; r += 4) { const f32x4 s4 = *(const f32x4*)(stash + d * 16 + r);
#pragma unroll
            for (int e = 0; e < 4; ++e) { const float v = s4[e] - lam * o[d][r + e]; o[d][r + e] = v; ss[r + e] += v * v; } }
        asm volatile("" ::: "memory"); SBAR(); }
#pragma unroll
    for (int r = 0; r < 16; ++r) { float s = ss[r]; s += __shfl_xor(s, 1); s += __shfl_xor(s, 2); s += __shfl_xor(s, 4); s += __shfl_xor(s, 8); s += __shfl_xor(s, 16);
        ss[r] = (1.0f / sqrtf(s * (1.f / 128.f) + EPS)) * (1.f - lam_init); }
    const float* gs = inp<I_GDASUB>() + l * 128;
    float gcol[4];
#pragma unroll
    for (int d = 0; d < 4; ++d) gcol[d] = gs[d * 32 + r32];
    store_o(o, ss, gcol, WSP(bf16, WS_HEADS) + (size_t)(q0 + wid * 32) * DM + h * 128, DM, F.lds, wid, lane);
    __syncthreads();
}
__device__ __forceinline__ void mla_unit(const Args& A, const Frame& F, int q0, int k0, int NT, int h) {
    int tid_ = threadIdx.x; asm volatile("" : "+v"(tid_)); const int tid = tid_, wid = tid >> 6, lane = tid & 63, r32 = lane & 31, hi = lane >> 5;
    f32x16 o[4];
    attn_pass<192>(o, WSP(bf16, WS_QMLA) + (size_t)(q0 + wid * 32) * 1152 + h * 192, 1152, WSP(bf16, WS_KMLA) + (size_t)k0 * 1152 + h * 192, 1152, WSP(bf16, WS_VMLA) + (size_t)k0 * 768 + h * 128, 768, NT, F.lds);
    float rs[16], gcol[4];
#pragma unroll
    for (int r = 0; r < 16; ++r) rs[r] = 1.f;
#pragma unroll
    for (int d = 0; d < 4; ++d) gcol[d] = 1.f;
    store_o(o, rs, gcol, WSP(bf16, WS_HEADS) + (size_t)(q0 + wid * 32) * DM + 1280 + h * 128, DM, F.lds, wid, lane);
    __syncthreads();
}
__device__ __forceinline__ void attn_phase(const Args& A, const Frame& F, int l, bool with_ctx, int which = 3) {
    const int nun = with_ctx ? 432 : 384;
    for (int un = F.vcu; un < nun; un += F.G) {
        if (un < 384) { const int v = un < 192 ? un : un - 192; const int bh = v >> 3, qb = v & 7, b = bh / 6, h = bh - b * 6;

#ifndef NO_DA
            if (un < 192 && (which & 1)) da_unit(A, F, l, b * TOK + CTX + qb * 256, b * TOK, 36, h);
#endif
#ifndef NO_MLA
            if (un >= 192 && (which & 2)) mla_unit(A, F, b * TOK + CTX + qb * 256, b * TOK, 36, h);
#endif
        }
        else { const int v = un < 408 ? un - 384 : un - 408; const int b = v / 6, h = v - b * 6;

#ifndef NO_DA
            if (un < 408 && (which & 1)) da_unit(A, F, l, b * TOK, b * TOK, 4, h);
#endif
#ifndef NO_MLA
            if (un >= 408 && (which & 2)) mla_unit(A, F, b * TOK, b * TOK, 4, h);
#endif
        }
    }
}

__device__ __forceinline__ void gate_unit(const Args& A, const Frame& F, int l, int ch, int g) {
    int tid_ = threadIdx.x; asm volatile("" : "+v"(tid_)); const int tid = tid_, wid = tid >> 6, lane = tid & 63, r32 = lane & 31, hi = lane >> 5;
    const int r0 = ch * 128;
    LAS unsigned char* img = F.lds;
    { const int sc = (tid & 15) * 8; const float* gain = inp<I_GGMV>() + (l * 4 + g) * 128 + sc; const f32x4 g0 = *(const f32x4*)gain, g1 = *(const f32x4*)(gain + 4);
#pragma unroll
      for (int i = 0; i < 4; ++i) { const int q = (tid >> 4) + 32 * i, row = r0 + q;
          const float* src = WSP(float, WS_GV) + (size_t)row * 512 + g * 128 + sc; const f32x4 a = *(const f32x4*)src, b = *(const f32x4*)(src + 4);
          const f32x4 sq = *(const f32x4*)(WSP(float, WS_GVSS) + (size_t)row * 16 + g * 4); const float rs = 1.0f / sqrtf(((sq[0] + sq[1]) + (sq[2] + sq[3])) * (1.f / 128.f) + EPS);
          *(LAS u32x4*)(img + (q >> 6) * V_TILE + v_st(q & 63, sc)) = pack8(a * rs * g0, b * rs * g1); } }
    __syncthreads();
    const int pb = wid & 3, chh = wid >> 2;
    const bf16* Wsg = WSP(bf16, WS_WSP) + ((size_t)(l * 4 + g) * 128 + pb * 32 + r32) * 128 + hi * 8;
    f32x16 acc0 = f32x16{}, acc1 = f32x16{};
    const int vb0 = (int)(uintptr_t)img + v_rd_base(lane);
#pragma unroll
    for (int t = 0; t < 2; ++t) {
        const bf16x8 a0 = *(const bf16x8*)(Wsg + t * 64), a1 = *(const bf16x8*)(Wsg + t * 64 + 16), a2 = *(const bf16x8*)(Wsg + t * 64 + 32), a3 = *(const bf16x8*)(Wsg + t * 64 + 48);
        const int vb = vb0 + t * V_TILE;
        if (chh == 0) { pv_one<0>(acc0, vb, a0, a1, a2, a3); pv_one<1>(acc1, vb, a0, a1, a2, a3); }
        else          { pv_one<2>(acc0, vb, a0, a1, a2, a3); pv_one<3>(acc1, vb, a0, a1, a2, a3); }
    }
    const float* bs = inp<I_BSP>() + (l * 4 + g) * 128 + pb * 32;
    LAS float* mix = (LAS float*)(F.lds + 2 * V_TILE);
#pragma unroll
    for (int r = 0; r < 16; ++r) { const int p = crow(r, hi); const float bias = bs[p]; LAS float* mp = mix + (pb * 32 + p) * 128 + chh * 64 + r32; mp[0] = acc0[r] + bias; mp[32] = acc1[r] + bias; }
    __syncthreads();
    { const int sc = (tid & 15) * 8; const float* up = WSP(float, WS_U) + (size_t)(r0 + (tid >> 4)) * 512 + g * 128 + sc; bf16* hp = WSP(bf16, WS_HEADS) + (size_t)(r0 + (tid >> 4)) * DM + 768 + g * 128 + sc;
#pragma unroll
      for (int i = 0; i < 4; ++i) { const LAS float* mp = mix + ((tid >> 4) + 32 * i) * 128 + sc; const f32x4 m0 = *(const LAS f32x4*)mp, m1 = *(const LAS f32x4*)(mp + 4);
          const f32x4 u0 = *(const f32x4*)up, u1 = *(const f32x4*)(up + 4); *(u32x4*)hp = pack8(u0 * m0, u1 * m1);
          up += 32 * 512; hp += 32 * (size_t)DM; asm volatile("" : "+v"(up), "+v"(hp)); } }
    __syncthreads();
}
#undef SBAR
}

#ifndef MK_SPLIT
#define MK_SPLIT 0
#endif
constexpr int PH_PER_LAYER = 8, PH_FINAL = 2 + PH_PER_LAYER * DEPTH, N_PHASES = PH_FINAL + 1;

__global__ void __launch_bounds__(NTHR, 2) fwd_kernel(Args args) {
    extern __shared__ __attribute__((aligned(16))) unsigned char lds_raw[];
    cg::grid_group grid = cg::this_grid();
    Frame F;
    F.lds = (LAS unsigned char*)lds_raw;
    F.G = gridDim.x; { const int bx = blockIdx.x; F.vcu = (F.G % 8 == 0) ? (bx % 8) * (F.G / 8) + bx / 8 : bx; }
    const Args& A = args;
    F.out = args.out; F.ws = args.ws;
    const int lo = args.ph_lo, hi = args.ph_hi;
#ifndef PH_MASK
#define PH_MASK 0x7ff
#endif
#define PHM(j) (((PH_MASK) >> (j)) & 1)
#ifndef RPT_MASK
#define RPT_MASK 0
#endif
#define NREP(j) ((((RPT_MASK) >> (j)) & 1) ? 2 : 1)
#define IN(k) (lo <= (k) && (k) < hi)
#define SEAM(k) do { if (IN(k) && IN((k) + 1)) xcd_barrier(xb); } while (0)
    const float* ropetab = WSP(float, WS_ROPE);
    volatile LAS unsigned* MISC = (volatile LAS unsigned*)(F.lds + 131072);
    if (threadIdx.x < 64) MISC[threadIdx.x] = 0u;
    unsigned* barw = (unsigned*)(F.ws + WS_BAR);
    if (blockIdx.x == 0) for (int i = threadIdx.x; i < XCD_BAR_WORDS; i += NTHR) barw[i] = 0u;
    __syncthreads();
    XcdBarrier xb; xb.bar = barw; xb.x = 0; xb.st = MISC + 8;

    for (int rep_ = 0; rep_ < NREP(0); ++rep_) { if (rep_) xcd_barrier(xb); if (PHM(0) && IN(0)) { p0_prologue(A, F); } }
    if (IN(0) && IN(1)) { grid.sync(); }
    xb = xcd_barrier_post(barw, MISC + 8);
    for (int rep_ = 0; rep_ < NREP(1); ++rep_) { if (rep_) xcd_barrier(xb); if (PHM(1) && IN(1)) { p0b_modreduce(A, F); } } SEAM(1);

    for (int l = 0; l < DEPTH; ++l) {
        const int pb = 2 + PH_PER_LAYER * l; const bool last = (l == DEPTH - 1); const bool first = (l == 0);
        const float* modl = WSP(float, WS_MOD) + (size_t)l * 5 * MODW;
        for (int rep_ = 0; rep_ < NREP(2); ++rep_) { if (rep_) xcd_barrier(xb); if (PHM(2) && IN(pb + 0)) { norm_phase(A, F, l, first ? 1 : 0, inp<I_GMIX>() + l * DM, 0, first ? nullptr : WSP(float, WS_SLAB), false); } } SEAM(pb + 0);
        for (int rep_ = 0; rep_ < NREP(3); ++rep_) { if (rep_) xcd_barrier(xb); if (PHM(3) && IN(pb + 1)) {
            pg8::Gemm g{WSP(bf16, WS_HN), WSP(bf16, WS_WIN) + (size_t)l * NZP * DM, M, NZP, DM, DM}; TileOrder S; S.init(NZP, F.G, (int)blockIdx.x, 0);
            EpiZ E{F.ws, ropetab};
            pg8::gemm_phase<EpiZ, TileOrder, true, true>(F.lds, g, S, E);
        } } SEAM(pb + 1);
        for (int rep_ = 0; rep_ < NREP(4); ++rep_) { if (rep_) xcd_barrier(xb); if (PHM(4) && IN(pb + 2)) {
            { pg8::Gemm g{WSP(bf16, WS_CKV), WSP(bf16, WS_WUKV) + (size_t)l * NUKV * RANK, M, NUKV, RANK, RANK}; TileOrder S; S.init(NUKV, F.G, (int)blockIdx.x, 0);
              EpiKV E{F.ws}; pg8::gemm_phase<EpiKV, TileOrder, true, true>(F.lds, g, S, E); }
            { pg8::Gemm g{WSP(bf16, WS_CQ), WSP(bf16, WS_WUQ) + (size_t)l * NUQP * RANK, M, NUQP, RANK, RANK}; TileOrder S; S.init(NUQP, F.G, (int)blockIdx.x, last ? 1 : 0);
              EpiQ E{F.ws, ropetab}; pg8::gemm_phase<EpiQ, TileOrder, true, true>(F.lds, g, S, E); }
            for (int un = F.vcu; un < 72 * 4; un += F.G) { const int ch = un >> 2, g = un & 3; if (last && (ch % 18) < 2) continue; att::gate_unit(A, F, l, ch, g); }
        } } SEAM(pb + 2);
        for (int rep_ = 0; rep_ < NREP(5); ++rep_) { if (rep_) xcd_barrier(xb); if (PHM(5) && IN(pb + 3)) {
#ifdef ATT_RPT_WHICH
            att::attn_phase(A, F, l, !last, rep_ ? ATT_RPT_WHICH : 3);
#else
            att::attn_phase(A, F, l, !last);
#endif
        } } SEAM(pb + 3);
        for (int rep_ = 0; rep_ < NREP(6); ++rep_) { if (rep_) xcd_barrier(xb); if (PHM(6) && IN(pb + 4)) {
            { pg8::Gemm g{WSP(bf16, WS_HEADS), WSP(bf16, WS_WOUT) + (size_t)l * DM * DM, M, DM, DM, DM}; TileOrder S; S.init(DM, F.G, (int)blockIdx.x, 1);
              EpiResid E{F.ws, inp<I_X>(), inp<I_CTX>(), modl + 2 * DM, first};
              pg8::gemm_phase<EpiResid, TileOrder, true, true>(F.lds, g, S, E); }
            if (!last) {
              pg8::Gemm g{WSP(bf16, WS_HEADS), WSP(bf16, WS_WOUT) + (size_t)l * DM * DM, M, DM, DM / 8, DM}; TileOrder S; S.init(DM, F.G, (int)blockIdx.x, 3, 8, DM / 8);
              EpiSlab E{WSP(float, WS_SLAB), modl + 4 * MODW + 2 * DM};
              pg8::gemm_phase<EpiSlab, TileOrder, true, true>(F.lds, g, S, E); }
        } } SEAM(pb + 4);
        for (int rep_ = 0; rep_ < NREP(7); ++rep_) { if (rep_) xcd_barrier(xb); if (PHM(7) && IN(pb + 5)) { norm_phase(A, F, l, first ? 2 : 0, inp<I_GMLP>() + l * DM, 3 * DM, last ? nullptr : WSP(float, WS_SLAB), last); } } SEAM(pb + 5);
        for (int rep_ = 0; rep_ < NREP(8); ++rep_) { if (rep_) xcd_barrier(xb); if (PHM(8) && IN(pb + 6)) {
            pg8::Gemm g{WSP(bf16, WS_HN), WSP(bf16, WS_WFC1) + (size_t)l * FF * DM, M, FF, DM, DM}; TileOrder S; S.init(FF, F.G, (int)blockIdx.x, last ? 1 : 0);
            EpiFc1 E{F.ws};
            pg8::gemm_phase<EpiFc1, TileOrder, true, true>(F.lds, g, S, E);
        } } SEAM(pb + 6);
        for (int rep_ = 0; rep_ < NREP(9); ++rep_) { if (rep_) xcd_barrier(xb); if (PHM(9) && IN(pb + 7)) {
            { pg8::Gemm g{WSP(bf16, WS_ACT), WSP(bf16, WS_WFC2) + (size_t)l * DM * FF, M, DM, FF, FF}; TileOrder S; S.init(DM, F.G, (int)blockIdx.x, 1);
              EpiResid E{F.ws, inp<I_X>(), inp<I_CTX>(), modl + 5 * DM, false};
              pg8::gemm_phase<EpiResid, TileOrder, true, true>(F.lds, g, S, E); }
            if (!last) {
              pg8::Gemm g{WSP(bf16, WS_ACT), WSP(bf16, WS_WFC2) + (size_t)l * DM * FF, M, DM, FF / 8, FF}; TileOrder S; S.init(DM, F.G, (int)blockIdx.x, 3, 8, FF / 8);
              EpiSlab E{WSP(float, WS_SLAB), modl + 4 * MODW + 5 * DM};
              pg8::gemm_phase<EpiSlab, TileOrder, true, true>(F.lds, g, S, E); }
        } } SEAM(pb + 7);
    }
    for (int rep_ = 0; rep_ < NREP(10); ++rep_) { if (rep_) xcd_barrier(xb); if (PHM(10) && IN(PH_FINAL)) { final_norm_phase(A, F); } }
#undef IN
#undef SEAM
}

extern "C" void kernel_launch(void* const* d_in, const int* in_sizes, int n_in, void* d_out, int out_size, void* d_ws, size_t ws_size, hipStream_t stream) {
    static int grid = 0;
    if (grid == 0) {
        if (n_in != N_IN || ws_size < WS_END || out_size != NB * SEQ * DM) { fprintf(stderr, "kernel_launch: unexpected shapes: n_in %d ws %zu (need %zu) out %d\n", n_in, ws_size, (size_t)WS_END, out_size); grid = -1; return; }
        int dev = 0, cus = 0, per_cu = 0;
        if (hipGetDevice(&dev) != hipSuccess || hipDeviceGetAttribute(&cus, hipDeviceAttributeMultiprocessorCount, dev) != hipSuccess) { fprintf(stderr, "kernel_launch: device query failed\n"); grid = -1; return; }
        if (hipFuncSetAttribute((const void*)fwd_kernel, hipFuncAttributeMaxDynamicSharedMemorySize, LDS_BYTES) != hipSuccess) { fprintf(stderr, "kernel_launch: hipFuncSetAttribute failed\n"); grid = -1; return; }
        if (hipOccupancyMaxActiveBlocksPerMultiprocessor(&per_cu, (const void*)fwd_kernel, NTHR, LDS_BYTES) != hipSuccess || per_cu < 1) { fprintf(stderr, "kernel_launch: occupancy query says %d blocks/CU\n", per_cu); (void)hipGetLastError(); per_cu = 1; }
        grid = cus * per_cu; if (grid > 256) grid = 256;
        grid -= grid % 8;
        fprintf(stderr, "kernel_launch: cus %d per_cu %d grid %d\n", cus, per_cu, grid);
    }
    if (grid <= 0) return;
    Args a{};
    for (int i = 0; i < N_IN; ++i) a.in[i] = (const float*)d_in[i];
    a.out = (float*)d_out; a.ws = (unsigned char*)d_ws;
#if MK_SPLIT
    for (int p = 0; p < N_PHASES; ++p) {
        a.ph_lo = p; a.ph_hi = p + 1; void* kargs[] = {&a};
        hipError_t e = hipLaunchCooperativeKernel((const void*)fwd_kernel, dim3(grid), dim3(NTHR), kargs, LDS_BYTES, stream);
        if (e != hipSuccess) { fprintf(stderr, "kernel_launch: launch of phase %d failed: %s\n", p, hipGetErrorString(e)); break; }
    }
#else
    a.ph_lo = 0; a.ph_hi = N_PHASES; void* kargs[] = {&a};
    hipError_t e = hipLaunchCooperativeKernel((const void*)fwd_kernel, dim3(grid), dim3(NTHR), kargs, LDS_BYTES, stream);
    if (e != hipSuccess) fprintf(stderr, "kernel_launch: cooperative launch failed: %s (grid %d)\n", hipGetErrorString(e), grid);
#endif
}
```

```cpp
#include <hip/hip_runtime.h>
#include <hip/hip_cooperative_groups.h>
#include <cstdio>
#include <cstdint>
namespace cg = cooperative_groups;
namespace pg8 {
#define PG8_LAS __attribute__((address_space(3)))
typedef unsigned short bf16_t;
typedef short bf16x8 __attribute__((ext_vector_type(8)));
typedef float f32x4 __attribute__((ext_vector_type(4)));
typedef unsigned u32x4 __attribute__((ext_vector_type(4)));
constexpr int BM = 256, BK = 64, HALF = 128, HTB = HALF * BK * 2  , STAGE_BYTES = 8 * HTB, NXCD = 8, WGM = 8;

__host__ __device__ __forceinline__ int lds_byte(int r, int c) { const int st = (r >> 4) * 2 + (c >> 5), rr = r & 15, cc = c & 31, ob = rr * 64 + cc * 2; return st * 1024 + (ob ^ (((ob >> 9) & 1) << 5)); }
__host__ __device__ __forceinline__ void stage_rc(int b, int& R, int& C) { const int st = b / 1024, sb = b % 1024, swz = sb ^ (((sb >> 9) & 1) << 5); R = (st >> 1) * 16 + swz / 64; C = (st & 1) * 32 + (swz % 64) / 2; }
__host__ __device__ __forceinline__ int perm32(int rho) { const int n = rho >> 4, i = rho & 15; return 8 * (i >> 2) + 4 * n + (i & 3); }

struct Unit { int pm, pn, k0, ks; };
struct Gemm { const bf16_t* A; const bf16_t* Bt; int M, N, K, ld; };

__device__ __forceinline__ unsigned cvt_pk_bf16(float lo, float hi) { unsigned r; asm volatile("v_cvt_pk_bf16_f32 %0, %1, %2" : "=v"(r) : "v"(lo), "v"(hi)); return r; }
typedef float f32x2 __attribute__((ext_vector_type(2)));
__device__ __forceinline__ f32x2 gelu_pk(f32x2 v) {
    const f32x2 av = __builtin_elementwise_abs(v), d = av * 0.2316418882f + 1.0f;
    f32x2 t; t.x = __builtin_amdgcn_rcpf(d.x); t.y = __builtin_amdgcn_rcpf(d.y);
    f32x2 q = t * 0.5307027145f + (-0.7265760135f); q = q * t + 0.7107068705f; q = q * t + (-0.142248368f); q = q * t + 0.127414796f; q = q * t;
    const f32x2 s = (v * v) * (-0.72134752044f);
    f32x2 e; e.x = __builtin_amdgcn_exp2f(s.x); e.y = __builtin_amdgcn_exp2f(s.y);
    const f32x2 m = v * (q * e), r = v - m;
    f32x2 o; o.x = v.x < 0.f ? m.x : r.x; o.y = v.y < 0.f ? m.y : r.y; return o;
}
template <class Epi, class Sched, bool ALIGN_EPI = false, bool SP2 = false>
__device__ __forceinline__ void gemm_phase(PG8_LAS unsigned char* lds, const Gemm g, const Sched& S, const Epi& E) {
    int tid_ = threadIdx.x; asm volatile("" : "+v"(tid_)); const int tid = tid_, wid = __builtin_amdgcn_readfirstlane(tid >> 6), lane = tid & 63, wr = wid >> 2, wc = wid & 3, fr = lane & 15, fq = lane >> 4;
    const int K = g.K, nt = K / BK;
    unsigned voffA[2], voffB[2];
#pragma unroll
    for (int i = 0; i < 2; ++i) { int R, C; stage_rc(tid * 16 + i * 8192, R, C); const int Rb = Epi::PERM ? ((R & ~31) + perm32(R & 31)) : R;
        voffA[i] = (unsigned)(R * g.ld + C) * 2u; voffB[i] = (unsigned)(Rb * g.ld + C) * 2u; }
    const size_t kstep = (size_t)(BK * 2);
    const size_t hstep = (size_t)HALF * g.ld * 2;
    const size_t tstep = 2 * hstep;
    const unsigned ldsw = (unsigned)wid * 1024u;
    const int aoff = lds_byte(wr * 64 + fr, fq * 8), boff = lds_byte(wc * 32 + fr, fq * 8);
#define PG8_SA(b, h) (((b) * 2 + (h)) * HTB)
#define PG8_SB(b, h) ((4 + (b) * 2 + (h)) * HTB)
#define PG8_STAGE(bufoff, gbase, voff) do { _Pragma("unroll") for (int _i = 0; _i < 2; ++_i) \
        __builtin_amdgcn_global_load_lds((const unsigned*)((const char*)(gbase) + (voff)[_i]), (PG8_LAS unsigned*)(lds + (bufoff) + ldsw + _i * 8192), 16, 0, 0); } while (0)
#define PG8_LDA(dst, b, h) do { _Pragma("unroll") for (int m = 0; m < 4; ++m) _Pragma("unroll") for (int k = 0; k < 2; ++k) dst[m][k] = *(const PG8_LAS bf16x8*)(lds + PG8_SA(b, h) + aoff + m * 2048 + k * 1024); } while (0)
#define PG8_LDB(dst, b, h) do { _Pragma("unroll") for (int n = 0; n < 2; ++n) _Pragma("unroll") for (int k = 0; k < 2; ++k) dst[n][k] = *(const PG8_LAS bf16x8*)(lds + PG8_SB(b, h) + boff + n * 2048 + k * 1024); } while (0)
#define PG8_MMA(ai, bj, At, Bt) do { __builtin_amdgcn_s_setprio(1); _Pragma("unroll") for (int m = 0; m < 4; ++m) _Pragma("unroll") for (int n = 0; n < 2; ++n) _Pragma("unroll") for (int k = 0; k < 2; ++k) \
        acc[ai][bj][m][n] = __builtin_amdgcn_mfma_f32_16x16x32_bf16(Bt[n][k], At[m][k], acc[ai][bj][m][n], 0, 0, 0); __builtin_amdgcn_s_setprio(0); } while (0)
#define PG8_WAIT_V(n) asm volatile("s_waitcnt vmcnt(" #n ")" ::: "memory")
#define PG8_WAIT_L(n) asm volatile("s_waitcnt lgkmcnt(" #n ")" ::: "memory")
#define PG8_BAR __builtin_amdgcn_s_barrier()
#define PG8_SCHED __builtin_amdgcn_sched_barrier(0)
    Unit cur, nxt; int ui = 0;
    if (!S.next(0, cur)) return;
    f32x4 acc[2][2][4][2];
#pragma unroll
    for (int a = 0; a < 2; ++a)
#pragma unroll
        for (int b = 0; b < 2; ++b)
#pragma unroll
            for (int m = 0; m < 4; ++m)
#pragma unroll
                for (int n = 0; n < 2; ++n) acc[a][b][m][n] = (f32x4){0.f, 0.f, 0.f, 0.f};
    bf16x8 At[4][2], B0[2][2], B1[2][2];
    const char* cA = (const char*)g.A + (size_t)cur.pm * tstep + (size_t)cur.k0 * 2; const char* cB = (const char*)g.Bt + (size_t)cur.pn * tstep + (size_t)cur.k0 * 2;
    S.a_ready(cur);
    if constexpr (SP2) {
        PG8_STAGE(PG8_SB(0, 0), cB, voffB); PG8_STAGE(PG8_SB(0, 1), cB + hstep, voffB); PG8_STAGE(PG8_SA(0, 0), cA, voffA); PG8_STAGE(PG8_SA(0, 1), cA + hstep, voffA);
        if (wr == 1) PG8_BAR;
        PG8_WAIT_V(2); PG8_BAR;
        PG8_STAGE(PG8_SB(1, 0), cB + kstep, voffB); PG8_STAGE(PG8_SA(1, 0), cA + kstep, voffA); PG8_STAGE(PG8_SB(1, 1), cB + hstep + kstep, voffB);
        PG8_WAIT_V(6); PG8_BAR;
    } else {
        PG8_STAGE(PG8_SB(0, 0), cB, voffB); PG8_STAGE(PG8_SA(0, 0), cA, voffA); PG8_STAGE(PG8_SB(0, 1), cB + hstep, voffB); PG8_STAGE(PG8_SA(0, 1), cA + hstep, voffA);
        if (wr == 1) PG8_BAR;
        PG8_WAIT_V(4); PG8_BAR;
        PG8_STAGE(PG8_SB(1, 0), cB + kstep, voffB); PG8_STAGE(PG8_SA(1, 0), cA + kstep, voffA); PG8_STAGE(PG8_SB(1, 1), cB + hstep + kstep, voffB);
        PG8_WAIT_V(6); PG8_BAR;
    }
    for (;;) {
        const bool has_next = S.next(ui + 1, nxt);
        const char* nA = has_next ? (const char*)g.A + (size_t)nxt.pm * tstep + (size_t)nxt.k0 * 2 : cA; const char* nB = has_next ? (const char*)g.Bt + (size_t)nxt.pn * tstep + (size_t)nxt.k0 * 2 : cB;
        for (int t = 0; t < nt; t += 2) {
            const bool last = (t == nt - 2);
            const char* a1 = cA + (size_t)(t + 1) * kstep;
            const char* a2 = last ? nA : cA + (size_t)(t + 2) * kstep; const char* b2 = last ? nB : cB + (size_t)(t + 2) * kstep;
            const char* a3 = a2 + kstep; const char* b3 = b2 + kstep;
            if (last && has_next) S.a_ready(nxt);
            if constexpr (SP2) {
            PG8_LDB(B0, 0, 0); PG8_LDB(B1, 0, 1); PG8_SCHED; PG8_LDA(At, 0, 0); PG8_STAGE(PG8_SA(1, 1), a1 + hstep, voffA);
            PG8_WAIT_V(8); PG8_WAIT_L(0); PG8_BAR; PG8_MMA(0, 0, At, B0); PG8_MMA(0, 1, At, B1); PG8_BAR; PG8_SCHED;
            PG8_LDA(At, 0, 1); PG8_STAGE(PG8_SB(0, 0), b2, voffB); PG8_STAGE(PG8_SB(0, 1), b2 + hstep, voffB); PG8_STAGE(PG8_SA(0, 0), a2, voffA);
            PG8_WAIT_V(8); PG8_WAIT_L(0); PG8_BAR; PG8_MMA(1, 0, At, B0); PG8_MMA(1, 1, At, B1); PG8_BAR; PG8_SCHED;
            PG8_LDB(B0, 1, 0); PG8_LDB(B1, 1, 1); PG8_SCHED; PG8_LDA(At, 1, 0); PG8_STAGE(PG8_SA(0, 1), a2 + hstep, voffA);
            PG8_WAIT_V(8); PG8_WAIT_L(0); PG8_BAR; PG8_MMA(0, 0, At, B0); PG8_MMA(0, 1, At, B1); PG8_BAR; PG8_SCHED;
            PG8_LDA(At, 1, 1); PG8_STAGE(PG8_SB(1, 0), b3, voffB); PG8_STAGE(PG8_SB(1, 1), b3 + hstep, voffB); PG8_STAGE(PG8_SA(1, 0), a3, voffA);
            PG8_WAIT_V(8); PG8_WAIT_L(0); PG8_BAR; PG8_MMA(1, 0, At, B0); PG8_MMA(1, 1, At, B1); PG8_BAR; PG8_SCHED;
            } else {
            PG8_LDB(B0, 0, 0); PG8_SCHED; PG8_LDA(At, 0, 0); PG8_STAGE(PG8_SA(1, 1), a1 + hstep, voffA);
            PG8_WAIT_L(8); PG8_BAR; PG8_WAIT_L(0); PG8_MMA(0, 0, At, B0); PG8_BAR; PG8_SCHED;
            PG8_LDB(B1, 0, 1); PG8_STAGE(PG8_SB(0, 0), b2, voffB);
            PG8_BAR; PG8_WAIT_L(0); PG8_MMA(0, 1, At, B1); PG8_BAR;
            PG8_LDA(At, 0, 1); PG8_STAGE(PG8_SA(0, 0), a2, voffA);
            PG8_BAR; PG8_WAIT_L(0); PG8_MMA(1, 0, At, B0); PG8_BAR; PG8_SCHED;
            PG8_STAGE(PG8_SB(0, 1), b2 + hstep, voffB);
            PG8_WAIT_V(6); PG8_BAR; PG8_MMA(1, 1, At, B1); PG8_BAR;
            PG8_LDB(B0, 1, 0); PG8_SCHED; PG8_LDA(At, 1, 0); PG8_STAGE(PG8_SA(0, 1), a2 + hstep, voffA);
            PG8_WAIT_L(8); PG8_BAR; PG8_WAIT_L(0); PG8_MMA(0, 0, At, B0); PG8_BAR; PG8_SCHED;
            PG8_LDB(B1, 1, 1); PG8_STAGE(PG8_SB(1, 0), b3, voffB);
            PG8_BAR; PG8_WAIT_L(0); PG8_MMA(0, 1, At, B1); PG8_BAR;
            PG8_LDA(At, 1, 1); PG8_STAGE(PG8_SA(1, 0), a3, voffA);
            PG8_BAR; PG8_WAIT_L(0); PG8_MMA(1, 0, At, B0); PG8_BAR; PG8_SCHED;
            PG8_STAGE(PG8_SB(1, 1), b3 + hstep, voffB);
            PG8_WAIT_V(6); PG8_BAR; PG8_MMA(1, 1, At, B1); PG8_BAR;
            }
        }
        if constexpr (ALIGN_EPI) { if (wr == 0) PG8_BAR; }
        if constexpr (!Epi::AFTER_DRAIN) { E(acc, cur, wr, wc, fr, fq); S.done(cur); }
        if (!has_next) break;
#pragma unroll
        for (int a = 0; a < 2; ++a)
#pragma unroll
            for (int b = 0; b < 2; ++b)
#pragma unroll
                for (int m = 0; m < 4; ++m)
#pragma unroll
                    for (int n = 0; n < 2; ++n) acc[a][b][m][n] = (f32x4){0.f, 0.f, 0.f, 0.f};
        cur = nxt; cA = nA; cB = nB; ++ui;
        if constexpr (ALIGN_EPI) { if (wr == 1) PG8_BAR; }
    }
    PG8_WAIT_V(0);
    if constexpr (!ALIGN_EPI) { if (wr == 0) PG8_BAR; }
    PG8_BAR;
    if constexpr (Epi::AFTER_DRAIN) { E.fused(acc, cur, wr, wc, fr, fq, lds, wid, lane); S.done(cur); }
#undef PG8_SA
#undef PG8_SB
#undef PG8_STAGE
#undef PG8_LDA
#undef PG8_LDB
#undef PG8_MMA
#undef PG8_WAIT_V
#undef PG8_WAIT_L
#undef PG8_BAR
#undef PG8_SCHED
}
}

#define GAS __attribute__((address_space(1)))
#define LAS __attribute__((address_space(3)))
typedef unsigned short bf16;
typedef float f32x4 __attribute__((ext_vector_type(4)));
typedef float f32x2 __attribute__((ext_vector_type(2)));
typedef float f32x16 __attribute__((ext_vector_type(16)));
typedef short bf16x8 __attribute__((ext_vector_type(8)));
typedef short s16x4 __attribute__((ext_vector_type(4)));
typedef unsigned u32x4 __attribute__((ext_vector_type(4)));
typedef unsigned u32x2 __attribute__((ext_vector_type(2)));

constexpr int NB = 4, SEQ = 2048, CTX = 256, DM = 2048, DEPTH = 2, FF = 8192;
constexpr int TOK = CTX + SEQ;
constexpr int M = NB * TOK;
constexpr int NZ = 4416, NZP = 4608;
constexpr int NUQ = 1152, NUQP = 1280, NUKV = 1536, RANK = 512;
constexpr int MODW = 6 * DM;
constexpr float EPS = 1e-6f;
constexpr float LOG2E = 1.4426950408889634f;
constexpr float DA_QS = 0.125f * LOG2E;
constexpr float MLA_QS = 0.07216878364870322f * LOG2E;
constexpr int NWAVES = 8, NTHR = 512;

enum { I_X = 0, I_C, I_CTX, I_CCTX, I_WMOD, I_BMOD, I_GMIX, I_GMLP, I_WIN, I_LQ1, I_LK1, I_LQ2, I_LK2, I_GDASUB, I_GGMV, I_WSP, I_BSP,
       I_GMQ, I_WUQ, I_GMKV, I_WUKV, I_WOUT, I_WFC1, I_WFC2, I_GFINAL, N_IN };

constexpr size_t al256(size_t x) { return (x + 255) / 256 * 256; }
constexpr size_t WS_ROPE  = 0;
constexpr size_t WS_SCAL  = WS_ROPE + 8192;
constexpr size_t WS_BAR   = WS_SCAL + 256;
constexpr size_t WS_MOD   = WS_BAR + 16384;
constexpr size_t WS_MODP  = al256(WS_MOD + (size_t)DEPTH * 5 * MODW * 4);
constexpr size_t WS_WIN   = al256(WS_MODP + (size_t)DEPTH * 32 * 5 * MODW * 4);
constexpr size_t WS_WOUT  = al256(WS_WIN + (size_t)DEPTH * NZP * DM * 2);
constexpr size_t WS_WFC1  = al256(WS_WOUT + (size_t)DEPTH * DM * DM * 2);
constexpr size_t WS_WFC2  = al256(WS_WFC1 + (size_t)DEPTH * FF * DM * 2);
constexpr size_t WS_WUQ   = al256(WS_WFC2 + (size_t)DEPTH * DM * FF * 2);
constexpr size_t WS_WUKV  = al256(WS_WUQ + (size_t)DEPTH * NUQP * RANK * 2);
constexpr size_t WS_WSP   = al256(WS_WUKV + (size_t)DEPTH * NUKV * RANK * 2);
constexpr size_t WS_XW    = al256(WS_WSP + (size_t)DEPTH * 4 * 128 * 128 * 2);
constexpr size_t WS_HN    = al256(WS_XW + (size_t)M * DM * 4);
constexpr size_t WS_QDA   = al256(WS_HN + (size_t)M * DM * 2);
constexpr size_t WS_KDA   = al256(WS_QDA + (size_t)M * 768 * 2);
constexpr size_t WS_VDA   = al256(WS_KDA + (size_t)M * 768 * 2);
constexpr size_t WS_U     = al256(WS_VDA + (size_t)M * 768 * 2);
constexpr size_t WS_GV    = al256(WS_U + (size_t)M * 512 * 4);
constexpr size_t WS_GVSS  = al256(WS_GV + (size_t)M * 512 * 4);
constexpr size_t WS_CQSS  = al256(WS_GVSS + (size_t)M * 16 * 4);
constexpr size_t WS_CKVSS = al256(WS_CQSS + (size_t)M * 8 * 4);
constexpr size_t WS_CQ    = al256(WS_CKVSS + (size_t)M * 8 * 4);
constexpr size_t WS_CKV   = al256(WS_CQ + (size_t)M * 512 * 2);
constexpr size_t WS_KMLA  = al256(WS_CKV + (size_t)M * 512 * 2);
constexpr size_t WS_VMLA  = al256(WS_KMLA + (size_t)M * 1152 * 2);
constexpr size_t WS_QMLA  = al256(WS_VMLA + (size_t)M * 768 * 2);
constexpr size_t WS_HEADS = al256(WS_QMLA + (size_t)M * 1152 * 2);
constexpr size_t WS_ACT   = al256(WS_HEADS + (size_t)M * DM * 2);
constexpr size_t WS_STASH = al256(WS_ACT + (size_t)M * FF * 2);
constexpr size_t WS_SLAB  = al256(WS_STASH + (size_t)256 * 64 * 512 * 4);
constexpr size_t WS_END   = al256(WS_SLAB + (size_t)8 * 1024 * DM * 4);

constexpr int LDS_BYTES = 131072 + 1024;

__device__ __forceinline__ unsigned cvtpk(float lo, float hi) { unsigned r; asm volatile("v_cvt_pk_bf16_f32 %0, %1, %2" : "=v"(r) : "v"(lo), "v"(hi)); return r; }
__device__ __forceinline__ u32x4 pack8(f32x4 a, f32x4 b) { u32x4 w; w.x = cvtpk(a[0], a[1]); w.y = cvtpk(a[2], a[3]); w.z = cvtpk(b[0], b[1]); w.w = cvtpk(b[2], b[3]); return w; }
__device__ __forceinline__ float wave_sum(float v) {
#pragma unroll
    for (int o = 1; o < 64; o <<= 1) v += __shfl_xor(v, o);
    return v;
}
__device__ __forceinline__ float bf2f(unsigned short h) { return __uint_as_float(((unsigned)h) << 16); }

struct Args { const float* in[N_IN]; float* out; unsigned char* ws; int ph_lo, ph_hi; };
struct Frame {
    LAS unsigned char* lds;
    int G, vcu;
    float* out; unsigned char* ws;
};
#define WSP(T, off) ((T*)(F.ws + (off)))
template <int I> __device__ __forceinline__ const float* inp() {
    unsigned long long p; asm volatile("s_load_dwordx2 %0, %1, %2\n\ts_waitcnt lgkmcnt(0)" : "=s"(p) : "s"(__builtin_amdgcn_kernarg_segment_ptr()), "n"(I * 8) : "memory"); return (const float*)p; }

__device__ __forceinline__ const float* xrow_in(const Args& A, const Frame& F, int row) {
    const int b = row / TOK, rr = row - b * TOK;
    return rr < CTX ? inp<I_CTX>() + (size_t)(b * CTX + rr) * DM : inp<I_X>() + (size_t)(b * SEQ + rr - CTX) * DM;
}

__device__ __forceinline__ void p0_transpose_item(const float* W, int K, int N, bf16* WT, const float* kscale, LAS float* scr, int item, int lane) {
    const int nblk = N / 32, kb = item / nblk, nb = item % nblk, k0 = 64 * kb, n0 = 32 * nb;
    { const int r8 = lane >> 3, c4 = (lane & 7) * 4; f32x4 v[8];
#pragma unroll
      for (int i = 0; i < 8; ++i) v[i] = *(const f32x4*)(W + (size_t)(k0 + r8 + 8 * i) * N + n0 + c4);
#pragma unroll
      for (int i = 0; i < 8; ++i) { const int kk = r8 + 8 * i; const float s = kscale ? kscale[k0 + kk] : 1.f; LAS float* d = scr + kk * 33 + c4;
          d[0] = v[i][0] * s; d[1] = v[i][1] * s; d[2] = v[i][2] * s; d[3] = v[i][3] * s; } }
    asm volatile("s_waitcnt lgkmcnt(0)" ::: "memory");
    const int c = lane & 7;
#pragma unroll
    for (int j = 0; j < 4; ++j) { const int n = (lane >> 3) + 8 * j; const LAS float* s = scr + (8 * c) * 33 + n;
        u32x4 o; o.x = cvtpk(s[0 * 33], s[1 * 33]); o.y = cvtpk(s[2 * 33], s[3 * 33]); o.z = cvtpk(s[4 * 33], s[5 * 33]); o.w = cvtpk(s[6 * 33], s[7 * 33]);
        *(u32x4*)(WT + (size_t)(n0 + n) * K + k0 + 8 * c) = o; }
    asm volatile("s_waitcnt lgkmcnt(0)" ::: "memory");
}
__device__ __forceinline__ float silu_f(float x) { return x / (1.f + __expf(-x)); }

__device__ __forceinline__ void p0_mod_item(const Args& A, const Frame& F, LAS float* scr, int item, int lane) {
    const int l = item / (32 * 48), r = item % (32 * 48), kc = r / 48, nc = r % 48;
    const int k = kc * 64 + lane;
#pragma unroll
    for (int bb = 0; bb < 5; ++bb) { const float cv = bb < 4 ? inp<I_C>()[bb * DM + k] : inp<I_CCTX>()[k]; scr[bb * 64 + lane] = silu_f(cv); }
    asm volatile("s_waitcnt lgkmcnt(0)" ::: "memory");
    const float* W = inp<I_WMOD>() + ((size_t)l * DM + kc * 64) * MODW + nc * 256 + lane * 4;
    f32x4 acc[5];
#pragma unroll
    for (int bb = 0; bb < 5; ++bb) acc[bb] = (f32x4){0.f, 0.f, 0.f, 0.f};
#pragma unroll 8
    for (int kk = 0; kk < 64; ++kk) { const f32x4 w = *(const f32x4*)(W + (size_t)kk * MODW);
#pragma unroll
        for (int bb = 0; bb < 5; ++bb) acc[bb] += w * scr[bb * 64 + kk]; }
    float* P = WSP(float, WS_MODP) + ((size_t)(l * 32 + kc) * 5) * MODW + nc * 256 + lane * 4;
#pragma unroll
    for (int bb = 0; bb < 5; ++bb) *(f32x4*)(P + (size_t)bb * MODW) = acc[bb];
    asm volatile("s_waitcnt lgkmcnt(0)" ::: "memory");
}

__device__ __forceinline__ void p0_prologue(const Args& A, const Frame& F) {
    int tid_ = threadIdx.x; asm volatile("" : "+v"(tid_)); const int ptid = tid_, plane = ptid & 63, pwave = __builtin_amdgcn_readfirstlane(ptid >> 6);
    LAS float* scr = (LAS float*)(F.lds + pwave * 16384);
    const int gw = F.vcu * NWAVES + pwave, NGW = F.G * NWAVES;
    constexpr int I_MOD = DEPTH * 32 * 48;
    constexpr int T_IN = (DM / 64) * (NZ / 32), T_OUT = (DM / 64) * (DM / 32), T_FC1 = (DM / 64) * (FF / 32), T_FC2 = (FF / 64) * (DM / 32), T_UQ = (RANK / 64) * (NUQ / 32), T_UKV = (RANK / 64) * (NUKV / 32);
    constexpr int T_L = T_IN + T_OUT + T_FC1 + T_FC2 + T_UQ + T_UKV;
    constexpr int NITEMS = I_MOD + DEPTH * T_L;
    for (int it = gw; it < NITEMS; it += NGW) {
        if (it < I_MOD) { p0_mod_item(A, F, scr, it, plane); continue; }
        int r = it - I_MOD; const int l = r / T_L; r -= l * T_L;
        if (r < T_IN)  { p0_transpose_item(inp<I_WIN>() + (size_t)l * DM * NZ, DM, NZ, WSP(bf16, WS_WIN) + (size_t)l * NZP * DM, nullptr, scr, r, plane); continue; } r -= T_IN;
        if (r < T_OUT) { p0_transpose_item(inp<I_WOUT>() + (size_t)l * DM * DM, DM, DM, WSP(bf16, WS_WOUT) + (size_t)l * DM * DM, nullptr, scr, r, plane); continue; } r -= T_OUT;
        if (r < T_FC1) { p0_transpose_item(inp<I_WFC1>() + (size_t)l * DM * FF, DM, FF, WSP(bf16, WS_WFC1) + (size_t)l * FF * DM, nullptr, scr, r, plane); continue; } r -= T_FC1;
        if (r < T_FC2) { p0_transpose_item(inp<I_WFC2>() + (size_t)l * FF * DM, FF, DM, WSP(bf16, WS_WFC2) + (size_t)l * DM * FF, nullptr, scr, r, plane); continue; } r -= T_FC2;
        if (r < T_UQ)  { p0_transpose_item(inp<I_WUQ>() + (size_t)l * RANK * NUQ, RANK, NUQ, WSP(bf16, WS_WUQ) + (size_t)l * NUQP * RANK, inp<I_GMQ>() + l * RANK, scr, r, plane); continue; } r -= T_UQ;
        p0_transpose_item(inp<I_WUKV>() + (size_t)l * RANK * NUKV, RANK, NUKV, WSP(bf16, WS_WUKV) + (size_t)l * NUKV * RANK, inp<I_GMKV>() + l * RANK, scr, r, plane);
    }
    const int gt = F.vcu * NTHR + ptid, NGT = F.G * NTHR;
    for (int i = gt; i < DEPTH * (NZP - NZ) * DM / 8; i += NGT) { const int l = i / ((NZP - NZ) * DM / 8), r = i % ((NZP - NZ) * DM / 8);
        *(u32x4*)(WSP(bf16, WS_WIN) + ((size_t)l * NZP + NZ) * DM + (size_t)r * 8) = (u32x4){0u, 0u, 0u, 0u}; }
    for (int i = gt; i < DEPTH * (NUQP - NUQ) * RANK / 8; i += NGT) { const int l = i / ((NUQP - NUQ) * RANK / 8), r = i % ((NUQP - NUQ) * RANK / 8);
        *(u32x4*)(WSP(bf16, WS_WUQ) + ((size_t)l * NUQP + NUQ) * RANK + (size_t)r * 8) = (u32x4){0u, 0u, 0u, 0u}; }
    for (int i = gt; i < DEPTH * 4 * 128 * 128 / 8; i += NGT) { const f32x4 a = *(const f32x4*)(inp<I_WSP>() + (size_t)i * 8), b = *(const f32x4*)(inp<I_WSP>() + (size_t)i * 8 + 4);
        *(u32x4*)(WSP(bf16, WS_WSP) + (size_t)i * 8) = pack8(a, b); }
    if (gt < 64 * 16) { const int pos = gt >> 4, f = gt & 15; const float inv = powf(10000.0f, -(float)f / 16.0f); const float ang = (float)pos * inv;
        WSP(float, WS_ROPE)[gt] = cosf(ang); WSP(float, WS_ROPE)[1024 + gt] = sinf(ang); }
    if (gt < 64 * DEPTH) {
        const int l = gt >> 6; const float a = inp<I_LQ1>()[l * 64 + plane] * inp<I_LK1>()[l * 64 + plane], b = inp<I_LQ2>()[l * 64 + plane] * inp<I_LK2>()[l * 64 + plane];
        const float sa = wave_sum(a), sb = wave_sum(b); const float lam_init = 0.8f - 0.6f * expf(-0.3f * (float)l);
        if (plane == 0) WSP(float, WS_SCAL)[l] = expf(sa) - expf(sb) + lam_init;
    }
}
__device__ __forceinline__ void p0b_modreduce(const Args& A, const Frame& F) {
    int tid_ = threadIdx.x; asm volatile("" : "+v"(tid_)); const int ptid = tid_, plane = ptid & 63, pwave = __builtin_amdgcn_readfirstlane(ptid >> 6);
    const int gt = F.vcu * NTHR + ptid, NGT = F.G * NTHR;
    for (int i = gt; i < DEPTH * 5 * MODW; i += NGT) { const int l = i / (5 * MODW), r = i % (5 * MODW), n = r % MODW;
        float s = inp<I_BMOD>()[l * MODW + n]; const float* P = WSP(float, WS_MODP) + (size_t)l * 32 * 5 * MODW + r;
#pragma unroll 8
        for (int kc = 0; kc < 32; ++kc) s += P[(size_t)kc * 5 * MODW];
        WSP(float, WS_MOD)[i] = s; }
}

__device__ __forceinline__ void norm_phase(const Args& A, const Frame& F, int l, int src_mode, const float* g, int shoff, const float* slab, bool skip_ctx) {
    int tid_ = threadIdx.x; asm volatile("" : "+v"(tid_)); const int ptid = tid_, plane = ptid & 63, pwave = __builtin_amdgcn_readfirstlane(ptid >> 6);
    const int gw = F.vcu * NWAVES + pwave, NGW = F.G * NWAVES;
    for (int row = gw; row < M; row += NGW) {
        const int b = row / TOK, rr = row - b * TOK; const bool isctx = rr < CTX; const int bsel = isctx ? 4 : b;
        if (isctx && skip_ctx) continue;
        const bool from_in = src_mode == 1 || (src_mode == 2 && isctx);
        const float* xr = from_in ? xrow_in(A, F, row) : WSP(float, WS_XW) + (size_t)row * DM;
        const float* md = WSP(float, WS_MOD) + ((size_t)l * 5 + bsel) * MODW + shoff;
        f32x4 v[8]; float s = 0.f;
#pragma unroll
        for (int j = 0; j < 8; ++j) v[j] = *(const f32x4*)(xr + 4 * plane + 256 * j);
        if (isctx && slab) {
            const float* sp = slab + (size_t)(b * CTX + rr) * DM + 4 * plane;
            for (int ks = 0; ks < 8; ++ks) {
#pragma unroll
                for (int j = 0; j < 8; ++j) v[j] += *(const f32x4*)(sp + (size_t)ks * 1024 * DM + 256 * j); }
            float* xo = WSP(float, WS_XW) + (size_t)row * DM + 4 * plane;
#pragma unroll
            for (int j = 0; j < 8; ++j) *(f32x4*)(xo + 256 * j) = v[j];
        }
#pragma unroll
        for (int j = 0; j < 8; ++j) s += (v[j].x * v[j].x + v[j].y * v[j].y) + (v[j].z * v[j].z + v[j].w * v[j].w);
        const float rstd = 1.0f / sqrtf(wave_sum(s) * (1.f / DM) + EPS);
        bf16* o = WSP(bf16, WS_HN) + (size_t)row * DM;
#pragma unroll
        for (int j = 0; j < 8; ++j) { const int c = 4 * plane + 256 * j; const f32x4 gg = *(const f32x4*)(g + c), sh = *(const f32x4*)(md + c), sc = *(const f32x4*)(md + DM + c);
            const f32x4 y = (v[j] * rstd) * gg * (sc + 1.0f) + sh; u32x2 w; w.x = cvtpk(y.x, y.y); w.y = cvtpk(y.z, y.w); *(u32x2*)(o + c) = w; }
    }
}
__device__ __forceinline__ void final_norm_phase(const Args& A, const Frame& F) {
    int tid_ = threadIdx.x; asm volatile("" : "+v"(tid_)); const int ptid = tid_, plane = ptid & 63, pwave = __builtin_amdgcn_readfirstlane(ptid >> 6);
    const int gw = F.vcu * NWAVES + pwave, NGW = F.G * NWAVES; const float* g = inp<I_GFINAL>();
    for (int r = gw; r < NB * SEQ; r += NGW) {
        const int b = r / SEQ, t = r - b * SEQ; const float* xr = WSP(float, WS_XW) + (size_t)(b * TOK + CTX + t) * DM;
        f32x4 v[8]; float s = 0.f;
#pragma unroll
        for (int j = 0; j < 8; ++j) { v[j] = *(const f32x4*)(xr + 4 * plane + 256 * j); s += (v[j].x * v[j].x + v[j].y * v[j].y) + (v[j].z * v[j].z + v[j].w * v[j].w); }
        const float rstd = 1.0f / sqrtf(wave_sum(s) * (1.f / DM) + EPS);
        float* o = F.out + (size_t)r * DM;
#pragma unroll
        for (int j = 0; j < 8; ++j) { const int c = 4 * plane + 256 * j; const f32x4 gg = *(const f32x4*)(g + c); *(f32x4*)(o + c) = (v[j] * rstd) * gg; }
    }
}

struct TileOrder {
    int nM, nN, nwg, G, c, mode, nsplit, kslice;
    __device__ void init(int N, int G_, int c_, int mode_, int nsplit_ = 1, int kslice_ = 0) { mode = mode_; nsplit = nsplit_; kslice = kslice_; nM = mode_ == 0 ? 36 : (mode_ == 1 ? 32 : 4); nN = N / 256; nwg = nM * nN * nsplit_; G = G_; c = c_; }
    __device__ bool next(int i, pg8::Unit& u) const {
        const long L = (long)i * G + c; if (L >= nwg) return false;
        int wgid = (int)L; { const int q = nwg / 8, r = nwg % 8, xcd = wgid % 8, off = wgid / 8; wgid = (xcd < r ? xcd * (q + 1) : r * (q + 1) + (xcd - r) * q) + off; }
        if (mode == 3) {
            const int per = 4 * nN, ks = wgid / per, rem = wgid - ks * per; u.ks = ks; u.k0 = ks * kslice; u.pn = rem >> 2; u.pm = (rem & 3) * 9; return true; }
        const int nig = 8 * nN, gid = wgid / nig, fm = gid * 8, gsz = (nM - fm) < 8 ? (nM - fm) : 8;
        int pm = fm + ((wgid % nig) % gsz); u.pn = (wgid % nig) / gsz;
        if (mode == 1) pm = (pm >> 3) * 9 + 1 + (pm & 7); else if (mode == 2) pm = pm * 9;
        u.pm = pm; u.k0 = 0; u.ks = 0; return true;
    }
    __device__ __forceinline__ void a_ready(const pg8::Unit&) const {}
    __device__ __forceinline__ void done(const pg8::Unit&) const {}
};

__device__ __forceinline__ void rope8(f32x4& v0, f32x4& v1, const float* ropetab, int pos, int f0) {
    const f32x4 c = *(const f32x4*)(ropetab + pos * 16 + f0), s = *(const f32x4*)(ropetab + 1024 + pos * 16 + f0);
    const f32x4 a = v0, b = v1;
    v0[0] = a[0] * c[0] - a[1] * s[0]; v0[1] = a[0] * s[0] + a[1] * c[0]; v0[2] = a[2] * c[1] - a[3] * s[1]; v0[3] = a[2] * s[1] + a[3] * c[1];
    v1[0] = b[0] * c[2] - b[1] * s[2]; v1[1] = b[0] * s[2] + b[1] * c[2]; v1[2] = b[2] * c[3] - b[3] * s[3]; v1[3] = b[2] * s[3] + b[3] * c[3];
}
__device__ __forceinline__ f32x4 gelu4(f32x4 v) { const f32x2 a = pg8::gelu_pk((f32x2){v[0], v[1]}), b = pg8::gelu_pk((f32x2){v[2], v[3]}); return (f32x4){a.x, a.y, b.x, b.y}; }
__device__ __forceinline__ float ss8(f32x4 a, f32x4 b) { return (a[0] * a[0] + a[1] * a[1]) + (a[2] * a[2] + a[3] * a[3]) + (b[0] * b[0] + b[1] * b[1]) + (b[2] * b[2] + b[3] * b[3]); }

struct EpiZ {
    static constexpr bool PERM = true, AFTER_DRAIN = false;
    unsigned char* ws; const float* ropetab;
    __device__ __forceinline__ void operator()(const f32x4 (&acc)[2][2][4][2], const pg8::Unit& u, int wr, int wc, int fr, int fq) const {
        const int pn = u.pn;
#pragma unroll
        for (int ai = 0; ai < 2; ++ai)
#pragma unroll
            for (int m = 0; m < 4; ++m) {
                const int row = u.pm * 256 + ai * 128 + wr * 64 + m * 16 + fr;
                const int b = row / TOK, rr = row - b * TOK; const bool lat = rr >= CTX; const int t = rr - CTX, prow = (t >> 6) & 31, pcol = t & 63;
                float ssq = 0.f;
#pragma unroll
                for (int bj = 0; bj < 2; ++bj) {
                    const int colt = bj * 128 + wc * 32 + 8 * fq;
                    f32x4 v0 = acc[ai][bj][m][0], v1 = acc[ai][bj][m][1];
                    if (pn < 6) {
                        if (lat) { const int j0 = (colt & 63) >> 1; rope8(v0, v1, ropetab, j0 < 16 ? prow : pcol, j0 & 15); }
                        if (pn < 3) { v0 *= DA_QS; v1 *= DA_QS; *(u32x4*)((bf16*)(ws + WS_QDA) + (size_t)row * 768 + pn * 256 + colt) = pack8(v0, v1); }
                        else *(u32x4*)((bf16*)(ws + WS_KDA) + (size_t)row * 768 + (pn - 3) * 256 + colt) = pack8(v0, v1);
                    } else if (pn < 9) {
                        *(u32x4*)((bf16*)(ws + WS_VDA) + (size_t)row * 768 + (pn - 6) * 256 + colt) = pack8(v0, v1);
                    } else if (pn < 11) {
                        float* o = (float*)(ws + WS_U) + (size_t)row * 512 + (pn - 9) * 256 + colt; *(f32x4*)o = gelu4(v0); *(f32x4*)(o + 4) = gelu4(v1);
                    } else if (pn < 13) {
                        v0 = gelu4(v0); v1 = gelu4(v1);
                        float* o = (float*)(ws + WS_GV) + (size_t)row * 512 + (pn - 11) * 256 + colt; *(f32x4*)o = v0; *(f32x4*)(o + 4) = v1;
                        float s = ss8(v0, v1); s += __shfl_xor(s, 16); s += __shfl_xor(s, 32);
                        if (fq == 0) ((float*)(ws + WS_GVSS))[(size_t)row * 16 + ((pn - 11) * 2 + bj) * 4 + wc] = s;
                    } else if (pn < 15) {
                        *(u32x4*)((bf16*)(ws + WS_CQ) + (size_t)row * 512 + (pn - 13) * 256 + colt) = pack8(v0, v1); ssq += ss8(v0, v1);
                    } else if (pn < 17) {
                        *(u32x4*)((bf16*)(ws + WS_CKV) + (size_t)row * 512 + (pn - 15) * 256 + colt) = pack8(v0, v1); ssq += ss8(v0, v1);
                    } else {
                        if (colt < 64) {
                            if (lat) { const int j0 = colt >> 1; rope8(v0, v1, ropetab, j0 < 16 ? prow : pcol, j0 & 15); }
                            const u32x4 w = pack8(v0, v1); bf16* o = (bf16*)(ws + WS_KMLA) + (size_t)row * 1152 + 128 + colt;
#pragma unroll
                            for (int h = 0; h < 6; ++h) *(u32x4*)(o + h * 192) = w;
                        }
                    }
                }
                if (pn >= 13 && pn < 17) {
                    ssq += __shfl_xor(ssq, 16); ssq += __shfl_xor(ssq, 32);
                    if (fq == 0) { if (pn < 15) ((float*)(ws + WS_CQSS))[(size_t)row * 8 + (pn - 13) * 4 + wc] = ssq; else ((float*)(ws + WS_CKVSS))[(size_t)row * 8 + (pn - 15) * 4 + wc] = ssq; }
                }
            }
    }
};
__device__ __forceinline__ float rstd8(const float* p, float inv_n) { const f32x4 a = *(const f32x4*)p, b = *(const f32x4*)(p + 4); return 1.0f / sqrtf(((a[0] + a[1]) + (a[2] + a[3]) + (b[0] + b[1]) + (b[2] + b[3])) * inv_n + EPS); }

struct EpiKV {
    static constexpr bool PERM = true, AFTER_DRAIN = false;
    unsigned char* ws;
    __device__ __forceinline__ void operator()(const f32x4 (&acc)[2][2][4][2], const pg8::Unit& u, int wr, int wc, int fr, int fq) const {
#pragma unroll
        for (int ai = 0; ai < 2; ++ai)
#pragma unroll
            for (int m = 0; m < 4; ++m) {
                const int row = u.pm * 256 + ai * 128 + wr * 64 + m * 16 + fr;
                const float rs = rstd8((const float*)(ws + WS_CKVSS) + (size_t)row * 8, 1.f / RANK);
                const int c = wc * 32 + 8 * fq;
                *(u32x4*)((bf16*)(ws + WS_KMLA) + (size_t)row * 1152 + u.pn * 192 + c) = pack8(acc[ai][0][m][0] * rs, acc[ai][0][m][1] * rs);
                *(u32x4*)((bf16*)(ws + WS_VMLA) + (size_t)row * 768 + u.pn * 128 + c) = pack8(acc[ai][1][m][0] * rs, acc[ai][1][m][1] * rs);
            }
    }
};
struct EpiQ {
    static constexpr bool PERM = true, AFTER_DRAIN = false;
    unsigned char* ws; const float* ropetab;
    __device__ __forceinline__ void operator()(const f32x4 (&acc)[2][2][4][2], const pg8::Unit& u, int wr, int wc, int fr, int fq) const {
#pragma unroll
        for (int ai = 0; ai < 2; ++ai)
#pragma unroll
            for (int m = 0; m < 4; ++m) {
                const int row = u.pm * 256 + ai * 128 + wr * 64 + m * 16 + fr;
                const int b = row / TOK, rr = row - b * TOK; const bool lat = rr >= CTX; const int t = rr - CTX, prow = (t >> 6) & 31, pcol = t & 63;
                const float rs = rstd8((const float*)(ws + WS_CQSS) + (size_t)row * 8, 1.f / RANK) * MLA_QS;
#pragma unroll
                for (int bj = 0; bj < 2; ++bj) {
                    const int col = u.pn * 256 + bj * 128 + wc * 32 + 8 * fq;
                    if (col < NUQ) {
                        f32x4 v0 = acc[ai][bj][m][0] * rs, v1 = acc[ai][bj][m][1] * rs;
                        const int hd = col / 192, i = col - hd * 192;
                        if (lat && i >= 128) { const int j0 = (i - 128) >> 1; rope8(v0, v1, ropetab, j0 < 16 ? prow : pcol, j0 & 15); }
                        *(u32x4*)((bf16*)(ws + WS_QMLA) + (size_t)row * 1152 + col) = pack8(v0, v1);
                    }
                }
            }
    }
};
struct EpiResid {
    static constexpr bool PERM = true, AFTER_DRAIN = false;
    unsigned char* ws; const float* xin; const float* cin; const float* gate; bool from_inputs;
    __device__ __forceinline__ void operator()(const f32x4 (&acc)[2][2][4][2], const pg8::Unit& u, int wr, int wc, int fr, int fq) const {
        const int b = u.pm / 9; const bool isctx = (u.pm - b * 9) == 0; const int bsel = isctx ? 4 : b;
        const float* gp = gate + (size_t)bsel * MODW + u.pn * 256 + wc * 32 + 8 * fq;
        f32x4 g[2][2];
#pragma unroll
        for (int bj = 0; bj < 2; ++bj) { g[bj][0] = *(const f32x4*)(gp + bj * 128); g[bj][1] = *(const f32x4*)(gp + bj * 128 + 4); }
#pragma unroll
        for (int ai = 0; ai < 2; ++ai)
#pragma unroll
            for (int m = 0; m < 4; ++m) {
                const int row = u.pm * 256 + ai * 128 + wr * 64 + m * 16 + fr; const int rr = row - b * TOK;
                const float* bp = from_inputs ? (isctx ? cin + (size_t)(b * CTX + rr) * DM : xin + (size_t)(b * SEQ + rr - CTX) * DM) : (const float*)(ws + WS_XW) + (size_t)row * DM;
                float* op = (float*)(ws + WS_XW) + (size_t)row * DM;
#pragma unroll
                for (int bj = 0; bj < 2; ++bj) { const int c = u.pn * 256 + bj * 128 + wc * 32 + 8 * fq;
                    const f32x4 b0 = *(const f32x4*)(bp + c), b1 = *(const f32x4*)(bp + c + 4);
                    *(f32x4*)(op + c) = b0 + g[bj][0] * acc[ai][bj][m][0]; *(f32x4*)(op + c + 4) = b1 + g[bj][1] * acc[ai][bj][m][1]; }
            }
    }
};
struct EpiSlab {
    static constexpr bool PERM = true, AFTER_DRAIN = false;
    float* slab; const float* gate;
    __device__ __forceinline__ void operator()(const f32x4 (&acc)[2][2][4][2], const pg8::Unit& u, int wr, int wc, int fr, int fq) const {
        const int b = u.pm / 9; const float* gp = gate + u.pn * 256 + wc * 32 + 8 * fq;
        f32x4 g[2][2];
#pragma unroll
        for (int bj = 0; bj < 2; ++bj) { g[bj][0] = *(const f32x4*)(gp + bj * 128); g[bj][1] = *(const f32x4*)(gp + bj * 128 + 4); }
#pragma unroll
        for (int ai = 0; ai < 2; ++ai)
#pragma unroll
            for (int m = 0; m < 4; ++m) {
                const int crow_ = b * CTX + ai * 128 + wr * 64 + m * 16 + fr;
                float* op = slab + ((size_t)u.ks * 1024 + crow_) * DM + u.pn * 256 + wc * 32 + 8 * fq;
#pragma unroll
                for (int bj = 0; bj < 2; ++bj) { *(f32x4*)(op + bj * 128) = g[bj][0] * acc[ai][bj][m][0]; *(f32x4*)(op + bj * 128 + 4) = g[bj][1] * acc[ai][bj][m][1]; }
            }
    }
};
struct EpiFc1 {
    static constexpr bool PERM = true, AFTER_DRAIN = false;
    unsigned char* ws;
    __device__ __forceinline__ void operator()(const f32x4 (&acc)[2][2][4][2], const pg8::Unit& u, int wr, int wc, int fr, int fq) const {
#pragma unroll
        for (int ai = 0; ai < 2; ++ai)
#pragma unroll
            for (int m = 0; m < 4; ++m) {
                const int row = u.pm * 256 + ai * 128 + wr * 64 + m * 16 + fr;
#pragma unroll
                for (int bj = 0; bj < 2; ++bj) { const int c = u.pn * 256 + bj * 128 + wc * 32 + 8 * fq;
                    f32x4 v0 = __builtin_elementwise_max(acc[ai][bj][m][0], (f32x4){0.f, 0.f, 0.f, 0.f}), v1 = __builtin_elementwise_max(acc[ai][bj][m][1], (f32x4){0.f, 0.f, 0.f, 0.f});
                    *(u32x4*)((bf16*)(ws + WS_ACT) + (size_t)row * FF + c) = pack8(v0 * v0, v1 * v1); }
            }
    }
};
#define XB_TMO      128
#define XB_XCNT(j)  (256  + 64 * (j))
#define XB_XSUB(j)  (1280 + 64 * (j))
#define XB_XGEN(j)  (2304 + 64 * (j))
#define XB_TOP      3328
#define XB_TOPGEN   3392
#define XCD_BAR_WORDS 3456
#define XB_SPIN_CAP (1u << 18)

__device__ __forceinline__ unsigned xb_ld(unsigned* p)              { return __hip_atomic_load(p, __ATOMIC_RELAXED, __HIP_MEMORY_SCOPE_AGENT); }
__device__ __forceinline__ unsigned xb_add(unsigned* p, unsigned v) { return __hip_atomic_fetch_add(p, v, __ATOMIC_RELAXED, __HIP_MEMORY_SCOPE_AGENT); }
__device__ __forceinline__ unsigned xb_xcc_id() { return (unsigned)__builtin_amdgcn_s_getreg((3 << 11) | 20) & 0xFu; }
#define XB_SPIN(cond, bar) do { unsigned _sp = 0; while (cond) { __builtin_amdgcn_s_sleep(1); \
    if ((++_sp & 255u) == 0u) { if (xb_ld(&(bar)[XB_TMO])) break; if (_sp > XB_SPIN_CAP) { atomicAdd(&(bar)[XB_TMO], 1u); break; } } } } while (0)

struct XcdBarrier {
    unsigned* bar; unsigned x;
    volatile LAS unsigned* st;
};

__device__ __forceinline__ XcdBarrier xcd_barrier_post(unsigned* bar, volatile LAS unsigned* st) {
    XcdBarrier b; b.bar = bar; b.x = xb_xcc_id(); b.st = st;
    if (threadIdx.x == 0) (void)xb_add(&bar[XB_XCNT(b.x)], 1u);
    return b;
}
__device__ __forceinline__ void xcd_barrier_complete(unsigned* bar, unsigned x, unsigned& nloc, unsigned& nx) {
    const unsigned G = gridDim.x * gridDim.y * gridDim.z;
    unsigned sum, cnt, mine, sp = 0u;
    for (;;) {
        sum = 0u; cnt = 0u; mine = 0u;
#pragma unroll
        for (unsigned j = 0; j < 16; ++j) { const unsigned c = xb_ld(&bar[XB_XCNT(j)]); sum += c; cnt += (c > 0u) ? 1u : 0u; mine = (j == x) ? c : mine; }
        if (sum == G) break;
        __builtin_amdgcn_s_sleep(1);
        if ((++sp & 255u) == 0u) { if (xb_ld(&bar[XB_TMO])) break; if (sp > XB_SPIN_CAP) { atomicAdd(&bar[XB_TMO], 1u); break; } }
    }
    nloc = mine > 0u ? mine : 1u; nx = cnt > 0u ? cnt : 1u;
}

__device__ __forceinline__ void xcd_barrier(const XcdBarrier& b) {
    asm volatile("s_waitcnt vmcnt(0)" ::: "memory");
    __syncthreads();
    if (threadIdx.x == 0) {
        unsigned* bar = b.bar;
        __builtin_amdgcn_s_waitcnt(0);
        unsigned nloc = b.st[0], nx = b.st[1];
        if (nloc == 0u) { xcd_barrier_complete(bar, b.x, nloc, nx); b.st[0] = nloc; b.st[1] = nx; }
        const unsigned old = xb_add(&bar[XB_XSUB(b.x)], 1u);
        const unsigned gen = old / nloc;
        if (old + 1u == (gen + 1u) * nloc) {
            __builtin_amdgcn_fence(__ATOMIC_RELEASE, "agent");
            asm volatile("s_waitcnt vmcnt(0)" ::: "memory");
            const unsigned og = xb_add(&bar[XB_TOP], 1u);
            const unsigned tg = og / nx;
            if (og + 1u == (tg + 1u) * nx) xb_add(&bar[XB_TOPGEN], 1u);
            else XB_SPIN(xb_ld(&bar[XB_TOPGEN]) == tg, bar);
            __builtin_amdgcn_fence(__ATOMIC_ACQUIRE, "agent");
            xb_add(&bar[XB_XGEN(b.x)], 1u);
            asm volatile("s_waitcnt vmcnt(0)" ::: "memory");
        } else {
            XB_SPIN(xb_ld(&bar[XB_XGEN(b.x)]) == gen, bar);
            __builtin_amdgcn_fence(__ATOMIC_ACQUIRE, "agent");
            asm volatile("s_waitcnt vmcnt(0)" ::: "memory");
        }
    }
    __syncthreads();
}

namespace att {
#define SBAR() __builtin_amdgcn_sched_barrier(0)
constexpr int V_TILE = 64 * 128 * 2, K_OFF = 2 * V_TILE, K_TILE_MAX = 64 * 192 * 2, WS_OFF = K_OFF + 2 * K_TILE_MAX;
constexpr float THR = 6.0f;
__device__ __forceinline__ int crow(int r, int hi) { return (r & 3) + 8 * (r >> 2) + 4 * hi; }
__device__ __forceinline__ int v_st(int k, int c) { const int kk = (k & ~0xC) | ((k & 4) << 1) | ((k & 8) >> 1); return ((kk >> 3) * 4 + (c >> 5)) * 512 + ((kk & 7) * 32 + (c & 31)) * 2; }
__device__ __forceinline__ int v_rd_base(int lane) { return ((lane & 3) << 3) | (((lane >> 2) & 3) << 6) | (((lane >> 4) & 1) << 5) | (((lane >> 5) & 1) << 8); }
constexpr int v_rd_off(int d0, int ks, int half) { return d0 * 512 + ks * 4096 + half * 2048; }
template <int OFF> __device__ __forceinline__ s16x4 tr_read(int vb) { s16x4 r; asm volatile("ds_read_b64_tr_b16 %0, %1 offset:%2" : "=&v"(r) : "v"(vb), "i"(OFF) : "memory"); return r; }
template <int D0> __device__ __forceinline__ void pv_one(f32x16& od, int vb, bf16x8 pa0, bf16x8 pa1, bf16x8 pa2, bf16x8 pa3) {
    const s16x4 l0 = tr_read<v_rd_off(D0, 0, 0)>(vb), h0 = tr_read<v_rd_off(D0, 0, 1)>(vb), l1 = tr_read<v_rd_off(D0, 1, 0)>(vb), h1 = tr_read<v_rd_off(D0, 1, 1)>(vb);
    const s16x4 l2 = tr_read<v_rd_off(D0, 2, 0)>(vb), h2 = tr_read<v_rd_off(D0, 2, 1)>(vb), l3 = tr_read<v_rd_off(D0, 3, 0)>(vb), h3 = tr_read<v_rd_off(D0, 3, 1)>(vb);
    asm volatile("s_waitcnt lgkmcnt(0)" ::: "memory"); SBAR();
#define PK(L, H) (bf16x8){L[0], L[1], L[2], L[3], H[0], H[1], H[2], H[3]}
    od = __builtin_amdgcn_mfma_f32_32x32x16_bf16(pa0, PK(l0, h0), od, 0, 0, 0);
    od = __builtin_amdgcn_mfma_f32_32x32x16_bf16(pa1, PK(l1, h1), od, 0, 0, 0);
    od = __builtin_amdgcn_mfma_f32_32x32x16_bf16(pa2, PK(l2, h2), od, 0, 0, 0);
    od = __builtin_amdgcn_mfma_f32_32x32x16_bf16(pa3, PK(l3, h3), od, 0, 0, 0);
#undef PK
}

template <int KS> __device__ __forceinline__ void v_read8(int vb, s16x4 (&L)[4], s16x4 (&H)[4]) {
    L[0] = tr_read<v_rd_off(0, KS, 0)>(vb); H[0] = tr_read<v_rd_off(0, KS, 1)>(vb); L[1] = tr_read<v_rd_off(1, KS, 0)>(vb); H[1] = tr_read<v_rd_off(1, KS, 1)>(vb);
    L[2] = tr_read<v_rd_off(2, KS, 0)>(vb); H[2] = tr_read<v_rd_off(2, KS, 1)>(vb); L[3] = tr_read<v_rd_off(3, KS, 0)>(vb); H[3] = tr_read<v_rd_off(3, KS, 1)>(vb);
}
#define PKV(L, H) (bf16x8){L[0], L[1], L[2], L[3], H[0], H[1], H[2], H[3]}
__device__ __forceinline__ void pv_mma4(f32x16 (&o)[4], bf16x8 pa, const s16x4 (&L)[4], const s16x4 (&H)[4]) {
    o[0] = __builtin_amdgcn_mfma_f32_32x32x16_bf16(pa, PKV(L[0], H[0]), o[0], 0, 0, 0);
    o[1] = __builtin_amdgcn_mfma_f32_32x32x16_bf16(pa, PKV(L[1], H[1]), o[1], 0, 0, 0);
    o[2] = __builtin_amdgcn_mfma_f32_32x32x16_bf16(pa, PKV(L[2], H[2]), o[2], 0, 0, 0);
    o[3] = __builtin_amdgcn_mfma_f32_32x32x16_bf16(pa, PKV(L[3], H[3]), o[3], 0, 0, 0);
}
__device__ __forceinline__ void pv_all(f32x16 (&o)[4], int vb, bf16x8 pa0, bf16x8 pa1, bf16x8 pa2, bf16x8 pa3) {
    s16x4 LA[4], HA[4], LB[4], HB[4];
    v_read8<0>(vb, LA, HA); v_read8<1>(vb, LB, HB);
    asm volatile("s_waitcnt lgkmcnt(8)" ::: "memory"); SBAR(); pv_mma4(o, pa0, LA, HA); SBAR();
    v_read8<2>(vb, LA, HA);
    asm volatile("s_waitcnt lgkmcnt(8)" ::: "memory"); SBAR(); pv_mma4(o, pa1, LB, HB); SBAR();
    v_read8<3>(vb, LB, HB);
    asm volatile("s_waitcnt lgkmcnt(8)" ::: "memory"); SBAR(); pv_mma4(o, pa2, LA, HA); SBAR();
    asm volatile("s_waitcnt lgkmcnt(0)" ::: "memory"); SBAR(); pv_mma4(o, pa3, LB, HB);
}
#undef PKV
template <int DQK> __device__ __forceinline__ int k_off(int r, int c) { return r * (DQK * 2) + ((c ^ ((r >> 1) & 7)) << 4); }

template <int DQK>
__device__ __forceinline__ void attn_pass(f32x16 (&o)[4], const bf16* __restrict__ Qw, int ldq, const bf16* __restrict__ Kb, int ldk, const bf16* __restrict__ Vb, int ldv, int NT, LAS unsigned char* lds) {
    constexpr int KT = 64 * DQK * 2, NKC = DQK / 8, NKS = (64 * NKC) / NTHR, ND = DQK / 16;
    int tid_ = threadIdx.x; asm volatile("" : "+v"(tid_)); const int tid = tid_, wid = tid >> 6, lane = tid & 63, r32 = lane & 31, hi = lane >> 5;
    LAS unsigned char* V_lds = lds; LAS unsigned char* K_lds = lds + K_OFF;
    LAS float* wsf = (LAS float*)(lds + WS_OFF) + wid * 64;
    bf16x8 qr[ND];
#pragma unroll
    for (int d0 = 0; d0 < ND; ++d0) qr[d0] = *(const bf16x8*)(Qw + (size_t)r32 * ldq + d0 * 16 + hi * 8);
    unsigned kgo[NKS]; int klo[NKS];
#pragma unroll
    for (int i = 0; i < NKS; ++i) { const int idx = tid + NTHR * i, r = idx / NKC, c = idx - r * NKC; kgo[i] = (unsigned)(r * ldk + c * 8) * 2u; klo[i] = k_off<DQK>(r, c); }
    const int sr = tid >> 4, sc = (tid & 15) * 8, vst0 = v_st(sr, sc), vst1 = v_st(32 + sr, sc);
    const unsigned vgo0 = (unsigned)(sr * ldv + sc) * 2u, vgo1 = (unsigned)((32 + sr) * ldv + sc) * 2u;
    const int vb0 = (int)(uintptr_t)V_lds + v_rd_base(lane);
    bf16x8 ksA[NKS], vsA0, vsA1, ksB[NKS], vsB0, vsB1;
#define SLOAD(S, k0) do { const char* kt_ = (const char*)(Kb + (size_t)(k0) * ldk); const char* vt_ = (const char*)(Vb + (size_t)(k0) * ldv); \
        _Pragma("unroll") for (int i_ = 0; i_ < NKS; ++i_) ks##S[i_] = *(const bf16x8*)(kt_ + kgo[i_]); \
        vs##S##0 = *(const bf16x8*)(vt_ + vgo0); vs##S##1 = *(const bf16x8*)(vt_ + vgo1); } while (0)
#define SWRITE(S, buf) do { _Pragma("unroll") for (int i_ = 0; i_ < NKS; ++i_) *(LAS bf16x8*)(K_lds + (buf) * KT + klo[i_]) = ks##S[i_]; \
        *(LAS bf16x8*)(V_lds + (buf) * V_TILE + vst0) = vs##S##0; *(LAS bf16x8*)(V_lds + (buf) * V_TILE + vst1) = vs##S##1; } while (0)
    float m_reg = -1e30f, l_reg = 0.f;
#pragma unroll
    for (int d = 0; d < 4; ++d) o[d] = f32x16{};
#define TILE(buf) do { \
        f32x16 p0 = f32x16{}, p1 = f32x16{}; \
        { const LAS unsigned char* Kt = K_lds + (buf) * KT; \
          _Pragma("unroll") for (int d0 = 0; d0 < ND; ++d0) { \
              const bf16x8 b0 = *(const LAS bf16x8*)(Kt + k_off<DQK>(r32, 2 * d0 + hi)), b1 = *(const LAS bf16x8*)(Kt + k_off<DQK>(32 + r32, 2 * d0 + hi)); \
              p0 = __builtin_amdgcn_mfma_f32_32x32x16_bf16(b0, qr[d0], p0, 0, 0, 0); \
              p1 = __builtin_amdgcn_mfma_f32_32x32x16_bf16(b1, qr[d0], p1, 0, 0, 0); } } \
        float pmax = p0[0]; \
        _Pragma("unroll") for (int r = 1; r < 16; ++r) pmax = fmaxf(pmax, p0[r]); \
        _Pragma("unroll") for (int r = 0; r < 16; ++r) pmax = fmaxf(pmax, p1[r]); \
        { auto rr = __builtin_amdgcn_permlane32_swap(__float_as_uint(pmax), __float_as_uint(pmax), false, false); pmax = fmaxf(__uint_as_float(rr[0]), __uint_as_float(rr[1])); } \
        float alpha = 1.f; \
        if (!__all(pmax - m_reg <= THR)) { const float mn = fmaxf(m_reg, pmax); alpha = __builtin_amdgcn_exp2f(m_reg - mn); m_reg = mn; \
            if (hi == 0) wsf[r32] = alpha; asm volatile("s_waitcnt lgkmcnt(0)" ::: "memory"); \
            _Pragma("unroll") for (int r = 0; r < 16; ++r) { const float a = wsf[crow(r, hi)]; \
                _Pragma("unroll") for (int d = 0; d < 4; ++d) o[d][r] *= a; } \
            asm volatile("s_waitcnt lgkmcnt(0)" ::: "memory"); } \
        float ps = 0.f; \
        _Pragma("unroll") for (int r = 0; r < 16; ++r) { p0[r] = __builtin_amdgcn_exp2f(p0[r] - m_reg); p1[r] = __builtin_amdgcn_exp2f(p1[r] - m_reg); ps += p0[r] + p1[r]; } \
        { auto rr = __builtin_amdgcn_permlane32_swap(__float_as_uint(ps), __float_as_uint(ps), false, false); ps = __uint_as_float(rr[0]) + __uint_as_float(rr[1]); } \
        l_reg = l_reg * alpha + ps; \
        bf16x8 pa0, pa1, pa2, pa3; \
        PK4(p0, 0, pa0); PK4(p0, 8, pa1); PK4(p1, 0, pa2); PK4(p1, 8, pa3); \
        SBAR(); \
        { const int vb = vb0 + (buf) * V_TILE; \
          if constexpr (DQK == 64) pv_all(o, vb, pa0, pa1, pa2, pa3); else { pv_one<0>(o[0], vb, pa0, pa1, pa2, pa3); pv_one<1>(o[1], vb, pa0, pa1, pa2, pa3); pv_one<2>(o[2], vb, pa0, pa1, pa2, pa3); pv_one<3>(o[3], vb, pa0, pa1, pa2, pa3); } } \
    } while (0)
#define PK4(P, BASE, OUT) do { unsigned a0 = cvtpk(P[BASE + 0], P[BASE + 1]), a1 = cvtpk(P[BASE + 2], P[BASE + 3]); \
        unsigned b0 = cvtpk(P[BASE + 4], P[BASE + 5]), b1 = cvtpk(P[BASE + 6], P[BASE + 7]); \
        auto r0 = __builtin_amdgcn_permlane32_swap(a0, b0, false, false); auto r1 = __builtin_amdgcn_permlane32_swap(a1, b1, false, false); \
        u32x4 w = {r0[0], r1[0], r0[1], r1[1]}; OUT = __builtin_bit_cast(bf16x8, w); } while (0)
    if constexpr (DQK == 64) {
    SLOAD(A, 0); SLOAD(B, 64); SWRITE(A, 0); __syncthreads();
    for (int j = 0; j < NT; j += 2) {
        { const int t2 = (j + 2 < NT) ? j + 2 : NT - 2; SLOAD(A, t2 * 64); }
        TILE(0);
        SWRITE(B, 1);
        __syncthreads();
        { const int t3 = (j + 3 < NT) ? j + 3 : NT - 1; SLOAD(B, t3 * 64); }
        TILE(1);
        SWRITE(A, 0);
        __syncthreads();
    }
    } else {
    SLOAD(A, 0); SWRITE(A, 0); __syncthreads();
    for (int j = 0; j < NT; j += 2) {
        SLOAD(A, (j + 1) * 64);
        TILE(0);
        SWRITE(A, 1);
        __syncthreads();
        if (j + 2 < NT) SLOAD(A, (j + 2) * 64);
        TILE(1);
        if (j + 2 < NT) SWRITE(A, 0);
        __syncthreads();
    }
    }
#undef PK4
#undef TILE
    if (hi == 0) wsf[32 + r32] = l_reg; asm volatile("s_waitcnt lgkmcnt(0)" ::: "memory");
#pragma unroll
    for (int r = 0; r < 16; ++r) { const float rl = 1.0f / wsf[32 + crow(r, hi)];
#pragma unroll
        for (int d = 0; d < 4; ++d) o[d][r] *= rl; }
    asm volatile("s_waitcnt lgkmcnt(0)" ::: "memory");
#undef SLOAD
#undef SWRITE
}


__device__ __forceinline__ void store_o(const f32x16 (&o)[4], const float (&rs)[16], const float (&gcol)[4], bf16* dst, int ld, LAS unsigned char* lds, int wid, int lane) {
    const int r32 = lane & 31, hi = lane >> 5;
    LAS unsigned short* stg = (LAS unsigned short*)(lds + wid * 8192);
#pragma unroll
    for (int d = 0; d < 4; ++d)
#pragma unroll
        for (int r = 0; r < 16; ++r) stg[crow(r, hi) * 128 + d * 32 + r32] = (unsigned short)(cvtpk(o[d][r] * rs[r] * gcol[d], 0.f) & 0xffffu);
    asm volatile("s_waitcnt lgkmcnt(0)" ::: "memory");
    bf16* p = dst + (size_t)(lane >> 4) * ld + (lane & 15) * 8;
#pragma unroll
    for (int i = 0; i < 8; ++i) { const u32x4 v = *(const LAS u32x4*)(stg + (i * 4 + (lane >> 4)) * 128 + (lane & 15) * 8); *(u32x4*)p = v; p += 4 * (size_t)ld; asm volatile("" : "+v"(p)); }
}

__device__ __forceinline__ void da_unit(const Args& A, const Frame& F, int l, int q0, int k0, int NT, int h) {
    int tid_ = threadIdx.x; asm volatile("" : "+v"(tid_)); const int tid = tid_, wid = tid >> 6, lane = tid & 63, r32 = lane & 31, hi = lane >> 5;
    const bf16* Q = WSP(bf16, WS_QDA); const bf16* K = WSP(bf16, WS_KDA); const bf16* V = WSP(bf16, WS_VDA);
    float* stash = WSP(float, WS_STASH) + ((size_t)blockIdx.x * NTHR + tid) * 64;
    const float lam = WSP(float, WS_SCAL)[l]; const float lam_init = 0.8f - 0.6f * expf(-0.3f * (float)l);
    f32x16 o[4];
    attn_pass<64>(o, Q + (size_t)(q0 + wid * 32) * 768 + (2 * h) * 64, 768, K + (size_t)k0 * 768 + (2 * h) * 64, 768, V + (size_t)k0 * 768 + h * 128, 768, NT, F.lds);
#pragma unroll
    for (int d = 0; d < 4; ++d)
#pragma unroll
        for (int r = 0; r < 16; r += 4) *(f32x4*)(stash + d * 16 + r) = (f32x4){o[d][r], o[d][r + 1], o[d][r + 2], o[d][r + 3]};
    attn_pass<64>(o, Q + (size_t)(q0 + wid * 32) * 768 + (2 * h + 1) * 64, 768, K + (size_t)k0 * 768 + (2 * h + 1) * 64, 768, V + (size_t)k0 * 768 + h * 128, 768, NT, F.lds);
    float ss[16];
#pragma unroll
    for (int r = 0; r < 16; ++r) ss[r] = 0.f;
#pragma unroll
    for (int d = 0; d < 4; ++d) {
#pragma unroll
        for (int r = 0; r < 16; r += 4) { const f32x4 s4 = *(const f32x4*)(stash + d * 16 + r);
#pragma unroll
            for (int e = 0; e < 4; ++e) { const float v = s4[e] - lam * o[d][r + e]; o[d][r + e] = v; ss[r + e] += v * v; } }
        asm volatile("" ::: "memory"); SBAR(); }
#pragma unroll
    for (int r = 0; r < 16; ++r) { float s = ss[r]; s += __shfl_xor(s, 1); s += __shfl_xor(s, 2); s += __shfl_xor(s, 4); s += __shfl_xor(s, 8); s += __shfl_xor(s, 16);
        ss[r] = (1.0f / sqrtf(s * (1.f / 128.f) + EPS)) * (1.f - lam_init); }
    const float* gs = inp<I_GDASUB>() + l * 128;
    float gcol[4];
#pragma unroll
    for (int d = 0; d < 4; ++d) gcol[d] = gs[d * 32 + r32];
    store_o(o, ss, gcol, WSP(bf16, WS_HEADS) + (size_t)(q0 + wid * 32) * DM + h * 128, DM, F.lds, wid, lane);
    __syncthreads();
}
__device__ __forceinline__ void mla_unit(const Args& A, const Frame& F, int q0, int k0, int NT, int h) {
    int tid_ = threadIdx.x; asm volatile("" : "+v"(tid_)); const int tid = tid_, wid = tid >> 6, lane = tid & 63, r32 = lane & 31, hi = lane >> 5;
    f32x16 o[4];
    attn_pass<192>(o, WSP(bf16, WS_QMLA) + (size_t)(q0 + wid * 32) * 1152 + h * 192, 1152, WSP(bf16, WS_KMLA) + (size_t)k0 * 1152 + h * 192, 1152, WSP(bf16, WS_VMLA) + (size_t)k0 * 768 + h * 128, 768, NT, F.lds);
    float rs[16], gcol[4];
#pragma unroll
    for (int r = 0; r < 16; ++r) rs[r] = 1.f;
#pragma unroll
    for (int d = 0; d < 4; ++d) gcol[d] = 1.f;
    store_o(o, rs, gcol, WSP(bf16, WS_HEADS) + (size_t)(q0 + wid * 32) * DM + 1280 + h * 128, DM, F.lds, wid, lane);
    __syncthreads();
}
__device__ __forceinline__ void da_latent(const Args& A, const Frame& F, int l, int v) { const int bh = v >> 3, qb = v & 7, b = bh / 6, h = bh - b * 6; da_unit(A, F, l, b * TOK + CTX + qb * 256, b * TOK, 36, h); }
__device__ __forceinline__ void da_ctx(const Args& A, const Frame& F, int l, int v) { const int b = v / 6, h = v - b * 6; da_unit(A, F, l, b * TOK, b * TOK, 4, h); }
__device__ __forceinline__ void mla_phase(const Args& A, const Frame& F, bool with_ctx) {
    const int nun = with_ctx ? 216 : 192;
    for (int un = F.vcu; un < nun; un += F.G) {
        if (un < 192) { const int bh = un >> 3, qb = un & 7, b = bh / 6, h = bh - b * 6; mla_unit(A, F, b * TOK + CTX + qb * 256, b * TOK, 36, h); }
        else { const int v = un - 192, b = v / 6, h = v - b * 6; mla_unit(A, F, b * TOK, b * TOK, 4, h); }
    }
}

__device__ __forceinline__ void gate_unit(const Args& A, const Frame& F, int l, int ch, int g) {
    int tid_ = threadIdx.x; asm volatile("" : "+v"(tid_)); const int tid = tid_, wid = tid >> 6, lane = tid & 63, r32 = lane & 31, hi = lane >> 5;
    const int r0 = ch * 128;
    LAS unsigned char* img = F.lds;
    { const int sc = (tid & 15) * 8; const float* gain = inp<I_GGMV>() + (l * 4 + g) * 128 + sc; const f32x4 g0 = *(const f32x4*)gain, g1 = *(const f32x4*)(gain + 4);
#pragma unroll
      for (int i = 0; i < 4; ++i) { const int q = (tid >> 4) + 32 * i, row = r0 + q;
          const float* src = WSP(float, WS_GV) + (size_t)row * 512 + g * 128 + sc; const f32x4 a = *(const f32x4*)src, b = *(const f32x4*)(src + 4);
          const f32x4 sq = *(const f32x4*)(WSP(float, WS_GVSS) + (size_t)row * 16 + g * 4); const float rs = 1.0f / sqrtf(((sq[0] + sq[1]) + (sq[2] + sq[3])) * (1.f / 128.f) + EPS);
          *(LAS u32x4*)(img + (q >> 6) * V_TILE + v_st(q & 63, sc)) = pack8(a * rs * g0, b * rs * g1); } }
    __syncthreads();
    const int pb = wid & 3, chh = wid >> 2;
    const bf16* Wsg = WSP(bf16, WS_WSP) + ((size_t)(l * 4 + g) * 128 + pb * 32 + r32) * 128 + hi * 8;
    f32x16 acc0 = f32x16{}, acc1 = f32x16{};
    const int vb0 = (int)(uintptr_t)img + v_rd_base(lane);
#pragma unroll
    for (int t = 0; t < 2; ++t) {
        const bf16x8 a0 = *(const bf16x8*)(Wsg + t * 64), a1 = *(const bf16x8*)(Wsg + t * 64 + 16), a2 = *(const bf16x8*)(Wsg + t * 64 + 32), a3 = *(const bf16x8*)(Wsg + t * 64 + 48);
        const int vb = vb0 + t * V_TILE;
        if (chh == 0) { pv_one<0>(acc0, vb, a0, a1, a2, a3); pv_one<1>(acc1, vb, a0, a1, a2, a3); }
        else          { pv_one<2>(acc0, vb, a0, a1, a2, a3); pv_one<3>(acc1, vb, a0, a1, a2, a3); }
    }
    const float* bs = inp<I_BSP>() + (l * 4 + g) * 128 + pb * 32;
    LAS float* mix = (LAS float*)(F.lds + 2 * V_TILE);
#pragma unroll
    for (int r = 0; r < 16; ++r) { const int p = crow(r, hi); const float bias = bs[p]; LAS float* mp = mix + (pb * 32 + p) * 128 + chh * 64 + r32; mp[0] = acc0[r] + bias; mp[32] = acc1[r] + bias; }
    __syncthreads();
    { const int sc = (tid & 15) * 8; const float* up = WSP(float, WS_U) + (size_t)(r0 + (tid >> 4)) * 512 + g * 128 + sc; bf16* hp = WSP(bf16, WS_HEADS) + (size_t)(r0 + (tid >> 4)) * DM + 768 + g * 128 + sc;
#pragma unroll
      for (int i = 0; i < 4; ++i) { const LAS float* mp = mix + ((tid >> 4) + 32 * i) * 128 + sc; const f32x4 m0 = *(const LAS f32x4*)mp, m1 = *(const LAS f32x4*)(mp + 4);
          const f32x4 u0 = *(const f32x4*)up, u1 = *(const f32x4*)(up + 4); *(u32x4*)hp = pack8(u0 * m0, u1 * m1);
          up += 32 * 512; hp += 32 * (size_t)DM; asm volatile("" : "+v"(up), "+v"(hp)); } }
    __syncthreads();
}
#undef SBAR
}

#ifndef MK_SPLIT
#define MK_SPLIT 0
#endif
constexpr int PH_PER_LAYER = 8, PH_FINAL = 2 + PH_PER_LAYER * DEPTH, N_PHASES = PH_FINAL + 1;

__global__ void __launch_bounds__(NTHR, 2) fwd_kernel(Args args) {
    extern __shared__ __attribute__((aligned(16))) unsigned char lds_raw[];
    cg::grid_group grid = cg::this_grid();
    Frame F;
    F.lds = (LAS unsigned char*)lds_raw;
    F.G = gridDim.x; { const int bx = blockIdx.x; F.vcu = (F.G % 8 == 0) ? (bx % 8) * (F.G / 8) + bx / 8 : bx; }
    const Args& A = args;
    F.out = args.out; F.ws = args.ws;
    const int lo = args.ph_lo, hi = args.ph_hi;
#ifndef PH_MASK
#define PH_MASK 0x7ff
#endif
#define PHM(j) (((PH_MASK) >> (j)) & 1)
#ifndef RPT_MASK
#define RPT_MASK 0
#endif
#define NREP(j) ((((RPT_MASK) >> (j)) & 1) ? 2 : 1)
#define IN(k) (lo <= (k) && (k) < hi)
#define SEAM(k) do { if (IN(k) && IN((k) + 1)) xcd_barrier(xb); } while (0)
    const float* ropetab = WSP(float, WS_ROPE);
    volatile LAS unsigned* MISC = (volatile LAS unsigned*)(F.lds + 131072);
    if (threadIdx.x < 64) MISC[threadIdx.x] = 0u;
    unsigned* barw = (unsigned*)(F.ws + WS_BAR);
    if (blockIdx.x == 0) for (int i = threadIdx.x; i < XCD_BAR_WORDS; i += NTHR) barw[i] = 0u;
    __syncthreads();
    XcdBarrier xb; xb.bar = barw; xb.x = 0; xb.st = MISC + 8;

    for (int rep_ = 0; rep_ < NREP(0); ++rep_) { if (rep_) xcd_barrier(xb); if (PHM(0) && IN(0)) { p0_prologue(A, F); } }
    if (IN(0) && IN(1)) { grid.sync(); }
    xb = xcd_barrier_post(barw, MISC + 8);
    for (int rep_ = 0; rep_ < NREP(1); ++rep_) { if (rep_) xcd_barrier(xb); if (PHM(1) && IN(1)) { p0b_modreduce(A, F); } } SEAM(1);

    for (int l = 0; l < DEPTH; ++l) {
        const int pb = 2 + PH_PER_LAYER * l; const bool last = (l == DEPTH - 1); const bool first = (l == 0);
        const float* modl = WSP(float, WS_MOD) + (size_t)l * 5 * MODW;
        for (int rep_ = 0; rep_ < NREP(2); ++rep_) { if (rep_) xcd_barrier(xb); if (PHM(2) && IN(pb + 0)) { norm_phase(A, F, l, first ? 1 : 0, inp<I_GMIX>() + l * DM, 0, first ? nullptr : WSP(float, WS_SLAB), false); } } SEAM(pb + 0);
        for (int rep_ = 0; rep_ < NREP(3); ++rep_) { if (rep_) xcd_barrier(xb); if (PHM(3) && IN(pb + 1)) {
            pg8::Gemm g{WSP(bf16, WS_HN), WSP(bf16, WS_WIN) + (size_t)l * NZP * DM, M, NZP, DM, DM}; TileOrder S; S.init(NZP, F.G, (int)blockIdx.x, 0);
            EpiZ E{F.ws, ropetab};
            pg8::gemm_phase<EpiZ, TileOrder, true, true>(F.lds, g, S, E);
        } } SEAM(pb + 1);
        for (int rep_ = 0; rep_ < NREP(4); ++rep_) { if (rep_) xcd_barrier(xb); if (PHM(4) && IN(pb + 2)) {
            const bool split = F.G >= 200; const int naux = split ? F.G - 192 : F.G, caux = split ? F.vcu - 192 : F.vcu;
            if (split && F.vcu < 192) { att::da_latent(A, F, l, F.vcu); }
            else {
                { pg8::Gemm g{WSP(bf16, WS_CKV), WSP(bf16, WS_WUKV) + (size_t)l * NUKV * RANK, M, NUKV, RANK, RANK}; TileOrder S; S.init(NUKV, naux, caux, 0);
                  EpiKV E{F.ws}; pg8::gemm_phase<EpiKV, TileOrder, true, true>(F.lds, g, S, E); }
                { pg8::Gemm g{WSP(bf16, WS_CQ), WSP(bf16, WS_WUQ) + (size_t)l * NUQP * RANK, M, NUQP, RANK, RANK}; TileOrder S; S.init(NUQP, naux, caux, last ? 1 : 0);
                  EpiQ E{F.ws, ropetab}; pg8::gemm_phase<EpiQ, TileOrder, true, true>(F.lds, g, S, E); }
                for (int un = caux; un < 72 * 4; un += naux) { const int ch = un >> 2, g = un & 3; if (last && (ch % 18) < 2) continue; att::gate_unit(A, F, l, ch, g); }
                if (!last) for (int un = caux; un < 24; un += naux) att::da_ctx(A, F, l, un);
                if (!split) for (int un = caux; un < 192; un += naux) att::da_latent(A, F, l, un);
            }
        } } SEAM(pb + 2);
        for (int rep_ = 0; rep_ < NREP(5); ++rep_) { if (rep_) xcd_barrier(xb); if (PHM(5) && IN(pb + 3)) { att::mla_phase(A, F, !last); } } SEAM(pb + 3);
        for (int rep_ = 0; rep_ < NREP(6); ++rep_) { if (rep_) xcd_barrier(xb); if (PHM(6) && IN(pb + 4)) {
            { pg8::Gemm g{WSP(bf16, WS_HEADS), WSP(bf16, WS_WOUT) + (size_t)l * DM * DM, M, DM, DM, DM}; TileOrder S; S.init(DM, F.G, (int)blockIdx.x, 1);
              EpiResid E{F.ws, inp<I_X>(), inp<I_CTX>(), modl + 2 * DM, first};
              pg8::gemm_phase<EpiResid, TileOrder, true, true>(F.lds, g, S, E); }
            if (!last) {
              pg8::Gemm g{WSP(bf16, WS_HEADS), WSP(bf16, WS_WOUT) + (size_t)l * DM * DM, M, DM, DM / 8, DM}; TileOrder S; S.init(DM, F.G, (int)blockIdx.x, 3, 8, DM / 8);
              EpiSlab E{WSP(float, WS_SLAB), modl + 4 * MODW + 2 * DM};
              pg8::gemm_phase<EpiSlab, TileOrder, true, true>(F.lds, g, S, E); }
        } } SEAM(pb + 4);
        for (int rep_ = 0; rep_ < NREP(7); ++rep_) { if (rep_) xcd_barrier(xb); if (PHM(7) && IN(pb + 5)) { norm_phase(A, F, l, first ? 2 : 0, inp<I_GMLP>() + l * DM, 3 * DM, last ? nullptr : WSP(float, WS_SLAB), last); } } SEAM(pb + 5);
        for (int rep_ = 0; rep_ < NREP(8); ++rep_) { if (rep_) xcd_barrier(xb); if (PHM(8) && IN(pb + 6)) {
            pg8::Gemm g{WSP(bf16, WS_HN), WSP(bf16, WS_WFC1) + (size_t)l * FF * DM, M, FF, DM, DM}; TileOrder S; S.init(FF, F.G, (int)blockIdx.x, last ? 1 : 0);
            EpiFc1 E{F.ws};
            pg8::gemm_phase<EpiFc1, TileOrder, true, true>(F.lds, g, S, E);
        } } SEAM(pb + 6);
        for (int rep_ = 0; rep_ < NREP(9); ++rep_) { if (rep_) xcd_barrier(xb); if (PHM(9) && IN(pb + 7)) {
            { pg8::Gemm g{WSP(bf16, WS_ACT), WSP(bf16, WS_WFC2) + (size_t)l * DM * FF, M, DM, FF, FF}; TileOrder S; S.init(DM, F.G, (int)blockIdx.x, 1);
              EpiResid E{F.ws, inp<I_X>(), inp<I_CTX>(), modl + 5 * DM, false};
              pg8::gemm_phase<EpiResid, TileOrder, true, true>(F.lds, g, S, E); }
            if (!last) {
              pg8::Gemm g{WSP(bf16, WS_ACT), WSP(bf16, WS_WFC2) + (size_t)l * DM * FF, M, DM, FF / 8, FF}; TileOrder S; S.init(DM, F.G, (int)blockIdx.x, 3, 8, FF / 8);
              EpiSlab E{WSP(float, WS_SLAB), modl + 4 * MODW + 5 * DM};
              pg8::gemm_phase<EpiSlab, TileOrder, true, true>(F.lds, g, S, E); }
        } } SEAM(pb + 7);
    }
    for (int rep_ = 0; rep_ < NREP(10); ++rep_) { if (rep_) xcd_barrier(xb); if (PHM(10) && IN(PH_FINAL)) { final_norm_phase(A, F); } }
#undef IN
#undef SEAM
}

extern "C" void kernel_launch(void* const* d_in, const int* in_sizes, int n_in, void* d_out, int out_size, void* d_ws, size_t ws_size, hipStream_t stream) {
    static int grid = 0;
    if (grid == 0) {
        if (n_in != N_IN || ws_size < WS_END || out_size != NB * SEQ * DM) { fprintf(stderr, "kernel_launch: unexpected shapes: n_in %d ws %zu (need %zu) out %d\n", n_in, ws_size, (size_t)WS_END, out_size); grid = -1; return; }
        int dev = 0, cus = 0, per_cu = 0;
        if (hipGetDevice(&dev) != hipSuccess || hipDeviceGetAttribute(&cus, hipDeviceAttributeMultiprocessorCount, dev) != hipSuccess) { fprintf(stderr, "kernel_launch: device query failed\n"); grid = -1; return; }
        if (hipFuncSetAttribute((const void*)fwd_kernel, hipFuncAttributeMaxDynamicSharedMemorySize, LDS_BYTES) != hipSuccess) { fprintf(stderr, "kernel_launch: hipFuncSetAttribute failed\n"); grid = -1; return; }
        if (hipOccupancyMaxActiveBlocksPerMultiprocessor(&per_cu, (const void*)fwd_kernel, NTHR, LDS_BYTES) != hipSuccess || per_cu < 1) { fprintf(stderr, "kernel_launch: occupancy query says %d blocks/CU\n", per_cu); (void)hipGetLastError(); per_cu = 1; }
        grid = cus * per_cu; if (grid > 256) grid = 256;
        grid -= grid % 8;
        fprintf(stderr, "kernel_launch: cus %d per_cu %d grid %d\n", cus, per_cu, grid);
    }
    if (grid <= 0) return;
    Args a{};
    for (int i = 0; i < N_IN; ++i) a.in[i] = (const float*)d_in[i];
    a.out = (float*)d_out; a.ws = (unsigned char*)d_ws;
#if MK_SPLIT
    for (int p = 0; p < N_PHASES; ++p) {
        a.ph_lo = p; a.ph_hi = p + 1; void* kargs[] = {&a};
        hipError_t e = hipLaunchCooperativeKernel((const void*)fwd_kernel, dim3(grid), dim3(NTHR), kargs, LDS_BYTES, stream);
        if (e != hipSuccess) { fprintf(stderr, "kernel_launch: launch of phase %d failed: %s\n", p, hipGetErrorString(e)); break; }
    }
#else
    a.ph_lo = 0; a.ph_hi = N_PHASES; void* kargs[] = {&a};
    hipError_t e = hipLaunchCooperativeKernel((const void*)fwd_kernel, dim3(grid), dim3(NTHR), kargs, LDS_BYTES, stream);
    if (e != hipSuccess) fprintf(stderr, "kernel_launch: cooperative launch failed: %s (grid %d)\n", hipGetErrorString(e), grid);
#endif
}
```

```cpp
#include <hip/hip_runtime.h>
#include <hip/hip_cooperative_groups.h>
#include <cstdio>
#include <cstdint>
namespace cg = cooperative_groups;
namespace pg8 {
#define PG8_LAS __attribute__((address_space(3)))
typedef unsigned short bf16_t;
typedef short bf16x8 __attribute__((ext_vector_type(8)));
typedef float f32x4 __attribute__((ext_vector_type(4)));
typedef unsigned u32x4 __attribute__((ext_vector_type(4)));
constexpr int BM = 256, BK = 64, HALF = 128, HTB = HALF * BK * 2  , STAGE_BYTES = 8 * HTB, NXCD = 8, WGM = 8;

__host__ __device__ __forceinline__ int lds_byte(int r, int c) { const int st = (r >> 4) * 2 + (c >> 5), rr = r & 15, cc = c & 31, ob = rr * 64 + cc * 2; return st * 1024 + (ob ^ (((ob >> 9) & 1) << 5)); }
__host__ __device__ __forceinline__ void stage_rc(int b, int& R, int& C) { const int st = b / 1024, sb = b % 1024, swz = sb ^ (((sb >> 9) & 1) << 5); R = (st >> 1) * 16 + swz / 64; C = (st & 1) * 32 + (swz % 64) / 2; }
__host__ __device__ __forceinline__ int perm32(int rho) { const int n = rho >> 4, i = rho & 15; return 8 * (i >> 2) + 4 * n + (i & 3); }

struct Unit { int pm, pn, k0, ks; };
struct Gemm { const bf16_t* A; const bf16_t* Bt; int M, N, K, ld; };

__device__ __forceinline__ unsigned cvt_pk_bf16(float lo, float hi) { unsigned r; asm volatile("v_cvt_pk_bf16_f32 %0, %1, %2" : "=v"(r) : "v"(lo), "v"(hi)); return r; }
typedef float f32x2 __attribute__((ext_vector_type(2)));
__device__ __forceinline__ f32x2 gelu_pk(f32x2 v) {
    const f32x2 av = __builtin_elementwise_abs(v), d = av * 0.2316418882f + 1.0f;
    f32x2 t; t.x = __builtin_amdgcn_rcpf(d.x); t.y = __builtin_amdgcn_rcpf(d.y);
    f32x2 q = t * 0.5307027145f + (-0.7265760135f); q = q * t + 0.7107068705f; q = q * t + (-0.142248368f); q = q * t + 0.127414796f; q = q * t;
    const f32x2 s = (v * v) * (-0.72134752044f);
    f32x2 e; e.x = __builtin_amdgcn_exp2f(s.x); e.y = __builtin_amdgcn_exp2f(s.y);
    const f32x2 m = v * (q * e), r = v - m;
    f32x2 o; o.x = v.x < 0.f ? m.x : r.x; o.y = v.y < 0.f ? m.y : r.y; return o;
}
template <class Epi, class Sched, bool ALIGN_EPI = false, bool SP2 = false>
__device__ __forceinline__ void gemm_phase(PG8_LAS unsigned char* lds, const Gemm g, const Sched& S, const Epi& E) {
    int tid_ = threadIdx.x; asm volatile("" : "+v"(tid_)); const int tid = tid_, wid = __builtin_amdgcn_readfirstlane(tid >> 6), lane = tid & 63, wr = wid >> 2, wc = wid & 3, fr = lane & 15, fq = lane >> 4;
    const int K = g.K, nt = K / BK;
    unsigned voffA[2], voffB[2];
#pragma unroll
    for (int i = 0; i < 2; ++i) { int R, C; stage_rc(tid * 16 + i * 8192, R, C); const int Rb = Epi::PERM ? ((R & ~31) + perm32(R & 31)) : R;
        voffA[i] = (unsigned)(R * g.ld + C) * 2u; voffB[i] = (unsigned)(Rb * g.ld + C) * 2u; }
    const size_t kstep = (size_t)(BK * 2);
    const size_t hstep = (size_t)HALF * g.ld * 2;
    const size_t tstep = 2 * hstep;
    const unsigned ldsw = (unsigned)wid * 1024u;
    const int aoff = lds_byte(wr * 64 + fr, fq * 8), boff = lds_byte(wc * 32 + fr, fq * 8);
#define PG8_SA(b, h) (((b) * 2 + (h)) * HTB)
#define PG8_SB(b, h) ((4 + (b) * 2 + (h)) * HTB)
#define PG8_STAGE(bufoff, gbase, voff) do { _Pragma("unroll") for (int _i = 0; _i < 2; ++_i) \
        __builtin_amdgcn_global_load_lds((const unsigned*)((const char*)(gbase) + (voff)[_i]), (PG8_LAS unsigned*)(lds + (bufoff) + ldsw + _i * 8192), 16, 0, 0); } while (0)
#define PG8_LDA(dst, b, h) do { _Pragma("unroll") for (int m = 0; m < 4; ++m) _Pragma("unroll") for (int k = 0; k < 2; ++k) dst[m][k] = *(const PG8_LAS bf16x8*)(lds + PG8_SA(b, h) + aoff + m * 2048 + k * 1024); } while (0)
#define PG8_LDB(dst, b, h) do { _Pragma("unroll") for (int n = 0; n < 2; ++n) _Pragma("unroll") for (int k = 0; k < 2; ++k) dst[n][k] = *(const PG8_LAS bf16x8*)(lds + PG8_SB(b, h) + boff + n * 2048 + k * 1024); } while (0)
#define PG8_MMA(ai, bj, At, Bt) do { __builtin_amdgcn_s_setprio(1); _Pragma("unroll") for (int m = 0; m < 4; ++m) _Pragma("unroll") for (int n = 0; n < 2; ++n) _Pragma("unroll") for (int k = 0; k < 2; ++k) \
        acc[ai][bj][m][n] = __builtin_amdgcn_mfma_f32_16x16x32_bf16(Bt[n][k], At[m][k], acc[ai][bj][m][n], 0, 0, 0); __builtin_amdgcn_s_setprio(0); } while (0)
#define PG8_WAIT_V(n) asm volatile("s_waitcnt vmcnt(" #n ")" ::: "memory")
#define PG8_WAIT_L(n) asm volatile("s_waitcnt lgkmcnt(" #n ")" ::: "memory")
#define PG8_BAR __builtin_amdgcn_s_barrier()
#define PG8_SCHED __builtin_amdgcn_sched_barrier(0)
    Unit cur, nxt; int ui = 0;
    if (!S.next(0, cur)) return;
    f32x4 acc[2][2][4][2];
#pragma unroll
    for (int a = 0; a < 2; ++a)
#pragma unroll
        for (int b = 0; b < 2; ++b)
#pragma unroll
            for (int m = 0; m < 4; ++m)
#pragma unroll
                for (int n = 0; n < 2; ++n) acc[a][b][m][n] = (f32x4){0.f, 0.f, 0.f, 0.f};
    bf16x8 At[4][2], B0[2][2], B1[2][2];
    const char* cA = (const char*)g.A + (size_t)cur.pm * tstep + (size_t)cur.k0 * 2; const char* cB = (const char*)g.Bt + (size_t)cur.pn * tstep + (size_t)cur.k0 * 2;
    S.a_ready(cur);
    if constexpr (SP2) {
        PG8_STAGE(PG8_SB(0, 0), cB, voffB); PG8_STAGE(PG8_SB(0, 1), cB + hstep, voffB); PG8_STAGE(PG8_SA(0, 0), cA, voffA); PG8_STAGE(PG8_SA(0, 1), cA + hstep, voffA);
        if (wr == 1) PG8_BAR;
        PG8_WAIT_V(2); PG8_BAR;
        PG8_STAGE(PG8_SB(1, 0), cB + kstep, voffB); PG8_STAGE(PG8_SA(1, 0), cA + kstep, voffA); PG8_STAGE(PG8_SB(1, 1), cB + hstep + kstep, voffB);
        PG8_WAIT_V(6); PG8_BAR;
    } else {
        PG8_STAGE(PG8_SB(0, 0), cB, voffB); PG8_STAGE(PG8_SA(0, 0), cA, voffA); PG8_STAGE(PG8_SB(0, 1), cB + hstep, voffB); PG8_STAGE(PG8_SA(0, 1), cA + hstep, voffA);
        if (wr == 1) PG8_BAR;
        PG8_WAIT_V(4); PG8_BAR;
        PG8_STAGE(PG8_SB(1, 0), cB + kstep, voffB); PG8_STAGE(PG8_SA(1, 0), cA + kstep, voffA); PG8_STAGE(PG8_SB(1, 1), cB + hstep + kstep, voffB);
        PG8_WAIT_V(6); PG8_BAR;
    }
    for (;;) {
        const bool has_next = S.next(ui + 1, nxt);
        const char* nA = has_next ? (const char*)g.A + (size_t)nxt.pm * tstep + (size_t)nxt.k0 * 2 : cA; const char* nB = has_next ? (const char*)g.Bt + (size_t)nxt.pn * tstep + (size_t)nxt.k0 * 2 : cB;
        for (int t = 0; t < nt; t += 2) {
            const bool last = (t == nt - 2);
            const char* a1 = cA + (size_t)(t + 1) * kstep;
            const char* a2 = last ? nA : cA + (size_t)(t + 2) * kstep; const char* b2 = last ? nB : cB + (size_t)(t + 2) * kstep;
            const char* a3 = a2 + kstep; const char* b3 = b2 + kstep;
            if (last && has_next) S.a_ready(nxt);
            if constexpr (SP2) {
            PG8_LDB(B0, 0, 0); PG8_LDB(B1, 0, 1); PG8_SCHED; PG8_LDA(At, 0, 0); PG8_STAGE(PG8_SA(1, 1), a1 + hstep, voffA);
            PG8_WAIT_V(8); PG8_WAIT_L(0); PG8_BAR; PG8_MMA(0, 0, At, B0); PG8_MMA(0, 1, At, B1); PG8_BAR; PG8_SCHED;
            PG8_LDA(At, 0, 1); PG8_STAGE(PG8_SB(0, 0), b2, voffB); PG8_STAGE(PG8_SB(0, 1), b2 + hstep, voffB); PG8_STAGE(PG8_SA(0, 0), a2, voffA);
            PG8_WAIT_V(8); PG8_WAIT_L(0); PG8_BAR; PG8_MMA(1, 0, At, B0); PG8_MMA(1, 1, At, B1); PG8_BAR; PG8_SCHED;
            PG8_LDB(B0, 1, 0); PG8_LDB(B1, 1, 1); PG8_SCHED; PG8_LDA(At, 1, 0); PG8_STAGE(PG8_SA(0, 1), a2 + hstep, voffA);
            PG8_WAIT_V(8); PG8_WAIT_L(0); PG8_BAR; PG8_MMA(0, 0, At, B0); PG8_MMA(0, 1, At, B1); PG8_BAR; PG8_SCHED;
            PG8_LDA(At, 1, 1); PG8_STAGE(PG8_SB(1, 0), b3, voffB); PG8_STAGE(PG8_SB(1, 1), b3 + hstep, voffB); PG8_STAGE(PG8_SA(1, 0), a3, voffA);
            PG8_WAIT_V(8); PG8_WAIT_L(0); PG8_BAR; PG8_MMA(1, 0, At, B0); PG8_MMA(1, 1, At, B1); PG8_BAR; PG8_SCHED;
            } else {
            PG8_LDB(B0, 0, 0); PG8_SCHED; PG8_LDA(At, 0, 0); PG8_STAGE(PG8_SA(1, 1), a1 + hstep, voffA);
            PG8_WAIT_L(8); PG8_BAR; PG8_WAIT_L(0); PG8_MMA(0, 0, At, B0); PG8_BAR; PG8_SCHED;
            PG8_LDB(B1, 0, 1); PG8_STAGE(PG8_SB(0, 0), b2, voffB);
            PG8_BAR; PG8_WAIT_L(0); PG8_MMA(0, 1, At, B1); PG8_BAR;
            PG8_LDA(At, 0, 1); PG8_STAGE(PG8_SA(0, 0), a2, voffA);
            PG8_BAR; PG8_WAIT_L(0); PG8_MMA(1, 0, At, B0); PG8_BAR; PG8_SCHED;
            PG8_STAGE(PG8_SB(0, 1), b2 + hstep, voffB);
            PG8_WAIT_V(6); PG8_BAR; PG8_MMA(1, 1, At, B1); PG8_BAR;
            PG8_LDB(B0, 1, 0); PG8_SCHED; PG8_LDA(At, 1, 0); PG8_STAGE(PG8_SA(0, 1), a2 + hstep, voffA);
            PG8_WAIT_L(8); PG8_BAR; PG8_WAIT_L(0); PG8_MMA(0, 0, At, B0); PG8_BAR; PG8_SCHED;
            PG8_LDB(B1, 1, 1); PG8_STAGE(PG8_SB(1, 0), b3, voffB);
            PG8_BAR; PG8_WAIT_L(0); PG8_MMA(0, 1, At, B1); PG8_BAR;
            PG8_LDA(At, 1, 1); PG8_STAGE(PG8_SA(1, 0), a3, voffA);
            PG8_BAR; PG8_WAIT_L(0); PG8_MMA(1, 0, At, B0); PG8_BAR; PG8_SCHED;
            PG8_STAGE(PG8_SB(1, 1), b3 + hstep, voffB);
            PG8_WAIT_V(6); PG8_BAR; PG8_MMA(1, 1, At, B1); PG8_BAR;
            }
        }
        if constexpr (ALIGN_EPI) { if (wr == 0) PG8_BAR; }
        if constexpr (!Epi::AFTER_DRAIN) { E(acc, cur, wr, wc, fr, fq); S.done(cur); }
        if (!has_next) break;
#pragma unroll
        for (int a = 0; a < 2; ++a)
#pragma unroll
            for (int b = 0; b < 2; ++b)
#pragma unroll
                for (int m = 0; m < 4; ++m)
#pragma unroll
                    for (int n = 0; n < 2; ++n) acc[a][b][m][n] = (f32x4){0.f, 0.f, 0.f, 0.f};
        cur = nxt; cA = nA; cB = nB; ++ui;
        if constexpr (ALIGN_EPI) { if (wr == 1) PG8_BAR; }
    }
    PG8_WAIT_V(0);
    if constexpr (!ALIGN_EPI) { if (wr == 0) PG8_BAR; }
    PG8_BAR;
    if constexpr (Epi::AFTER_DRAIN) { E.fused(acc, cur, wr, wc, fr, fq, lds, wid, lane); S.done(cur); }
#undef PG8_SA
#undef PG8_SB
#undef PG8_STAGE
#undef PG8_LDA
#undef PG8_LDB
#undef PG8_MMA
#undef PG8_WAIT_V
#undef PG8_WAIT_L
#undef PG8_BAR
#undef PG8_SCHED
}
}

#define GAS __attribute__((address_space(1)))
#define LAS __attribute__((address_space(3)))
typedef unsigned short bf16;
typedef float f32x4 __attribute__((ext_vector_type(4)));
typedef float f32x2 __attribute__((ext_vector_type(2)));
typedef float f32x16 __attribute__((ext_vector_type(16)));
typedef short bf16x8 __attribute__((ext_vector_type(8)));
typedef short s16x4 __attribute__((ext_vector_type(4)));
typedef unsigned u32x4 __attribute__((ext_vector_type(4)));
typedef unsigned u32x2 __attribute__((ext_vector_type(2)));

constexpr int NB = 4, SEQ = 2048, CTX = 256, DM = 2048, DEPTH = 2, FF = 8192;
constexpr int TOK = CTX + SEQ;
constexpr int M = NB * TOK;
constexpr int NZ = 4416, NZP = 4608;
constexpr int NUQ = 1152, NUQP = 1280, NUKV = 1536, RANK = 512;
constexpr int MODW = 6 * DM;
constexpr float EPS = 1e-6f;
constexpr float LOG2E = 1.4426950408889634f;
constexpr float DA_QS = 0.125f * LOG2E;
constexpr float MLA_QS = 0.07216878364870322f * LOG2E;
constexpr int NWAVES = 8, NTHR = 512;

enum { I_X = 0, I_C, I_CTX, I_CCTX, I_WMOD, I_BMOD, I_GMIX, I_GMLP, I_WIN, I_LQ1, I_LK1, I_LQ2, I_LK2, I_GDASUB, I_GGMV, I_WSP, I_BSP,
       I_GMQ, I_WUQ, I_GMKV, I_WUKV, I_WOUT, I_WFC1, I_WFC2, I_GFINAL, N_IN };

constexpr size_t al256(size_t x) { return (x + 255) / 256 * 256; }
constexpr size_t WS_ROPE  = 0;
constexpr size_t WS_SCAL  = WS_ROPE + 8192;
constexpr size_t WS_BAR   = WS_SCAL + 256;
constexpr size_t WS_MOD   = WS_BAR + 16384;
constexpr size_t WS_MODP  = al256(WS_MOD + (size_t)DEPTH * 5 * MODW * 4);
constexpr size_t WS_WIN   = al256(WS_MODP + (size_t)DEPTH * 32 * 5 * MODW * 4);
constexpr size_t WS_WOUT  = al256(WS_WIN + (size_t)DEPTH * NZP * DM * 2);
constexpr size_t WS_WFC1  = al256(WS_WOUT + (size_t)DEPTH * DM * DM * 2);
constexpr size_t WS_WFC2  = al256(WS_WFC1 + (size_t)DEPTH * FF * DM * 2);
constexpr size_t WS_WUQ   = al256(WS_WFC2 + (size_t)DEPTH * DM * FF * 2);
constexpr size_t WS_WUKV  = al256(WS_WUQ + (size_t)DEPTH * NUQP * RANK * 2);
constexpr size_t WS_WSP   = al256(WS_WUKV + (size_t)DEPTH * NUKV * RANK * 2);
constexpr size_t WS_XW    = al256(WS_WSP + (size_t)DEPTH * 4 * 128 * 128 * 2);
constexpr size_t WS_HN    = al256(WS_XW + (size_t)M * DM * 4);
constexpr size_t WS_QDA   = al256(WS_HN + (size_t)M * DM * 2);
constexpr size_t WS_KDA   = al256(WS_QDA + (size_t)M * 768 * 2);
constexpr size_t WS_VDA   = al256(WS_KDA + (size_t)M * 768 * 2);
constexpr size_t WS_U     = al256(WS_VDA + (size_t)M * 768 * 2);
constexpr size_t WS_GV    = al256(WS_U + (size_t)M * 512 * 4);
constexpr size_t WS_GVSS  = al256(WS_GV + (size_t)M * 512 * 4);
constexpr size_t WS_CQSS  = al256(WS_GVSS + (size_t)M * 16 * 4);
constexpr size_t WS_CKVSS = al256(WS_CQSS + (size_t)M * 8 * 4);
constexpr size_t WS_CQ    = al256(WS_CKVSS + (size_t)M * 8 * 4);
constexpr size_t WS_CKV   = al256(WS_CQ + (size_t)M * 512 * 2);
constexpr size_t WS_KMLA  = al256(WS_CKV + (size_t)M * 512 * 2);
constexpr size_t WS_VMLA  = al256(WS_KMLA + (size_t)M * 1152 * 2);
constexpr size_t WS_QMLA  = al256(WS_VMLA + (size_t)M * 768 * 2);
constexpr size_t WS_HEADS = al256(WS_QMLA + (size_t)M * 1152 * 2);
constexpr size_t WS_ACT   = al256(WS_HEADS + (size_t)M * DM * 2);
constexpr size_t WS_STASH = al256(WS_ACT + (size_t)M * FF * 2);
constexpr size_t WS_SLAB  = al256(WS_STASH + (size_t)256 * 64 * 512 * 4);
constexpr size_t WS_END   = al256(WS_SLAB + (size_t)8 * 1024 * DM * 4);

constexpr int LDS_BYTES = 131072 + 1024;

__device__ __forceinline__ unsigned cvtpk(float lo, float hi) { unsigned r; asm volatile("v_cvt_pk_bf16_f32 %0, %1, %2" : "=v"(r) : "v"(lo), "v"(hi)); return r; }
__device__ __forceinline__ u32x4 pack8(f32x4 a, f32x4 b) { u32x4 w; w.x = cvtpk(a[0], a[1]); w.y = cvtpk(a[2], a[3]); w.z = cvtpk(b[0], b[1]); w.w = cvtpk(b[2], b[3]); return w; }
__device__ __forceinline__ float wave_sum(float v) {
#pragma unroll
    for (int o = 1; o < 64; o <<= 1) v += __shfl_xor(v, o);
    return v;
}
__device__ __forceinline__ float bf2f(unsigned short h) { return __uint_as_float(((unsigned)h) << 16); }

struct Args { const float* in[N_IN]; float* out; unsigned char* ws; int ph_lo, ph_hi; };
struct Frame {
    LAS unsigned char* lds;
    int G, vcu;
    float* out; unsigned char* ws;
};
#define WSP(T, off) ((T*)(F.ws + (off)))
template <int I> __device__ __forceinline__ const float* inp() {
    unsigned long long p; asm volatile("s_load_dwordx2 %0, %1, %2\n\ts_waitcnt lgkmcnt(0)" : "=s"(p) : "s"(__builtin_amdgcn_kernarg_segment_ptr()), "n"(I * 8) : "memory"); return (const float*)p; }

__device__ __forceinline__ const float* xrow_in(const Args& A, const Frame& F, int row) {
    const int b = row / TOK, rr = row - b * TOK;
    return rr < CTX ? inp<I_CTX>() + (size_t)(b * CTX + rr) * DM : inp<I_X>() + (size_t)(b * SEQ + rr - CTX) * DM;
}

__device__ __forceinline__ void p0_transpose_item(const float* W, int K, int N, bf16* WT, const float* kscale, LAS float* scr, int item, int lane) {
    const int nblk = N / 32, kb = item / nblk, nb = item % nblk, k0 = 64 * kb, n0 = 32 * nb;
    { const int r8 = lane >> 3, c4 = (lane & 7) * 4; f32x4 v[8];
#pragma unroll
      for (int i = 0; i < 8; ++i) v[i] = *(const f32x4*)(W + (size_t)(k0 + r8 + 8 * i) * N + n0 + c4);
#pragma unroll
      for (int i = 0; i < 8; ++i) { const int kk = r8 + 8 * i; const float s = kscale ? kscale[k0 + kk] : 1.f; LAS float* d = scr + kk * 33 + c4;
          d[0] = v[i][0] * s; d[1] = v[i][1] * s; d[2] = v[i][2] * s; d[3] = v[i][3] * s; } }
    asm volatile("s_waitcnt lgkmcnt(0)" ::: "memory");
    const int c = lane & 7;
#pragma unroll
    for (int j = 0; j < 4; ++j) { const int n = (lane >> 3) + 8 * j; const LAS float* s = scr + (8 * c) * 33 + n;
        u32x4 o; o.x = cvtpk(s[0 * 33], s[1 * 33]); o.y = cvtpk(s[2 * 33], s[3 * 33]); o.z = cvtpk(s[4 * 33], s[5 * 33]); o.w = cvtpk(s[6 * 33], s[7 * 33]);
        *(u32x4*)(WT + (size_t)(n0 + n) * K + k0 + 8 * c) = o; }
    asm volatile("s_waitcnt lgkmcnt(0)" ::: "memory");
}
__device__ __forceinline__ float silu_f(float x) { return x / (1.f + __expf(-x)); }

__device__ __forceinline__ void p0_mod_item(const Args& A, const Frame& F, LAS float* scr, int item, int lane) {
    const int l = item / (32 * 48), r = item % (32 * 48), kc = r / 48, nc = r % 48;
    const int k = kc * 64 + lane;
#pragma unroll
    for (int bb = 0; bb < 5; ++bb) { const float cv = bb < 4 ? inp<I_C>()[bb * DM + k] : inp<I_CCTX>()[k]; scr[bb * 64 + lane] = silu_f(cv); }
    asm volatile("s_waitcnt lgkmcnt(0)" ::: "memory");
    const float* W = inp<I_WMOD>() + ((size_t)l * DM + kc * 64) * MODW + nc * 256 + lane * 4;
    f32x4 acc[5];
#pragma unroll
    for (int bb = 0; bb < 5; ++bb) acc[bb] = (f32x4){0.f, 0.f, 0.f, 0.f};
#pragma unroll 8
    for (int kk = 0; kk < 64; ++kk) { const f32x4 w = *(const f32x4*)(W + (size_t)kk * MODW);
#pragma unroll
        for (int bb = 0; bb < 5; ++bb) acc[bb] += w * scr[bb * 64 + kk]; }
    float* P = WSP(float, WS_MODP) + ((size_t)(l * 32 + kc) * 5) * MODW + nc * 256 + lane * 4;
#pragma unroll
    for (int bb = 0; bb < 5; ++bb) *(f32x4*)(P + (size_t)bb * MODW) = acc[bb];
    asm volatile("s_waitcnt lgkmcnt(0)" ::: "memory");
}

enum { J_IN = 1, J_OUT = 2, J_FC1 = 4, J_FC2 = 8, J_UQ = 16, J_UKV = 32 };
__device__ __forceinline__ void conv_weights(const Args& A, const Frame& F, int l, int jobs, int wcu, int ncu, int shift = 0) {
    int tid_ = threadIdx.x; asm volatile("" : "+v"(tid_)); const int ptid = tid_, plane = ptid & 63, pwave = __builtin_amdgcn_readfirstlane(ptid >> 6);
    LAS float* scr = (LAS float*)(F.lds + pwave * 16384);
    const int NGW = ncu * NWAVES, gw = (wcu * NWAVES + pwave + NGW - (shift % NGW)) % NGW;
    constexpr int T_IN = (DM / 64) * (NZ / 32), T_OUT = (DM / 64) * (DM / 32), T_FC1 = (DM / 64) * (FF / 32), T_FC2 = (FF / 64) * (DM / 32), T_UQ = (RANK / 64) * (NUQ / 32), T_UKV = (RANK / 64) * (NUKV / 32);
    const int n_in = (jobs & J_IN) ? T_IN : 0, n_out = (jobs & J_OUT) ? T_OUT : 0, n_fc1 = (jobs & J_FC1) ? T_FC1 : 0, n_fc2 = (jobs & J_FC2) ? T_FC2 : 0, n_uq = (jobs & J_UQ) ? T_UQ : 0, n_ukv = (jobs & J_UKV) ? T_UKV : 0;
    const int total = n_in + n_out + n_fc1 + n_fc2 + n_uq + n_ukv;
    for (int it = gw; it < total; it += NGW) {
        int r = it;
        if (r < n_in)  { p0_transpose_item(inp<I_WIN>() + (size_t)l * DM * NZ, DM, NZ, WSP(bf16, WS_WIN) + (size_t)l * NZP * DM, nullptr, scr, r, plane); continue; } r -= n_in;
        if (r < n_out) { p0_transpose_item(inp<I_WOUT>() + (size_t)l * DM * DM, DM, DM, WSP(bf16, WS_WOUT) + (size_t)l * DM * DM, nullptr, scr, r, plane); continue; } r -= n_out;
        if (r < n_fc1) { p0_transpose_item(inp<I_WFC1>() + (size_t)l * DM * FF, DM, FF, WSP(bf16, WS_WFC1) + (size_t)l * FF * DM, nullptr, scr, r, plane); continue; } r -= n_fc1;
        if (r < n_fc2) { p0_transpose_item(inp<I_WFC2>() + (size_t)l * FF * DM, FF, DM, WSP(bf16, WS_WFC2) + (size_t)l * DM * FF, nullptr, scr, r, plane); continue; } r -= n_fc2;
        if (r < n_uq)  { p0_transpose_item(inp<I_WUQ>() + (size_t)l * RANK * NUQ, RANK, NUQ, WSP(bf16, WS_WUQ) + (size_t)l * NUQP * RANK, inp<I_GMQ>() + l * RANK, scr, r, plane); continue; } r -= n_uq;
        p0_transpose_item(inp<I_WUKV>() + (size_t)l * RANK * NUKV, RANK, NUKV, WSP(bf16, WS_WUKV) + (size_t)l * NUKV * RANK, inp<I_GMKV>() + l * RANK, scr, r, plane);
    }
}
#ifndef DEFER_CONV
#define DEFER_CONV 1
#endif
__device__ __forceinline__ void p0_prologue(const Args& A, const Frame& F) {
    int tid_ = threadIdx.x; asm volatile("" : "+v"(tid_)); const int ptid = tid_, plane = ptid & 63, pwave = __builtin_amdgcn_readfirstlane(ptid >> 6);
    LAS float* scr = (LAS float*)(F.lds + pwave * 16384);
    const int gw = F.vcu * NWAVES + pwave, NGW = F.G * NWAVES;
    constexpr int I_MOD = DEPTH * 32 * 48;
    for (int it = gw; it < I_MOD; it += NGW) p0_mod_item(A, F, scr, it, plane);
    if (DEFER_CONV) conv_weights(A, F, 0, J_IN | J_UQ | J_UKV, F.vcu, F.G, I_MOD);
    else for (int l = 0; l < DEPTH; ++l) conv_weights(A, F, l, J_IN | J_OUT | J_FC1 | J_FC2 | J_UQ | J_UKV, F.vcu, F.G, I_MOD);
    const int gt = F.vcu * NTHR + ptid, NGT = F.G * NTHR;
    for (int i = gt; i < DEPTH * (NZP - NZ) * DM / 8; i += NGT) { const int l = i / ((NZP - NZ) * DM / 8), r = i % ((NZP - NZ) * DM / 8);
        *(u32x4*)(WSP(bf16, WS_WIN) + ((size_t)l * NZP + NZ) * DM + (size_t)r * 8) = (u32x4){0u, 0u, 0u, 0u}; }
    for (int i = gt; i < DEPTH * (NUQP - NUQ) * RANK / 8; i += NGT) { const int l = i / ((NUQP - NUQ) * RANK / 8), r = i % ((NUQP - NUQ) * RANK / 8);
        *(u32x4*)(WSP(bf16, WS_WUQ) + ((size_t)l * NUQP + NUQ) * RANK + (size_t)r * 8) = (u32x4){0u, 0u, 0u, 0u}; }
    for (int i = gt; i < DEPTH * 4 * 128 * 128 / 8; i += NGT) { const f32x4 a = *(const f32x4*)(inp<I_WSP>() + (size_t)i * 8), b = *(const f32x4*)(inp<I_WSP>() + (size_t)i * 8 + 4);
        *(u32x4*)(WSP(bf16, WS_WSP) + (size_t)i * 8) = pack8(a, b); }
    if (gt < 64 * 16) { const int pos = gt >> 4, f = gt & 15; const float inv = powf(10000.0f, -(float)f / 16.0f); const float ang = (float)pos * inv;
        WSP(float, WS_ROPE)[gt] = cosf(ang); WSP(float, WS_ROPE)[1024 + gt] = sinf(ang); }
    if (gt < 64 * DEPTH) {
        const int l = gt >> 6; const float a = inp<I_LQ1>()[l * 64 + plane] * inp<I_LK1>()[l * 64 + plane], b = inp<I_LQ2>()[l * 64 + plane] * inp<I_LK2>()[l * 64 + plane];
        const float sa = wave_sum(a), sb = wave_sum(b); const float lam_init = 0.8f - 0.6f * expf(-0.3f * (float)l);
        if (plane == 0) WSP(float, WS_SCAL)[l] = expf(sa) - expf(sb) + lam_init;
    }
}
__device__ __forceinline__ void p0b_modreduce(const Args& A, const Frame& F) {
    int tid_ = threadIdx.x; asm volatile("" : "+v"(tid_)); const int ptid = tid_, plane = ptid & 63, pwave = __builtin_amdgcn_readfirstlane(ptid >> 6);
    const int gt = F.vcu * NTHR + ptid, NGT = F.G * NTHR;
    for (int i = gt; i < DEPTH * 5 * MODW; i += NGT) { const int l = i / (5 * MODW), r = i % (5 * MODW), n = r % MODW;
        float s = inp<I_BMOD>()[l * MODW + n]; const float* P = WSP(float, WS_MODP) + (size_t)l * 32 * 5 * MODW + r;
#pragma unroll 8
        for (int kc = 0; kc < 32; ++kc) s += P[(size_t)kc * 5 * MODW];
        WSP(float, WS_MOD)[i] = s; }
}

__device__ __forceinline__ void norm_phase(const Args& A, const Frame& F, int l, int src_mode, const float* g, int shoff, const float* slab, bool skip_ctx) {
    int tid_ = threadIdx.x; asm volatile("" : "+v"(tid_)); const int ptid = tid_, plane = ptid & 63, pwave = __builtin_amdgcn_readfirstlane(ptid >> 6);
    const int gw = F.vcu * NWAVES + pwave, NGW = F.G * NWAVES;
    for (int row = gw; row < M; row += NGW) {
        const int b = row / TOK, rr = row - b * TOK; const bool isctx = rr < CTX; const int bsel = isctx ? 4 : b;
        if (isctx && skip_ctx) continue;
        const bool from_in = src_mode == 1 || (src_mode == 2 && isctx);
        const float* xr = from_in ? xrow_in(A, F, row) : WSP(float, WS_XW) + (size_t)row * DM;
        const float* md = WSP(float, WS_MOD) + ((size_t)l * 5 + bsel) * MODW + shoff;
        f32x4 v[8]; float s = 0.f;
#pragma unroll
        for (int j = 0; j < 8; ++j) v[j] = *(const f32x4*)(xr + 4 * plane + 256 * j);
        if (isctx && slab) {
            const float* sp = slab + (size_t)(b * CTX + rr) * DM + 4 * plane;
            for (int ks = 0; ks < 8; ++ks) {
#pragma unroll
                for (int j = 0; j < 8; ++j) v[j] += *(const f32x4*)(sp + (size_t)ks * 1024 * DM + 256 * j); }
            float* xo = WSP(float, WS_XW) + (size_t)row * DM + 4 * plane;
#pragma unroll
            for (int j = 0; j < 8; ++j) *(f32x4*)(xo + 256 * j) = v[j];
        }
#pragma unroll
        for (int j = 0; j < 8; ++j) s += (v[j].x * v[j].x + v[j].y * v[j].y) + (v[j].z * v[j].z + v[j].w * v[j].w);
        const float rstd = 1.0f / sqrtf(wave_sum(s) * (1.f / DM) + EPS);
        bf16* o = WSP(bf16, WS_HN) + (size_t)row * DM;
#pragma unroll
        for (int j = 0; j < 8; ++j) { const int c = 4 * plane + 256 * j; const f32x4 gg = *(const f32x4*)(g + c), sh = *(const f32x4*)(md + c), sc = *(const f32x4*)(md + DM + c);
            const f32x4 y = (v[j] * rstd) * gg * (sc + 1.0f) + sh; u32x2 w; w.x = cvtpk(y.x, y.y); w.y = cvtpk(y.z, y.w); *(u32x2*)(o + c) = w; }
    }
}
__device__ __forceinline__ void final_norm_phase(const Args& A, const Frame& F) {
    int tid_ = threadIdx.x; asm volatile("" : "+v"(tid_)); const int ptid = tid_, plane = ptid & 63, pwave = __builtin_amdgcn_readfirstlane(ptid >> 6);
    const int gw = F.vcu * NWAVES + pwave, NGW = F.G * NWAVES; const float* g = inp<I_GFINAL>();
    for (int r = gw; r < NB * SEQ; r += NGW) {
        const int b = r / SEQ, t = r - b * SEQ; const float* xr = WSP(float, WS_XW) + (size_t)(b * TOK + CTX + t) * DM;
        f32x4 v[8]; float s = 0.f;
#pragma unroll
        for (int j = 0; j < 8; ++j) { v[j] = *(const f32x4*)(xr + 4 * plane + 256 * j); s += (v[j].x * v[j].x + v[j].y * v[j].y) + (v[j].z * v[j].z + v[j].w * v[j].w); }
        const float rstd = 1.0f / sqrtf(wave_sum(s) * (1.f / DM) + EPS);
        float* o = F.out + (size_t)r * DM;
#pragma unroll
        for (int j = 0; j < 8; ++j) { const int c = 4 * plane + 256 * j; const f32x4 gg = *(const f32x4*)(g + c); *(f32x4*)(o + c) = (v[j] * rstd) * gg; }
    }
}

struct TileOrder {
    int nM, nN, nwg, G, c, mode, nsplit, kslice;
    __device__ void init(int N, int G_, int c_, int mode_, int nsplit_ = 1, int kslice_ = 0) { mode = mode_; nsplit = nsplit_; kslice = kslice_; nM = mode_ == 0 ? 36 : (mode_ == 1 ? 32 : 4); nN = N / 256; nwg = nM * nN * nsplit_; G = G_; c = c_; }
    __device__ bool next(int i, pg8::Unit& u) const {
        const long L = (long)i * G + c; if (L >= nwg) return false;
        int wgid = (int)L; { const int q = nwg / 8, r = nwg % 8, xcd = wgid % 8, off = wgid / 8; wgid = (xcd < r ? xcd * (q + 1) : r * (q + 1) + (xcd - r) * q) + off; }
        if (mode == 3) {
            const int per = 4 * nN, ks = wgid / per, rem = wgid - ks * per; u.ks = ks; u.k0 = ks * kslice; u.pn = rem >> 2; u.pm = (rem & 3) * 9; return true; }
        const int nig = 8 * nN, gid = wgid / nig, fm = gid * 8, gsz = (nM - fm) < 8 ? (nM - fm) : 8;
        int pm = fm + ((wgid % nig) % gsz); u.pn = (wgid % nig) / gsz;
        if (mode == 1) pm = (pm >> 3) * 9 + 1 + (pm & 7); else if (mode == 2) pm = pm * 9;
        u.pm = pm; u.k0 = 0; u.ks = 0; return true;
    }
    __device__ __forceinline__ void a_ready(const pg8::Unit&) const {}
    __device__ __forceinline__ void done(const pg8::Unit&) const {}
};

__device__ __forceinline__ void rope8(f32x4& v0, f32x4& v1, const float* ropetab, int pos, int f0) {
    const f32x4 c = *(const f32x4*)(ropetab + pos * 16 + f0), s = *(const f32x4*)(ropetab + 1024 + pos * 16 + f0);
    const f32x4 a = v0, b = v1;
    v0[0] = a[0] * c[0] - a[1] * s[0]; v0[1] = a[0] * s[0] + a[1] * c[0]; v0[2] = a[2] * c[1] - a[3] * s[1]; v0[3] = a[2] * s[1] + a[3] * c[1];
    v1[0] = b[0] * c[2] - b[1] * s[2]; v1[1] = b[0] * s[2] + b[1] * c[2]; v1[2] = b[2] * c[3] - b[3] * s[3]; v1[3] = b[2] * s[3] + b[3] * c[3];
}
__device__ __forceinline__ f32x4 gelu4(f32x4 v) { const f32x2 a = pg8::gelu_pk((f32x2){v[0], v[1]}), b = pg8::gelu_pk((f32x2){v[2], v[3]}); return (f32x4){a.x, a.y, b.x, b.y}; }
__device__ __forceinline__ float ss8(f32x4 a, f32x4 b) { return (a[0] * a[0] + a[1] * a[1]) + (a[2] * a[2] + a[3] * a[3]) + (b[0] * b[0] + b[1] * b[1]) + (b[2] * b[2] + b[3] * b[3]); }

struct EpiZ {
    static constexpr bool PERM = true, AFTER_DRAIN = false;
    unsigned char* ws; const float* ropetab;
    __device__ __forceinline__ void operator()(const f32x4 (&acc)[2][2][4][2], const pg8::Unit& u, int wr, int wc, int fr_, int fq_) const {
        int fr = fr_, fq = fq_; asm volatile("" : "+v"(fr), "+v"(fq));
        const int pn = u.pn;
#pragma unroll
        for (int ai = 0; ai < 2; ++ai)
#pragma unroll
            for (int m = 0; m < 4; ++m) {
                const int row = u.pm * 256 + ai * 128 + wr * 64 + m * 16 + fr;
                const int b = row / TOK, rr = row - b * TOK; const bool lat = rr >= CTX; const int t = rr - CTX, prow = (t >> 6) & 31, pcol = t & 63;
                float ssq = 0.f;
#pragma unroll
                for (int bj = 0; bj < 2; ++bj) {
                    const int colt = bj * 128 + wc * 32 + 8 * fq;
                    f32x4 v0 = acc[ai][bj][m][0], v1 = acc[ai][bj][m][1];
                    if (pn < 6) {
                        if (lat) { const int j0 = (colt & 63) >> 1; rope8(v0, v1, ropetab, j0 < 16 ? prow : pcol, j0 & 15); }
                        if (pn < 3) { v0 *= DA_QS; v1 *= DA_QS; *(u32x4*)((bf16*)(ws + WS_QDA) + (size_t)row * 768 + pn * 256 + colt) = pack8(v0, v1); }
                        else *(u32x4*)((bf16*)(ws + WS_KDA) + (size_t)row * 768 + (pn - 3) * 256 + colt) = pack8(v0, v1);
                    } else if (pn < 9) {
                        *(u32x4*)((bf16*)(ws + WS_VDA) + (size_t)row * 768 + (pn - 6) * 256 + colt) = pack8(v0, v1);
                    } else if (pn < 11) {
                        float* o = (float*)(ws + WS_U) + (size_t)row * 512 + (pn - 9) * 256 + colt; *(f32x4*)o = gelu4(v0); *(f32x4*)(o + 4) = gelu4(v1);
                    } else if (pn < 13) {
                        v0 = gelu4(v0); v1 = gelu4(v1);
                        float* o = (float*)(ws + WS_GV) + (size_t)row * 512 + (pn - 11) * 256 + colt; *(f32x4*)o = v0; *(f32x4*)(o + 4) = v1;
                        float s = ss8(v0, v1); s += __shfl_xor(s, 16); s += __shfl_xor(s, 32);
                        if (fq == 0) ((float*)(ws + WS_GVSS))[(size_t)row * 16 + ((pn - 11) * 2 + bj) * 4 + wc] = s;
                    } else if (pn < 15) {
                        *(u32x4*)((bf16*)(ws + WS_CQ) + (size_t)row * 512 + (pn - 13) * 256 + colt) = pack8(v0, v1); ssq += ss8(v0, v1);
                    } else if (pn < 17) {
                        *(u32x4*)((bf16*)(ws + WS_CKV) + (size_t)row * 512 + (pn - 15) * 256 + colt) = pack8(v0, v1); ssq += ss8(v0, v1);
                    } else {
                        if (colt < 64) {
                            if (lat) { const int j0 = colt >> 1; rope8(v0, v1, ropetab, j0 < 16 ? prow : pcol, j0 & 15); }
                            const u32x4 w = pack8(v0, v1); bf16* o = (bf16*)(ws + WS_KMLA) + (size_t)row * 1152 + 128 + colt;
#pragma unroll
                            for (int h = 0; h < 6; ++h) *(u32x4*)(o + h * 192) = w;
                        }
                    }
                }
                if (pn >= 13 && pn < 17) {
                    ssq += __shfl_xor(ssq, 16); ssq += __shfl_xor(ssq, 32);
                    if (fq == 0) { if (pn < 15) ((float*)(ws + WS_CQSS))[(size_t)row * 8 + (pn - 13) * 4 + wc] = ssq; else ((float*)(ws + WS_CKVSS))[(size_t)row * 8 + (pn - 15) * 4 + wc] = ssq; }
                }
            }
    }
};
__device__ __forceinline__ float rstd8(const float* p, float inv_n) { const f32x4 a = *(const f32x4*)p, b = *(const f32x4*)(p + 4); return 1.0f / sqrtf(((a[0] + a[1]) + (a[2] + a[3]) + (b[0] + b[1]) + (b[2] + b[3])) * inv_n + EPS); }

struct EpiKV {
    static constexpr bool PERM = true, AFTER_DRAIN = false;
    unsigned char* ws;
    __device__ __forceinline__ void operator()(const f32x4 (&acc)[2][2][4][2], const pg8::Unit& u, int wr, int wc, int fr_, int fq_) const {
        int fr = fr_, fq = fq_; asm volatile("" : "+v"(fr), "+v"(fq));
#pragma unroll
        for (int ai = 0; ai < 2; ++ai)
#pragma unroll
            for (int m = 0; m < 4; ++m) {
                const int row = u.pm * 256 + ai * 128 + wr * 64 + m * 16 + fr;
                const float rs = rstd8((const float*)(ws + WS_CKVSS) + (size_t)row * 8, 1.f / RANK);
                const int c = wc * 32 + 8 * fq;
                *(u32x4*)((bf16*)(ws + WS_KMLA) + (size_t)row * 1152 + u.pn * 192 + c) = pack8(acc[ai][0][m][0] * rs, acc[ai][0][m][1] * rs);
                *(u32x4*)((bf16*)(ws + WS_VMLA) + (size_t)row * 768 + u.pn * 128 + c) = pack8(acc[ai][1][m][0] * rs, acc[ai][1][m][1] * rs);
            }
    }
};
struct EpiQ {
    static constexpr bool PERM = true, AFTER_DRAIN = false;
    unsigned char* ws; const float* ropetab;
    __device__ __forceinline__ void operator()(const f32x4 (&acc)[2][2][4][2], const pg8::Unit& u, int wr, int wc, int fr_, int fq_) const {
        int fr = fr_, fq = fq_; asm volatile("" : "+v"(fr), "+v"(fq));
#pragma unroll
        for (int ai = 0; ai < 2; ++ai)
#pragma unroll
            for (int m = 0; m < 4; ++m) {
                const int row = u.pm * 256 + ai * 128 + wr * 64 + m * 16 + fr;
                const int b = row / TOK, rr = row - b * TOK; const bool lat = rr >= CTX; const int t = rr - CTX, prow = (t >> 6) & 31, pcol = t & 63;
                const float rs = rstd8((const float*)(ws + WS_CQSS) + (size_t)row * 8, 1.f / RANK) * MLA_QS;
#pragma unroll
                for (int bj = 0; bj < 2; ++bj) {
                    const int col = u.pn * 256 + bj * 128 + wc * 32 + 8 * fq;
                    if (col < NUQ) {
                        f32x4 v0 = acc[ai][bj][m][0] * rs, v1 = acc[ai][bj][m][1] * rs;
                        const int hd = col / 192, i = col - hd * 192;
                        if (lat && i >= 128) { const int j0 = (i - 128) >> 1; rope8(v0, v1, ropetab, j0 < 16 ? prow : pcol, j0 & 15); }
                        *(u32x4*)((bf16*)(ws + WS_QMLA) + (size_t)row * 1152 + col) = pack8(v0, v1);
                    }
                }
            }
    }
};
struct EpiResid {
    static constexpr bool PERM = true, AFTER_DRAIN = false;
    unsigned char* ws; const float* xin; const float* cin; const float* gate; bool from_inputs;
    __device__ __forceinline__ void operator()(const f32x4 (&acc)[2][2][4][2], const pg8::Unit& u, int wr, int wc, int fr_, int fq_) const {
        int fr = fr_, fq = fq_; asm volatile("" : "+v"(fr), "+v"(fq));
        const int b = u.pm / 9; const bool isctx = (u.pm - b * 9) == 0; const int bsel = isctx ? 4 : b;
        const int c0 = u.pn * 256 + wc * 32 + 8 * fq;
        const float* gp = gate + (size_t)bsel * MODW + c0;
        const int row0 = u.pm * 256 + wr * 64 + fr, rr0 = row0 - b * TOK;
        const float* bp = (from_inputs ? (isctx ? cin + (size_t)(b * CTX + rr0) * DM : xin + (size_t)(b * SEQ + rr0 - CTX) * DM) : (const float*)(ws + WS_XW) + (size_t)row0 * DM) + c0;
        float* op = (float*)(ws + WS_XW) + (size_t)row0 * DM + c0;
        f32x4 g[2][2];
#pragma unroll
        for (int bj = 0; bj < 2; ++bj) { g[bj][0] = *(const f32x4*)(gp + bj * 128); g[bj][1] = *(const f32x4*)(gp + bj * 128 + 4); }
#pragma unroll
        for (int ai = 0; ai < 2; ++ai)
#pragma unroll
            for (int m = 0; m < 4; ++m) {
#pragma unroll
                for (int bj = 0; bj < 2; ++bj) {
                    const f32x4 b0 = *(const f32x4*)(bp + bj * 128), b1 = *(const f32x4*)(bp + bj * 128 + 4);
                    *(f32x4*)(op + bj * 128) = b0 + g[bj][0] * acc[ai][bj][m][0]; *(f32x4*)(op + bj * 128 + 4) = b1 + g[bj][1] * acc[ai][bj][m][1]; }
                const int adv = (m == 3 ? 80 : 16) * DM; bp += adv; op += adv; asm volatile("" : "+v"(bp), "+v"(op));
            }
    }
};
struct EpiSlab {
    static constexpr bool PERM = true, AFTER_DRAIN = false;
    float* slab; const float* gate;
    __device__ __forceinline__ void operator()(const f32x4 (&acc)[2][2][4][2], const pg8::Unit& u, int wr, int wc, int fr_, int fq_) const {
        int fr = fr_, fq = fq_; asm volatile("" : "+v"(fr), "+v"(fq));
        const int b = u.pm / 9; const int c0 = u.pn * 256 + wc * 32 + 8 * fq; const float* gp = gate + c0;
        float* op = slab + ((size_t)u.ks * 1024 + b * CTX + wr * 64 + fr) * DM + c0;
        f32x4 g[2][2];
#pragma unroll
        for (int bj = 0; bj < 2; ++bj) { g[bj][0] = *(const f32x4*)(gp + bj * 128); g[bj][1] = *(const f32x4*)(gp + bj * 128 + 4); }
#pragma unroll
        for (int ai = 0; ai < 2; ++ai)
#pragma unroll
            for (int m = 0; m < 4; ++m) {
#pragma unroll
                for (int bj = 0; bj < 2; ++bj) { *(f32x4*)(op + bj * 128) = g[bj][0] * acc[ai][bj][m][0]; *(f32x4*)(op + bj * 128 + 4) = g[bj][1] * acc[ai][bj][m][1]; }
                op += (m == 3 ? 80 : 16) * DM; asm volatile("" : "+v"(op));
            }
    }
};
struct EpiFc1 {
    static constexpr bool PERM = true, AFTER_DRAIN = false;
    unsigned char* ws;
    __device__ __forceinline__ void operator()(const f32x4 (&acc)[2][2][4][2], const pg8::Unit& u, int wr, int wc, int fr_, int fq_) const {
        int fr = fr_, fq = fq_; asm volatile("" : "+v"(fr), "+v"(fq));
#pragma unroll
        for (int ai = 0; ai < 2; ++ai)
#pragma unroll
            for (int m = 0; m < 4; ++m) {
                const int row = u.pm * 256 + ai * 128 + wr * 64 + m * 16 + fr;
#pragma unroll
                for (int bj = 0; bj < 2; ++bj) { const int c = u.pn * 256 + bj * 128 + wc * 32 + 8 * fq;
                    f32x4 v0 = __builtin_elementwise_max(acc[ai][bj][m][0], (f32x4){0.f, 0.f, 0.f, 0.f}), v1 = __builtin_elementwise_max(acc[ai][bj][m][1], (f32x4){0.f, 0.f, 0.f, 0.f});
                    *(u32x4*)((bf16*)(ws + WS_ACT) + (size_t)row * FF + c) = pack8(v0 * v0, v1 * v1); }
            }
    }
};
#define XB_TMO      128
#define XB_XCNT(j)  (256  + 64 * (j))
#define XB_XSUB(j)  (1280 + 64 * (j))
#define XB_XGEN(j)  (2304 + 64 * (j))
#define XB_TOP      3328
#define XB_TOPGEN   3392
#define XCD_BAR_WORDS 3456
#define XB_SPIN_CAP (1u << 18)

__device__ __forceinline__ unsigned xb_ld(unsigned* p)              { return __hip_atomic_load(p, __ATOMIC_RELAXED, __HIP_MEMORY_SCOPE_AGENT); }
__device__ __forceinline__ unsigned xb_add(unsigned* p, unsigned v) { return __hip_atomic_fetch_add(p, v, __ATOMIC_RELAXED, __HIP_MEMORY_SCOPE_AGENT); }
__device__ __forceinline__ unsigned xb_xcc_id() { return (unsigned)__builtin_amdgcn_s_getreg((3 << 11) | 20) & 0xFu; }
#define XB_SPIN(cond, bar) do { unsigned _sp = 0; while (cond) { __builtin_amdgcn_s_sleep(1); \
    if ((++_sp & 255u) == 0u) { if (xb_ld(&(bar)[XB_TMO])) break; if (_sp > XB_SPIN_CAP) { atomicAdd(&(bar)[XB_TMO], 1u); break; } } } } while (0)

struct XcdBarrier {
    unsigned* bar; unsigned x;
    volatile LAS unsigned* st;
};

__device__ __forceinline__ XcdBarrier xcd_barrier_post(unsigned* bar, volatile LAS unsigned* st) {
    XcdBarrier b; b.bar = bar; b.x = xb_xcc_id(); b.st = st;
    if (threadIdx.x == 0) (void)xb_add(&bar[XB_XCNT(b.x)], 1u);
    return b;
}
__device__ __forceinline__ void xcd_barrier_complete(unsigned* bar, unsigned x, unsigned& nloc, unsigned& nx) {
    const unsigned G = gridDim.x * gridDim.y * gridDim.z;
    unsigned sum, cnt, mine, sp = 0u;
    for (;;) {
        sum = 0u; cnt = 0u; mine = 0u;
#pragma unroll
        for (unsigned j = 0; j < 16; ++j) { const unsigned c = xb_ld(&bar[XB_XCNT(j)]); sum += c; cnt += (c > 0u) ? 1u : 0u; mine = (j == x) ? c : mine; }
        if (sum == G) break;
        __builtin_amdgcn_s_sleep(1);
        if ((++sp & 255u) == 0u) { if (xb_ld(&bar[XB_TMO])) break; if (sp > XB_SPIN_CAP) { atomicAdd(&bar[XB_TMO], 1u); break; } }
    }
    nloc = mine > 0u ? mine : 1u; nx = cnt > 0u ? cnt : 1u;
}

__device__ __forceinline__ void xcd_barrier(const XcdBarrier& b) {
    asm volatile("s_waitcnt vmcnt(0)" ::: "memory");
    __syncthreads();
    if (threadIdx.x == 0) {
        unsigned* bar = b.bar;
        __builtin_amdgcn_s_waitcnt(0);
        unsigned nloc = b.st[0], nx = b.st[1];
        if (nloc == 0u) { xcd_barrier_complete(bar, b.x, nloc, nx); b.st[0] = nloc; b.st[1] = nx; }
        const unsigned old = xb_add(&bar[XB_XSUB(b.x)], 1u);
        const unsigned gen = old / nloc;
        if (old + 1u == (gen + 1u) * nloc) {
            __builtin_amdgcn_fence(__ATOMIC_RELEASE, "agent");
            asm volatile("s_waitcnt vmcnt(0)" ::: "memory");
            const unsigned og = xb_add(&bar[XB_TOP], 1u);
            const unsigned tg = og / nx;
            if (og + 1u == (tg + 1u) * nx) xb_add(&bar[XB_TOPGEN], 1u);
            else XB_SPIN(xb_ld(&bar[XB_TOPGEN]) == tg, bar);
            __builtin_amdgcn_fence(__ATOMIC_ACQUIRE, "agent");
            xb_add(&bar[XB_XGEN(b.x)], 1u);
            asm volatile("s_waitcnt vmcnt(0)" ::: "memory");
        } else {
            XB_SPIN(xb_ld(&bar[XB_XGEN(b.x)]) == gen, bar);
            __builtin_amdgcn_fence(__ATOMIC_ACQUIRE, "agent");
            asm volatile("s_waitcnt vmcnt(0)" ::: "memory");
        }
    }
    __syncthreads();
}

namespace att {
#define SBAR() __builtin_amdgcn_sched_barrier(0)
constexpr int V_TILE = 64 * 128 * 2, K_OFF = 2 * V_TILE, K_TILE_MAX = 64 * 192 * 2, WS_OFF = K_OFF + 2 * K_TILE_MAX;
constexpr int QR_OFF = WS_OFF + 2048;
constexpr float THR = 6.0f;
__device__ __forceinline__ int crow(int r, int hi) { return (r & 3) + 8 * (r >> 2) + 4 * hi; }
__device__ __forceinline__ int v_st(int k, int c) { const int kk = (k & ~0xC) | ((k & 4) << 1) | ((k & 8) >> 1); return ((kk >> 3) * 4 + (c >> 5)) * 512 + ((kk & 7) * 32 + (c & 31)) * 2; }
__device__ __forceinline__ int v_rd_base(int lane) { return ((lane & 3) << 3) | (((lane >> 2) & 3) << 6) | (((lane >> 4) & 1) << 5) | (((lane >> 5) & 1) << 8); }
constexpr int v_rd_off(int d0, int ks, int half) { return d0 * 512 + ks * 4096 + half * 2048; }
template <int OFF> __device__ __forceinline__ s16x4 tr_read(int vb) { s16x4 r; asm volatile("ds_read_b64_tr_b16 %0, %1 offset:%2" : "=&v"(r) : "v"(vb), "i"(OFF) : "memory"); return r; }
template <int D0> __device__ __forceinline__ void pv_one(f32x16& od, int vb, bf16x8 pa0, bf16x8 pa1, bf16x8 pa2, bf16x8 pa3) {
    const s16x4 l0 = tr_read<v_rd_off(D0, 0, 0)>(vb), h0 = tr_read<v_rd_off(D0, 0, 1)>(vb), l1 = tr_read<v_rd_off(D0, 1, 0)>(vb), h1 = tr_read<v_rd_off(D0, 1, 1)>(vb);
    const s16x4 l2 = tr_read<v_rd_off(D0, 2, 0)>(vb), h2 = tr_read<v_rd_off(D0, 2, 1)>(vb), l3 = tr_read<v_rd_off(D0, 3, 0)>(vb), h3 = tr_read<v_rd_off(D0, 3, 1)>(vb);
    asm volatile("s_waitcnt lgkmcnt(0)" ::: "memory"); SBAR();
#define PK(L, H) (bf16x8){L[0], L[1], L[2], L[3], H[0], H[1], H[2], H[3]}
    od = __builtin_amdgcn_mfma_f32_32x32x16_bf16(pa0, PK(l0, h0), od, 0, 0, 0);
    od = __builtin_amdgcn_mfma_f32_32x32x16_bf16(pa1, PK(l1, h1), od, 0, 0, 0);
    od = __builtin_amdgcn_mfma_f32_32x32x16_bf16(pa2, PK(l2, h2), od, 0, 0, 0);
    od = __builtin_amdgcn_mfma_f32_32x32x16_bf16(pa3, PK(l3, h3), od, 0, 0, 0);
#undef PK
}

template <int KS> __device__ __forceinline__ void v_read8(int vb, s16x4 (&L)[4], s16x4 (&H)[4]) {
    L[0] = tr_read<v_rd_off(0, KS, 0)>(vb); H[0] = tr_read<v_rd_off(0, KS, 1)>(vb); L[1] = tr_read<v_rd_off(1, KS, 0)>(vb); H[1] = tr_read<v_rd_off(1, KS, 1)>(vb);
    L[2] = tr_read<v_rd_off(2, KS, 0)>(vb); H[2] = tr_read<v_rd_off(2, KS, 1)>(vb); L[3] = tr_read<v_rd_off(3, KS, 0)>(vb); H[3] = tr_read<v_rd_off(3, KS, 1)>(vb);
}
#define PKV(L, H) (bf16x8){L[0], L[1], L[2], L[3], H[0], H[1], H[2], H[3]}
__device__ __forceinline__ void pv_mma4(f32x16 (&o)[4], bf16x8 pa, const s16x4 (&L)[4], const s16x4 (&H)[4]) {
    o[0] = __builtin_amdgcn_mfma_f32_32x32x16_bf16(pa, PKV(L[0], H[0]), o[0], 0, 0, 0);
    o[1] = __builtin_amdgcn_mfma_f32_32x32x16_bf16(pa, PKV(L[1], H[1]), o[1], 0, 0, 0);
    o[2] = __builtin_amdgcn_mfma_f32_32x32x16_bf16(pa, PKV(L[2], H[2]), o[2], 0, 0, 0);
    o[3] = __builtin_amdgcn_mfma_f32_32x32x16_bf16(pa, PKV(L[3], H[3]), o[3], 0, 0, 0);
}
__device__ __forceinline__ void pv_all(f32x16 (&o)[4], int vb, bf16x8 pa0, bf16x8 pa1, bf16x8 pa2, bf16x8 pa3) {
    s16x4 LA[4], HA[4], LB[4], HB[4];
    v_read8<0>(vb, LA, HA); v_read8<1>(vb, LB, HB);
    asm volatile("s_waitcnt lgkmcnt(8)" ::: "memory"); SBAR(); pv_mma4(o, pa0, LA, HA); SBAR();
    v_read8<2>(vb, LA, HA);
    asm volatile("s_waitcnt lgkmcnt(8)" ::: "memory"); SBAR(); pv_mma4(o, pa1, LB, HB); SBAR();
    v_read8<3>(vb, LB, HB);
    asm volatile("s_waitcnt lgkmcnt(8)" ::: "memory"); SBAR(); pv_mma4(o, pa2, LA, HA); SBAR();
    asm volatile("s_waitcnt lgkmcnt(0)" ::: "memory"); SBAR(); pv_mma4(o, pa3, LB, HB);
}
#undef PKV
template <int DQK> __device__ __forceinline__ int k_off(int r, int c) { return r * (DQK * 2) + ((c ^ ((r >> 1) & 7)) << 4); }

template <int DQK>
__device__ __forceinline__ void attn_pass(f32x16 (&o)[4], const bf16* __restrict__ Qw, int ldq, const bf16* __restrict__ Kb, int ldk, const bf16* __restrict__ Vb, int ldv, int NT, LAS unsigned char* lds) {
    constexpr int KT = 64 * DQK * 2, NKC = DQK / 8, NKS = (64 * NKC) / NTHR, ND = DQK / 16;
    int tid_ = threadIdx.x; asm volatile("" : "+v"(tid_)); const int tid = tid_, wid = tid >> 6, lane = tid & 63, r32 = lane & 31, hi = lane >> 5;
    LAS unsigned char* V_lds = lds; LAS unsigned char* K_lds = lds + K_OFF;
    LAS float* wsf = (LAS float*)(lds + WS_OFF) + wid * 64;
    constexpr int NDR = ND < 8 ? ND : 8;
    bf16x8 qr[NDR];
#pragma unroll
    for (int d0 = 0; d0 < NDR; ++d0) qr[d0] = *(const bf16x8*)(Qw + (size_t)r32 * ldq + d0 * 16 + hi * 8);
    LAS unsigned char* qpark = lds + QR_OFF + wid * 4096 + lane * 16;
#pragma unroll
    for (int d0 = NDR; d0 < ND; ++d0) *(LAS bf16x8*)(qpark + (d0 - NDR) * 1024) = *(const bf16x8*)(Qw + (size_t)r32 * ldq + d0 * 16 + hi * 8);
    unsigned kgo[NKS]; int klo[NKS];
#pragma unroll
    for (int i = 0; i < NKS; ++i) { const int idx = tid + NTHR * i, r = idx / NKC, c = idx - r * NKC; kgo[i] = (unsigned)(r * ldk + c * 8) * 2u; klo[i] = k_off<DQK>(r, c); }
    const int sr = tid >> 4, sc = (tid & 15) * 8, vst0 = v_st(sr, sc), vst1 = v_st(32 + sr, sc);
    const unsigned vgo0 = (unsigned)(sr * ldv + sc) * 2u, vgo1 = (unsigned)((32 + sr) * ldv + sc) * 2u;
    const int vb0 = (int)(uintptr_t)V_lds + v_rd_base(lane);
    bf16x8 ksA[NKS], vsA0, vsA1, ksB[NKS], vsB0, vsB1;
#define SLOAD(S, k0) do { const char* kt_ = (const char*)(Kb + (size_t)(k0) * ldk); const char* vt_ = (const char*)(Vb + (size_t)(k0) * ldv); \
        _Pragma("unroll") for (int i_ = 0; i_ < NKS; ++i_) ks##S[i_] = *(const bf16x8*)(kt_ + kgo[i_]); \
        vs##S##0 = *(const bf16x8*)(vt_ + vgo0); vs##S##1 = *(const bf16x8*)(vt_ + vgo1); } while (0)
#define SWRITE(S, buf) do { _Pragma("unroll") for (int i_ = 0; i_ < NKS; ++i_) *(LAS bf16x8*)(K_lds + (buf) * KT + klo[i_]) = ks##S[i_]; \
        *(LAS bf16x8*)(V_lds + (buf) * V_TILE + vst0) = vs##S##0; *(LAS bf16x8*)(V_lds + (buf) * V_TILE + vst1) = vs##S##1; } while (0)
    float m_reg = -1e30f, l_reg = 0.f;
#pragma unroll
    for (int d = 0; d < 4; ++d) o[d] = f32x16{};
#define TILE(buf) do { \
        f32x16 p0 = f32x16{}, p1 = f32x16{}; \
        { const LAS unsigned char* Kt = K_lds + (buf) * KT; \
          _Pragma("unroll") for (int d0 = 0; d0 < ND; ++d0) { \
              const bf16x8 b0 = *(const LAS bf16x8*)(Kt + k_off<DQK>(r32, 2 * d0 + hi)), b1 = *(const LAS bf16x8*)(Kt + k_off<DQK>(32 + r32, 2 * d0 + hi)); \
              bf16x8 qf; if (d0 < NDR) qf = qr[d0 < NDR ? d0 : 0]; else qf = *(const LAS bf16x8*)(qpark + (d0 - NDR) * 1024); \
              p0 = __builtin_amdgcn_mfma_f32_32x32x16_bf16(b0, qf, p0, 0, 0, 0); \
              p1 = __builtin_amdgcn_mfma_f32_32x32x16_bf16(b1, qf, p1, 0, 0, 0); } } \
        float pmax = p0[0]; \
        _Pragma("unroll") for (int r = 1; r < 16; ++r) pmax = fmaxf(pmax, p0[r]); \
        _Pragma("unroll") for (int r = 0; r < 16; ++r) pmax = fmaxf(pmax, p1[r]); \
        { auto rr = __builtin_amdgcn_permlane32_swap(__float_as_uint(pmax), __float_as_uint(pmax), false, false); pmax = fmaxf(__uint_as_float(rr[0]), __uint_as_float(rr[1])); } \
        float alpha = 1.f; \
        if (!__all(pmax - m_reg <= THR)) { const float mn = fmaxf(m_reg, pmax); alpha = __builtin_amdgcn_exp2f(m_reg - mn); m_reg = mn; \
            if (hi == 0) wsf[r32] = alpha; asm volatile("s_waitcnt lgkmcnt(0)" ::: "memory"); \
            _Pragma("unroll") for (int r = 0; r < 16; ++r) { const float a = wsf[crow(r, hi)]; \
                _Pragma("unroll") for (int d = 0; d < 4; ++d) o[d][r] *= a; } \
            asm volatile("s_waitcnt lgkmcnt(0)" ::: "memory"); } \
        float ps = 0.f; \
        _Pragma("unroll") for (int r = 0; r < 16; ++r) { p0[r] = __builtin_amdgcn_exp2f(p0[r] - m_reg); p1[r] = __builtin_amdgcn_exp2f(p1[r] - m_reg); ps += p0[r] + p1[r]; } \
        { auto rr = __builtin_amdgcn_permlane32_swap(__float_as_uint(ps), __float_as_uint(ps), false, false); ps = __uint_as_float(rr[0]) + __uint_as_float(rr[1]); } \
        l_reg = l_reg * alpha + ps; \
        bf16x8 pa0, pa1, pa2, pa3; \
        PK4(p0, 0, pa0); PK4(p0, 8, pa1); PK4(p1, 0, pa2); PK4(p1, 8, pa3); \
        SBAR(); \
        { const int vb = vb0 + (buf) * V_TILE; \
          if constexpr (DQK == 64) pv_all(o, vb, pa0, pa1, pa2, pa3); else { pv_one<0>(o[0], vb, pa0, pa1, pa2, pa3); pv_one<1>(o[1], vb, pa0, pa1, pa2, pa3); pv_one<2>(o[2], vb, pa0, pa1, pa2, pa3); pv_one<3>(o[3], vb, pa0, pa1, pa2, pa3); } } \
    } while (0)
#define PK4(P, BASE, OUT) do { unsigned a0 = cvtpk(P[BASE + 0], P[BASE + 1]), a1 = cvtpk(P[BASE + 2], P[BASE + 3]); \
        unsigned b0 = cvtpk(P[BASE + 4], P[BASE + 5]), b1 = cvtpk(P[BASE + 6], P[BASE + 7]); \
        auto r0 = __builtin_amdgcn_permlane32_swap(a0, b0, false, false); auto r1 = __builtin_amdgcn_permlane32_swap(a1, b1, false, false); \
        u32x4 w = {r0[0], r1[0], r0[1], r1[1]}; OUT = __builtin_bit_cast(bf16x8, w); } while (0)
    if constexpr (DQK == 64) {
    SLOAD(A, 0); SLOAD(B, 64); SWRITE(A, 0); __syncthreads();
    for (int j = 0; j < NT; j += 2) {
        { const int t2 = (j + 2 < NT) ? j + 2 : NT - 2; SLOAD(A, t2 * 64); }
        TILE(0);
        SWRITE(B, 1);
        __syncthreads();
        { const int t3 = (j + 3 < NT) ? j + 3 : NT - 1; SLOAD(B, t3 * 64); }
        TILE(1);
        SWRITE(A, 0);
        __syncthreads();
    }
    } else {
    SLOAD(A, 0); SWRITE(A, 0); __syncthreads();
    for (int j = 0; j < NT; j += 2) {
        SLOAD(A, (j + 1) * 64);
        TILE(0);
        SWRITE(A, 1);
        __syncthreads();
        if (j + 2 < NT) SLOAD(A, (j + 2) * 64);
        TILE(1);
        if (j + 2 < NT) SWRITE(A, 0);
        __syncthreads();
    }
    }
#undef PK4
#undef TILE
    if (hi == 0) wsf[32 + r32] = l_reg; asm volatile("s_waitcnt lgkmcnt(0)" ::: "memory");
#pragma unroll
    for (int r = 0; r < 16; ++r) { const float rl = 1.0f / wsf[32 + crow(r, hi)];
#pragma unroll
        for (int d = 0; d < 4; ++d) o[d][r] *= rl; }
    asm volatile("s_waitcnt lgkmcnt(0)" ::: "memory");
#undef SLOAD
#undef SWRITE
}


__device__ __forceinline__ void store_o(const f32x16 (&o)[4], const float (&rs)[16], const float (&gcol)[4], bf16* dst, int ld, LAS unsigned char* lds, int wid, int lane) {
    const int r32 = lane & 31, hi = lane >> 5;
    LAS unsigned short* stg = (LAS unsigned short*)(lds + wid * 8192);
#pragma unroll
    for (int d = 0; d < 4; ++d)
#pragma unroll
        for (int r = 0; r < 16; ++r) stg[crow(r, hi) * 128 + d * 32 + r32] = (unsigned short)(cvtpk(o[d][r] * rs[r] * gcol[d], 0.f) & 0xffffu);
    asm volatile("s_waitcnt lgkmcnt(0)" ::: "memory");
    bf16* p = dst + (size_t)(lane >> 4) * ld + (lane & 15) * 8;
#pragma unroll
    for (int i = 0; i < 8; ++i) { const u32x4 v = *(const LAS u32x4*)(stg + (i * 4 + (lane >> 4)) * 128 + (lane & 15) * 8); *(u32x4*)p = v; p += 4 * (size_t)ld; asm volatile("" : "+v"(p)); }
}

__device__ __forceinline__ void da_unit(const Args& A, const Frame& F, int l, int q0, int k0, int NT, int h) {
    int tid_ = threadIdx.x; asm volatile("" : "+v"(tid_)); const int tid = tid_, wid = tid >> 6, lane = tid & 63, r32 = lane & 31, hi = lane >> 5;
    const bf16* Q = WSP(bf16, WS_QDA); const bf16* K = WSP(bf16, WS_KDA); const bf16* V = WSP(bf16, WS_VDA);
    float* stash = WSP(float, WS_STASH) + ((size_t)blockIdx.x * NTHR + tid) * 64;
    const float lam = WSP(float, WS_SCAL)[l]; const float lam_init = 0.8f - 0.6f * expf(-0.3f * (float)l);
    f32x16 o[4];
    attn_pass<64>(o, Q + (size_t)(q0 + wid * 32) * 768 + (2 * h) * 64, 768, K + (size_t)k0 * 768 + (2 * h) * 64, 768, V + (size_t)k0 * 768 + h * 128, 768, NT, F.lds);
#pragma unroll
    for (int d = 0; d < 4; ++d)
#pragma unroll
        for (int r = 0; r < 16; r += 4) *(f32x4*)(stash + d * 16 + r) = (f32x4){o[d][r], o[d][r + 1], o[d][r + 2], o[d][r + 3]};
    attn_pass<64>(o, Q + (size_t)(q0 + wid * 32) * 768 + (2 * h + 1) * 64, 768, K + (size_t)k0 * 768 + (2 * h + 1) * 64, 768, V + (size_t)k0 * 768 + h * 128, 768, NT, F.lds);
    float ss[16];
#pragma unroll
    for (int r = 0; r < 16; ++r) ss[r] = 0.f;
#pragma unroll
    for (int d = 0; d < 4; ++d) {
#pragma unroll
        for (int r = 0; r < 16; r += 4) { const f32x4 s4 = *(const f32x4*)(stash + d * 16 + r);
#pragma unroll
            for (int e = 0; e < 4; ++e) { const float v = s4[e] - lam * o[d][r + e]; o[d][r + e] = v; ss[r + e] += v * v; } }
        asm volatile("" ::: "memory"); SBAR(); }
#pragma unroll
    for (int r = 0; r < 16; ++r) { float s = ss[r]; s += __shfl_xor(s, 1); s += __shfl_xor(s, 2); s += __shfl_xor(s, 4); s += __shfl_xor(s, 8); s += __shfl_xor(s, 16);
        ss[r] = (1.0f / sqrtf(s * (1.f / 128.f) + EPS)) * (1.f - lam_init); }
    const float* gs = inp<I_GDASUB>() + l * 128;
    float gcol[4];
#pragma unroll
    for (int d = 0; d < 4; ++d) gcol[d] = gs[d * 32 + r32];
    store_o(o, ss, gcol, WSP(bf16, WS_HEADS) + (size_t)(q0 + wid * 32) * DM + h * 128, DM, F.lds, wid, lane);
    __syncthreads();
}
__device__ __forceinline__ void mla_unit(const Args& A, const Frame& F, int q0, int k0, int NT, int h) {
    int tid_ = threadIdx.x; asm volatile("" : "+v"(tid_)); const int tid = tid_, wid = tid >> 6, lane = tid & 63, r32 = lane & 31, hi = lane >> 5;
    f32x16 o[4];
    attn_pass<192>(o, WSP(bf16, WS_QMLA) + (size_t)(q0 + wid * 32) * 1152 + h * 192, 1152, WSP(bf16, WS_KMLA) + (size_t)k0 * 1152 + h * 192, 1152, WSP(bf16, WS_VMLA) + (size_t)k0 * 768 + h * 128, 768, NT, F.lds);
    float rs[16], gcol[4];
#pragma unroll
    for (int r = 0; r < 16; ++r) rs[r] = 1.f;
#pragma unroll
    for (int d = 0; d < 4; ++d) gcol[d] = 1.f;
    store_o(o, rs, gcol, WSP(bf16, WS_HEADS) + (size_t)(q0 + wid * 32) * DM + 1280 + h * 128, DM, F.lds, wid, lane);
    __syncthreads();
}
__device__ __forceinline__ void da_latent(const Args& A, const Frame& F, int l, int v) { const int bh = v >> 3, qb = v & 7, b = bh / 6, h = bh - b * 6; da_unit(A, F, l, b * TOK + CTX + qb * 256, b * TOK, 36, h); }
__device__ __forceinline__ void da_ctx(const Args& A, const Frame& F, int l, int v) { const int b = v / 6, h = v - b * 6; da_unit(A, F, l, b * TOK, b * TOK, 4, h); }
__device__ __forceinline__ void mla_phase(const Args& A, const Frame& F, bool with_ctx) {
    const int nun = with_ctx ? 216 : 192;
    for (int un = F.vcu; un < nun; un += F.G) {
        if (un < 192) { const int bh = un >> 3, qb = un & 7, b = bh / 6, h = bh - b * 6; mla_unit(A, F, b * TOK + CTX + qb * 256, b * TOK, 36, h); }
        else { const int v = un - 192, b = v / 6, h = v - b * 6; mla_unit(A, F, b * TOK, b * TOK, 4, h); }
    }
}

__device__ __forceinline__ void gate_unit(const Args& A, const Frame& F, int l, int ch, int g) {
    int tid_ = threadIdx.x; asm volatile("" : "+v"(tid_)); const int tid = tid_, wid = tid >> 6, lane = tid & 63, r32 = lane & 31, hi = lane >> 5;
    const int r0 = ch * 128;
    LAS unsigned char* img = F.lds;
    { const int sc = (tid & 15) * 8; const float* gain = inp<I_GGMV>() + (l * 4 + g) * 128 + sc; const f32x4 g0 = *(const f32x4*)gain, g1 = *(const f32x4*)(gain + 4);
#pragma unroll
      for (int i = 0; i < 4; ++i) { const int q = (tid >> 4) + 32 * i, row = r0 + q;
          const float* src = WSP(float, WS_GV) + (size_t)row * 512 + g * 128 + sc; const f32x4 a = *(const f32x4*)src, b = *(const f32x4*)(src + 4);
          const f32x4 sq = *(const f32x4*)(WSP(float, WS_GVSS) + (size_t)row * 16 + g * 4); const float rs = 1.0f / sqrtf(((sq[0] + sq[1]) + (sq[2] + sq[3])) * (1.f / 128.f) + EPS);
          *(LAS u32x4*)(img + (q >> 6) * V_TILE + v_st(q & 63, sc)) = pack8(a * rs * g0, b * rs * g1); } }
    __syncthreads();
    const int pb = wid & 3, chh = wid >> 2;
    const bf16* Wsg = WSP(bf16, WS_WSP) + ((size_t)(l * 4 + g) * 128 + pb * 32 + r32) * 128 + hi * 8;
    f32x16 acc0 = f32x16{}, acc1 = f32x16{};
    const int vb0 = (int)(uintptr_t)img + v_rd_base(lane);
#pragma unroll
    for (int t = 0; t < 2; ++t) {
        const bf16x8 a0 = *(const bf16x8*)(Wsg + t * 64), a1 = *(const bf16x8*)(Wsg + t * 64 + 16), a2 = *(const bf16x8*)(Wsg + t * 64 + 32), a3 = *(const bf16x8*)(Wsg + t * 64 + 48);
        const int vb = vb0 + t * V_TILE;
        if (chh == 0) { pv_one<0>(acc0, vb, a0, a1, a2, a3); pv_one<1>(acc1, vb, a0, a1, a2, a3); }
        else          { pv_one<2>(acc0, vb, a0, a1, a2, a3); pv_one<3>(acc1, vb, a0, a1, a2, a3); }
    }
    const float* bs = inp<I_BSP>() + (l * 4 + g) * 128 + pb * 32;
    LAS float* mix = (LAS float*)(F.lds + 2 * V_TILE);
#pragma unroll
    for (int r = 0; r < 16; ++r) { const int p = crow(r, hi); const float bias = bs[p]; LAS float* mp = mix + (pb * 32 + p) * 128 + chh * 64 + r32; mp[0] = acc0[r] + bias; mp[32] = acc1[r] + bias; }
    __syncthreads();
    { const int sc = (tid & 15) * 8; const float* up = WSP(float, WS_U) + (size_t)(r0 + (tid >> 4)) * 512 + g * 128 + sc; bf16* hp = WSP(bf16, WS_HEADS) + (size_t)(r0 + (tid >> 4)) * DM + 768 + g * 128 + sc;
#pragma unroll
      for (int i = 0; i < 4; ++i) { const LAS float* mp = mix + ((tid >> 4) + 32 * i) * 128 + sc; const f32x4 m0 = *(const LAS f32x4*)mp, m1 = *(const LAS f32x4*)(mp + 4);
          const f32x4 u0 = *(const f32x4*)up, u1 = *(const f32x4*)(up + 4); *(u32x4*)hp = pack8(u0 * m0, u1 * m1);
          up += 32 * 512; hp += 32 * (size_t)DM; asm volatile("" : "+v"(up), "+v"(hp)); } }
    __syncthreads();
}
#undef SBAR
}

#ifndef MK_SPLIT
#define MK_SPLIT 0
#endif
constexpr int PH_PER_LAYER = 8, PH_FINAL = 2 + PH_PER_LAYER * DEPTH, N_PHASES = PH_FINAL + 1;

__global__ void __launch_bounds__(NTHR, 2) fwd_kernel(Args args) {
    extern __shared__ __attribute__((aligned(16))) unsigned char lds_raw[];
    cg::grid_group grid = cg::this_grid();
    Frame F;
    F.lds = (LAS unsigned char*)lds_raw;
    F.G = gridDim.x; { const int bx = blockIdx.x; F.vcu = (F.G % 8 == 0) ? (bx % 8) * (F.G / 8) + bx / 8 : bx; }
    const Args& A = args;
    F.out = args.out; F.ws = args.ws;
    const int lo = args.ph_lo, hi = args.ph_hi;
#ifndef PH_MASK
#define PH_MASK 0x7ff
#endif
#define PHM(j) (((PH_MASK) >> (j)) & 1)
#ifndef RPT_MASK
#define RPT_MASK 0
#endif
#define NREP(j) ((((RPT_MASK) >> (j)) & 1) ? 2 : 1)
#define IN(k) (lo <= (k) && (k) < hi)
#define SEAM(k) do { if (IN(k) && IN((k) + 1)) xcd_barrier(xb); } while (0)
    const float* ropetab = WSP(float, WS_ROPE);
    volatile LAS unsigned* MISC = (volatile LAS unsigned*)(F.lds + 131072);
    if (threadIdx.x < 64) MISC[threadIdx.x] = 0u;
    unsigned* barw = (unsigned*)(F.ws + WS_BAR);
    if (blockIdx.x == 0) for (int i = threadIdx.x; i < XCD_BAR_WORDS; i += NTHR) barw[i] = 0u;
    __syncthreads();
    XcdBarrier xb; xb.bar = barw; xb.x = 0; xb.st = MISC + 8;

    for (int rep_ = 0; rep_ < NREP(0); ++rep_) { if (rep_) xcd_barrier(xb); if (PHM(0) && IN(0)) { p0_prologue(A, F); } }
    if (IN(0) && IN(1)) { grid.sync(); }
    xb = xcd_barrier_post(barw, MISC + 8);
    for (int rep_ = 0; rep_ < NREP(1); ++rep_) { if (rep_) xcd_barrier(xb); if (PHM(1) && IN(1)) { p0b_modreduce(A, F); } } SEAM(1);

    for (int l = 0; l < DEPTH; ++l) {
        const int pb = 2 + PH_PER_LAYER * l; const bool last = (l == DEPTH - 1); const bool first = (l == 0);
        const float* modl = WSP(float, WS_MOD) + (size_t)l * 5 * MODW;
        for (int rep_ = 0; rep_ < NREP(2); ++rep_) { if (rep_) xcd_barrier(xb); if (PHM(2) && IN(pb + 0)) { norm_phase(A, F, l, first ? 1 : 0, inp<I_GMIX>() + l * DM, 0, first ? nullptr : WSP(float, WS_SLAB), false); } } SEAM(pb + 0);
        for (int rep_ = 0; rep_ < NREP(3); ++rep_) { if (rep_) xcd_barrier(xb); if (PHM(3) && IN(pb + 1)) {
            pg8::Gemm g{WSP(bf16, WS_HN), WSP(bf16, WS_WIN) + (size_t)l * NZP * DM, M, NZP, DM, DM}; TileOrder S; S.init(NZP, F.G, (int)blockIdx.x, 0);
            EpiZ E{F.ws, ropetab};
            pg8::gemm_phase<EpiZ, TileOrder, true, true>(F.lds, g, S, E);
        } } SEAM(pb + 1);
        for (int rep_ = 0; rep_ < NREP(4); ++rep_) { if (rep_) xcd_barrier(xb); if (PHM(4) && IN(pb + 2)) {
            const bool split = F.G >= 200; const int naux = split ? F.G - 192 : F.G, caux = split ? F.vcu - 192 : F.vcu;
            if (split && F.vcu < 192) { att::da_latent(A, F, l, F.vcu); }
            else {
                { pg8::Gemm g{WSP(bf16, WS_CKV), WSP(bf16, WS_WUKV) + (size_t)l * NUKV * RANK, M, NUKV, RANK, RANK}; TileOrder S; S.init(NUKV, naux, caux, 0);
                  EpiKV E{F.ws}; pg8::gemm_phase<EpiKV, TileOrder, true, true>(F.lds, g, S, E); }
                { pg8::Gemm g{WSP(bf16, WS_CQ), WSP(bf16, WS_WUQ) + (size_t)l * NUQP * RANK, M, NUQP, RANK, RANK}; TileOrder S; S.init(NUQP, naux, caux, last ? 1 : 0);
                  EpiQ E{F.ws, ropetab}; pg8::gemm_phase<EpiQ, TileOrder, true, true>(F.lds, g, S, E); }
                for (int un = caux; un < 72 * 4; un += naux) { const int ch = un >> 2, g = un & 3; if (last && (ch % 18) < 2) continue; att::gate_unit(A, F, l, ch, g); }
                if (!last) for (int un = caux; un < 24; un += naux) att::da_ctx(A, F, l, un);
                if (!split) for (int un = caux; un < 192; un += naux) att::da_latent(A, F, l, un);
                if (DEFER_CONV) { __syncthreads(); conv_weights(A, F, l, J_OUT, caux, naux); __syncthreads(); }
            }
        } } SEAM(pb + 2);
        for (int rep_ = 0; rep_ < NREP(5); ++rep_) { if (rep_) xcd_barrier(xb); if (PHM(5) && IN(pb + 3)) { att::mla_phase(A, F, !last);
            if (DEFER_CONV && F.G >= 200 && F.vcu >= 192) { __syncthreads(); conv_weights(A, F, l, last ? (J_FC1 | J_FC2) : J_FC1, F.vcu - 192, F.G - 192); __syncthreads(); }
            else if (DEFER_CONV && F.G < 200) { __syncthreads(); conv_weights(A, F, l, last ? (J_FC1 | J_FC2) : J_FC1, F.vcu, F.G); __syncthreads(); }
        } } SEAM(pb + 3);
        for (int rep_ = 0; rep_ < NREP(6); ++rep_) { if (rep_) xcd_barrier(xb); if (PHM(6) && IN(pb + 4)) {
            { pg8::Gemm g{WSP(bf16, WS_HEADS), WSP(bf16, WS_WOUT) + (size_t)l * DM * DM, M, DM, DM, DM}; TileOrder S; S.init(DM, F.G, (int)blockIdx.x, 1);
              EpiResid E{F.ws, inp<I_X>(), inp<I_CTX>(), modl + 2 * DM, first};
              pg8::gemm_phase<EpiResid, TileOrder, true, true>(F.lds, g, S, E); }
            if (!last) {
              pg8::Gemm g{WSP(bf16, WS_HEADS), WSP(bf16, WS_WOUT) + (size_t)l * DM * DM, M, DM, DM / 8, DM}; TileOrder S; S.init(DM, F.G, (int)blockIdx.x, 3, 8, DM / 8);
              EpiSlab E{WSP(float, WS_SLAB), modl + 4 * MODW + 2 * DM};
              pg8::gemm_phase<EpiSlab, TileOrder, true, true>(F.lds, g, S, E); }
        } } SEAM(pb + 4);
        for (int rep_ = 0; rep_ < NREP(7); ++rep_) { if (rep_) xcd_barrier(xb); if (PHM(7) && IN(pb + 5)) { norm_phase(A, F, l, first ? 2 : 0, inp<I_GMLP>() + l * DM, 3 * DM, last ? nullptr : WSP(float, WS_SLAB), last); } } SEAM(pb + 5);
        for (int rep_ = 0; rep_ < NREP(8); ++rep_) { if (rep_) xcd_barrier(xb); if (PHM(8) && IN(pb + 6)) {
            pg8::Gemm g{WSP(bf16, WS_HN), WSP(bf16, WS_WFC1) + (size_t)l * FF * DM, M, FF, DM, DM}; TileOrder S; S.init(FF, F.G, (int)blockIdx.x, last ? 1 : 0);
            EpiFc1 E{F.ws};
            pg8::gemm_phase<EpiFc1, TileOrder, true, true>(F.lds, g, S, E);
            if (DEFER_CONV && !last) {
                const int nun = 36 * (FF / 256), rem = nun % F.G, nidle = rem ? F.G - rem : F.G, cid = rem ? (int)blockIdx.x - rem : (int)blockIdx.x;
                if (cid >= 0) { __syncthreads(); conv_weights(A, F, l, J_FC2, cid, nidle); conv_weights(A, F, l + 1, J_IN | J_UQ | J_UKV, cid, nidle); __syncthreads(); }
            }
        } } SEAM(pb + 6);
        for (int rep_ = 0; rep_ < NREP(9); ++rep_) { if (rep_) xcd_barrier(xb); if (PHM(9) && IN(pb + 7)) {
            { pg8::Gemm g{WSP(bf16, WS_ACT), WSP(bf16, WS_WFC2) + (size_t)l * DM * FF, M, DM, FF, FF}; TileOrder S; S.init(DM, F.G, (int)blockIdx.x, 1);
              EpiResid E{F.ws, inp<I_X>(), inp<I_CTX>(), modl + 5 * DM, false};
              pg8::gemm_phase<EpiResid, TileOrder, true, true>(F.lds, g, S, E); }
            if (!last) {
              pg8::Gemm g{WSP(bf16, WS_ACT), WSP(bf16, WS_WFC2) + (size_t)l * DM * FF, M, DM, FF / 8, FF}; TileOrder S; S.init(DM, F.G, (int)blockIdx.x, 3, 8, FF / 8);
              EpiSlab E{WSP(float, WS_SLAB), modl + 4 * MODW + 5 * DM};
              pg8::gemm_phase<EpiSlab, TileOrder, true, true>(F.lds, g, S, E); }
        } } SEAM(pb + 7);
    }
    for (int rep_ = 0; rep_ < NREP(10); ++rep_) { if (rep_) xcd_barrier(xb); if (PHM(10) && IN(PH_FINAL)) { final_norm_phase(A, F); } }
#undef IN
#undef SEAM
}

extern "C" void kernel_launch(void* const* d_in, const int* in_sizes, int n_in, void* d_out, int out_size, void* d_ws, size_t ws_size, hipStream_t stream) {
    static int grid = 0;
    if (grid == 0) {
        if (n_in != N_IN || ws_size < WS_END || out_size != NB * SEQ * DM) { fprintf(stderr, "kernel_launch: unexpected shapes: n_in %d ws %zu (need %zu) out %d\n", n_in, ws_size, (size_t)WS_END, out_size); grid = -1; return; }
        int dev = 0, cus = 0, per_cu = 0;
        if (hipGetDevice(&dev) != hipSuccess || hipDeviceGetAttribute(&cus, hipDeviceAttributeMultiprocessorCount, dev) != hipSuccess) { fprintf(stderr, "kernel_launch: device query failed\n"); grid = -1; return; }
        if (hipFuncSetAttribute((const void*)fwd_kernel, hipFuncAttributeMaxDynamicSharedMemorySize, LDS_BYTES) != hipSuccess) { fprintf(stderr, "kernel_launch: hipFuncSetAttribute failed\n"); grid = -1; return; }
        if (hipOccupancyMaxActiveBlocksPerMultiprocessor(&per_cu, (const void*)fwd_kernel, NTHR, LDS_BYTES) != hipSuccess || per_cu < 1) { fprintf(stderr, "kernel_launch: occupancy query says %d blocks/CU\n", per_cu); (void)hipGetLastError(); per_cu = 1; }
        grid = cus * per_cu; if (grid > 256) grid = 256;
        grid -= grid % 8;
        fprintf(stderr, "kernel_launch: cus %d per_cu %d grid %d\n", cus, per_cu, grid);
    }
    if (grid <= 0) return;
    Args a{};
    for (int i = 0; i < N_IN; ++i) a.in[i] = (const float*)d_in[i];
    a.out = (float*)d_out; a.ws = (unsigned char*)d_ws;
#if MK_SPLIT
    for (int p = 0; p < N_PHASES; ++p) {
        a.ph_lo = p; a.ph_hi = p + 1; void* kargs[] = {&a};
        hipError_t e = hipLaunchCooperativeKernel((const void*)fwd_kernel, dim3(grid), dim3(NTHR), kargs, LDS_BYTES, stream);
        if (e != hipSuccess) { fprintf(stderr, "kernel_launch: launch of phase %d failed: %s\n", p, hipGetErrorString(e)); break; }
    }
#else
    a.ph_lo = 0; a.ph_hi = N_PHASES; void* kargs[] = {&a};
    hipError_t e = hipLaunchCooperativeKernel((const void*)fwd_kernel, dim3(grid), dim3(NTHR), kargs, LDS_BYTES, stream);
    if (e != hipSuccess) fprintf(stderr, "kernel_launch: cooperative launch failed: %s (grid %d)\n", hipGetErrorString(e), grid);
#endif
}
```

```cpp
#include <hip/hip_runtime.h>
#include <hip/hip_cooperative_groups.h>
#include <cstdio>
#include <cstdint>
namespace cg = cooperative_groups;
namespace pg8 {
#define PG8_LAS __attribute__((address_space(3)))
typedef unsigned short bf16_t;
typedef short bf16x8 __attribute__((ext_vector_type(8)));
typedef float f32x4 __attribute__((ext_vector_type(4)));
typedef unsigned u32x4 __attribute__((ext_vector_type(4)));
constexpr int BM = 256, BK = 64, HALF = 128, HTB = HALF * BK * 2  , STAGE_BYTES = 8 * HTB, NXCD = 8, WGM = 8;

__host__ __device__ __forceinline__ int lds_byte(int r, int c) { const int st = (r >> 4) * 2 + (c >> 5), rr = r & 15, cc = c & 31, ob = rr * 64 + cc * 2; return st * 1024 + (ob ^ (((ob >> 9) & 1) << 5)); }
__host__ __device__ __forceinline__ void stage_rc(int b, int& R, int& C) { const int st = b / 1024, sb = b % 1024, swz = sb ^ (((sb >> 9) & 1) << 5); R = (st >> 1) * 16 + swz / 64; C = (st & 1) * 32 + (swz % 64) / 2; }
__host__ __device__ __forceinline__ int perm32(int rho) { const int n = rho >> 4, i = rho & 15; return 8 * (i >> 2) + 4 * n + (i & 3); }

struct Unit { int pm, pn, k0, ks; };
struct Gemm { const bf16_t* A; const bf16_t* Bt; int M, N, K, ld; };

__device__ __forceinline__ unsigned cvt_pk_bf16(float lo, float hi) { unsigned r; asm volatile("v_cvt_pk_bf16_f32 %0, %1, %2" : "=v"(r) : "v"(lo), "v"(hi)); return r; }
typedef float f32x2 __attribute__((ext_vector_type(2)));
__device__ __forceinline__ f32x2 gelu_pk(f32x2 v) {
    const f32x2 av = __builtin_elementwise_abs(v), d = av * 0.2316418882f + 1.0f;
    f32x2 t; t.x = __builtin_amdgcn_rcpf(d.x); t.y = __builtin_amdgcn_rcpf(d.y);
    f32x2 q = t * 0.5307027145f + (-0.7265760135f); q = q * t + 0.7107068705f; q = q * t + (-0.142248368f); q = q * t + 0.127414796f; q = q * t;
    const f32x2 s = (v * v) * (-0.72134752044f);
    f32x2 e; e.x = __builtin_amdgcn_exp2f(s.x); e.y = __builtin_amdgcn_exp2f(s.y);
    const f32x2 m = v * (q * e), r = v - m;
    f32x2 o; o.x = v.x < 0.f ? m.x : r.x; o.y = v.y < 0.f ? m.y : r.y; return o;
}
template <class Epi, class Sched, bool ALIGN_EPI = false, bool SP2 = false>
__device__ __forceinline__ void gemm_phase(PG8_LAS unsigned char* lds, const Gemm g, const Sched& S, const Epi& E) {
    int tid_ = threadIdx.x; asm volatile("" : "+v"(tid_)); const int tid = tid_, wid = __builtin_amdgcn_readfirstlane(tid >> 6), lane = tid & 63, wr = wid >> 2, wc = wid & 3, fr = lane & 15, fq = lane >> 4;
    const int K = g.K, nt = K / BK;
    unsigned voffA[2], voffB[2];
#pragma unroll
    for (int i = 0; i < 2; ++i) { int R, C; stage_rc(tid * 16 + i * 8192, R, C); const int Rb = Epi::PERM ? ((R & ~31) + perm32(R & 31)) : R;
        voffA[i] = (unsigned)(R * g.ld + C) * 2u; voffB[i] = (unsigned)(Rb * g.ld + C) * 2u; }
    const size_t kstep = (size_t)(BK * 2);
    const size_t hstep = (size_t)HALF * g.ld * 2;
    const size_t tstep = 2 * hstep;
    const unsigned ldsw = (unsigned)wid * 1024u;
    const int aoff = lds_byte(wr * 64 + fr, fq * 8), boff = lds_byte(wc * 32 + fr, fq * 8);
#define PG8_SA(b, h) (((b) * 2 + (h)) * HTB)
#define PG8_SB(b, h) ((4 + (b) * 2 + (h)) * HTB)
#define PG8_STAGE(bufoff, gbase, voff) do { _Pragma("unroll") for (int _i = 0; _i < 2; ++_i) \
        __builtin_amdgcn_global_load_lds((const unsigned*)((const char*)(gbase) + (voff)[_i]), (PG8_LAS unsigned*)(lds + (bufoff) + ldsw + _i * 8192), 16, 0, 0); } while (0)
#define PG8_LDA(dst, b, h) do { _Pragma("unroll") for (int m = 0; m < 4; ++m) _Pragma("unroll") for (int k = 0; k < 2; ++k) dst[m][k] = *(const PG8_LAS bf16x8*)(lds + PG8_SA(b, h) + aoff + m * 2048 + k * 1024); } while (0)
#define PG8_LDB(dst, b, h) do { _Pragma("unroll") for (int n = 0; n < 2; ++n) _Pragma("unroll") for (int k = 0; k < 2; ++k) dst[n][k] = *(const PG8_LAS bf16x8*)(lds + PG8_SB(b, h) + boff + n * 2048 + k * 1024); } while (0)
#define PG8_MMA(ai, bj, At, Bt) do { __builtin_amdgcn_s_setprio(1); _Pragma("unroll") for (int m = 0; m < 4; ++m) _Pragma("unroll") for (int n = 0; n < 2; ++n) _Pragma("unroll") for (int k = 0; k < 2; ++k) \
        acc[ai][bj][m][n] = __builtin_amdgcn_mfma_f32_16x16x32_bf16(Bt[n][k], At[m][k], acc[ai][bj][m][n], 0, 0, 0); __builtin_amdgcn_s_setprio(0); } while (0)
#define PG8_WAIT_V(n) asm volatile("s_waitcnt vmcnt(" #n ")" ::: "memory")
#define PG8_WAIT_L(n) asm volatile("s_waitcnt lgkmcnt(" #n ")" ::: "memory")
#define PG8_BAR __builtin_amdgcn_s_barrier()
#define PG8_SCHED __builtin_amdgcn_sched_barrier(0)
    Unit cur, nxt; int ui = 0;
    if (!S.next(0, cur)) return;
    f32x4 acc[2][2][4][2];
#pragma unroll
    for (int a = 0; a < 2; ++a)
#pragma unroll
        for (int b = 0; b < 2; ++b)
#pragma unroll
            for (int m = 0; m < 4; ++m)
#pragma unroll
                for (int n = 0; n < 2; ++n) acc[a][b][m][n] = (f32x4){0.f, 0.f, 0.f, 0.f};
    bf16x8 At[4][2], B0[2][2], B1[2][2];
    const char* cA = (const char*)g.A + (size_t)cur.pm * tstep + (size_t)cur.k0 * 2; const char* cB = (const char*)g.Bt + (size_t)cur.pn * tstep + (size_t)cur.k0 * 2;
    S.a_ready(cur);
    if constexpr (SP2) {
        PG8_STAGE(PG8_SB(0, 0), cB, voffB); PG8_STAGE(PG8_SB(0, 1), cB + hstep, voffB); PG8_STAGE(PG8_SA(0, 0), cA, voffA); PG8_STAGE(PG8_SA(0, 1), cA + hstep, voffA);
        if (wr == 1) PG8_BAR;
        PG8_WAIT_V(2); PG8_BAR;
        PG8_STAGE(PG8_SB(1, 0), cB + kstep, voffB); PG8_STAGE(PG8_SA(1, 0), cA + kstep, voffA); PG8_STAGE(PG8_SB(1, 1), cB + hstep + kstep, voffB);
        PG8_WAIT_V(6); PG8_BAR;
    } else {
        PG8_STAGE(PG8_SB(0, 0), cB, voffB); PG8_STAGE(PG8_SA(0, 0), cA, voffA); PG8_STAGE(PG8_SB(0, 1), cB + hstep, voffB); PG8_STAGE(PG8_SA(0, 1), cA + hstep, voffA);
        if (wr == 1) PG8_BAR;
        PG8_WAIT_V(4); PG8_BAR;
        PG8_STAGE(PG8_SB(1, 0), cB + kstep, voffB); PG8_STAGE(PG8_SA(1, 0), cA + kstep, voffA); PG8_STAGE(PG8_SB(1, 1), cB + hstep + kstep, voffB);
        PG8_WAIT_V(6); PG8_BAR;
    }
    for (;;) {
        const bool has_next = S.next(ui + 1, nxt);
        const char* nA = has_next ? (const char*)g.A + (size_t)nxt.pm * tstep + (size_t)nxt.k0 * 2 : cA; const char* nB = has_next ? (const char*)g.Bt + (size_t)nxt.pn * tstep + (size_t)nxt.k0 * 2 : cB;
        for (int t = 0; t < nt; t += 2) {
            const bool last = (t == nt - 2);
            const char* a1 = cA + (size_t)(t + 1) * kstep;
            const char* a2 = last ? nA : cA + (size_t)(t + 2) * kstep; const char* b2 = last ? nB : cB + (size_t)(t + 2) * kstep;
            const char* a3 = a2 + kstep; const char* b3 = b2 + kstep;
            if (last && has_next) S.a_ready(nxt);
            if constexpr (SP2) {
            PG8_LDB(B0, 0, 0); PG8_LDB(B1, 0, 1); PG8_SCHED; PG8_LDA(At, 0, 0); PG8_STAGE(PG8_SA(1, 1), a1 + hstep, voffA);
            PG8_WAIT_V(8); PG8_WAIT_L(0); PG8_BAR; PG8_MMA(0, 0, At, B0); PG8_MMA(0, 1, At, B1); PG8_BAR; PG8_SCHED;
            PG8_LDA(At, 0, 1); PG8_STAGE(PG8_SB(0, 0), b2, voffB); PG8_STAGE(PG8_SB(0, 1), b2 + hstep, voffB); PG8_STAGE(PG8_SA(0, 0), a2, voffA);
            PG8_WAIT_V(8); PG8_WAIT_L(0); PG8_BAR; PG8_MMA(1, 0, At, B0); PG8_MMA(1, 1, At, B1); PG8_BAR; PG8_SCHED;
            PG8_LDB(B0, 1, 0); PG8_LDB(B1, 1, 1); PG8_SCHED; PG8_LDA(At, 1, 0); PG8_STAGE(PG8_SA(0, 1), a2 + hstep, voffA);
            PG8_WAIT_V(8); PG8_WAIT_L(0); PG8_BAR; PG8_MMA(0, 0, At, B0); PG8_MMA(0, 1, At, B1); PG8_BAR; PG8_SCHED;
            PG8_LDA(At, 1, 1); PG8_STAGE(PG8_SB(1, 0), b3, voffB); PG8_STAGE(PG8_SB(1, 1), b3 + hstep, voffB); PG8_STAGE(PG8_SA(1, 0), a3, voffA);
            PG8_WAIT_V(8); PG8_WAIT_L(0); PG8_BAR; PG8_MMA(1, 0, At, B0); PG8_MMA(1, 1, At, B1); PG8_BAR; PG8_SCHED;
            } else {
            PG8_LDB(B0, 0, 0); PG8_SCHED; PG8_LDA(At, 0, 0); PG8_STAGE(PG8_SA(1, 1), a1 + hstep, voffA);
            PG8_WAIT_L(8); PG8_BAR; PG8_WAIT_L(0); PG8_MMA(0, 0, At, B0); PG8_BAR; PG8_SCHED;
            PG8_LDB(B1, 0, 1); PG8_STAGE(PG8_SB(0, 0), b2, voffB);
            PG8_BAR; PG8_WAIT_L(0); PG8_MMA(0, 1, At, B1); PG8_BAR;
            PG8_LDA(At, 0, 1); PG8_STAGE(PG8_SA(0, 0), a2, voffA);
            PG8_BAR; PG8_WAIT_L(0); PG8_MMA(1, 0, At, B0); PG8_BAR; PG8_SCHED;
            PG8_STAGE(PG8_SB(0, 1), b2 + hstep, voffB);
            PG8_WAIT_V(6); PG8_BAR; PG8_MMA(1, 1, At, B1); PG8_BAR;
            PG8_LDB(B0, 1, 0); PG8_SCHED; PG8_LDA(At, 1, 0); PG8_STAGE(PG8_SA(0, 1), a2 + hstep, voffA);
            PG8_WAIT_L(8); PG8_BAR; PG8_WAIT_L(0); PG8_MMA(0, 0, At, B0); PG8_BAR; PG8_SCHED;
            PG8_LDB(B1, 1, 1); PG8_STAGE(PG8_SB(1, 0), b3, voffB);
            PG8_BAR; PG8_WAIT_L(0); PG8_MMA(0, 1, At, B1); PG8_BAR;
            PG8_LDA(At, 1, 1); PG8_STAGE(PG8_SA(1, 0), a3, voffA);
            PG8_BAR; PG8_WAIT_L(0); PG8_MMA(1, 0, At, B0); PG8_BAR; PG8_SCHED;
            PG8_STAGE(PG8_SB(1, 1), b3 + hstep, voffB);
            PG8_WAIT_V(6); PG8_BAR; PG8_MMA(1, 1, At, B1); PG8_BAR;
            }
        }
        if constexpr (ALIGN_EPI) { if (wr == 0) PG8_BAR; }
        if constexpr (!Epi::AFTER_DRAIN) { E(acc, cur, wr, wc, fr, fq); S.done(cur); }
        if (!has_next) break;
#pragma unroll
        for (int a = 0; a < 2; ++a)
#pragma unroll
            for (int b = 0; b < 2; ++b)
#pragma unroll
                for (int m = 0; m < 4; ++m)
#pragma unroll
                    for (int n = 0; n < 2; ++n) acc[a][b][m][n] = (f32x4){0.f, 0.f, 0.f, 0.f};
        cur = nxt; cA = nA; cB = nB; ++ui;
        if constexpr (ALIGN_EPI) { if (wr == 1) PG8_BAR; }
    }
    PG8_WAIT_V(0);
    if constexpr (!ALIGN_EPI) { if (wr == 0) PG8_BAR; }
    PG8_BAR;
    if constexpr (Epi::AFTER_DRAIN) { E.fused(acc, cur, wr, wc, fr, fq, lds, wid, lane); S.done(cur); }
#undef PG8_SA
#undef PG8_SB
#undef PG8_STAGE
#undef PG8_LDA
#undef PG8_LDB
#undef PG8_MMA
#undef PG8_WAIT_V
#undef PG8_WAIT_L
#undef PG8_BAR
#undef PG8_SCHED
}
}

#define GAS __attribute__((address_space(1)))
#define LAS __attribute__((address_space(3)))
typedef unsigned short bf16;
typedef float f32x4 __attribute__((ext_vector_type(4)));
typedef float f32x2 __attribute__((ext_vector_type(2)));
typedef float f32x16 __attribute__((ext_vector_type(16)));
typedef short bf16x8 __attribute__((ext_vector_type(8)));
typedef short s16x4 __attribute__((ext_vector_type(4)));
typedef unsigned u32x4 __attribute__((ext_vector_type(4)));
typedef unsigned u32x2 __attribute__((ext_vector_type(2)));

constexpr int NB = 4, SEQ = 2048, CTX = 256, DM = 2048, DEPTH = 2, FF = 8192;
constexpr int TOK = CTX + SEQ;
constexpr int M = NB * TOK;
constexpr int NZ = 4416, NZP = 4608;
constexpr int NUQ = 1152, NUQP = 1280, NUKV = 1536, RANK = 512;
constexpr int MODW = 6 * DM;
constexpr float EPS = 1e-6f;
constexpr float LOG2E = 1.4426950408889634f;
constexpr float DA_QS = 0.125f * LOG2E;
constexpr float MLA_QS = 0.07216878364870322f * LOG2E;
constexpr int NWAVES = 8, NTHR = 512;

enum { I_X = 0, I_C, I_CTX, I_CCTX, I_WMOD, I_BMOD, I_GMIX, I_GMLP, I_WIN, I_LQ1, I_LK1, I_LQ2, I_LK2, I_GDASUB, I_GGMV, I_WSP, I_BSP,
       I_GMQ, I_WUQ, I_GMKV, I_WUKV, I_WOUT, I_WFC1, I_WFC2, I_GFINAL, N_IN };

constexpr size_t al256(size_t x) { return (x + 255) / 256 * 256; }
constexpr size_t WS_ROPE  = 0;
constexpr size_t WS_SCAL  = WS_ROPE + 8192;
constexpr size_t WS_BAR   = WS_SCAL + 256;
constexpr size_t WS_MOD   = WS_BAR + 16384;
constexpr size_t WS_MODP  = al256(WS_MOD + (size_t)DEPTH * 5 * MODW * 4);
constexpr size_t WS_WIN   = al256(WS_MODP + (size_t)DEPTH * 32 * 5 * MODW * 4);
constexpr size_t WS_WOUT  = al256(WS_WIN + (size_t)DEPTH * NZP * DM * 2);
constexpr size_t WS_WFC1  = al256(WS_WOUT + (size_t)DEPTH * DM * DM * 2);
constexpr size_t WS_WFC2  = al256(WS_WFC1 + (size_t)DEPTH * FF * DM * 2);
constexpr size_t WS_WUQ   = al256(WS_WFC2 + (size_t)DEPTH * DM * FF * 2);
constexpr size_t WS_WUKV  = al256(WS_WUQ + (size_t)DEPTH * NUQP * RANK * 2);
constexpr size_t WS_WSP   = al256(WS_WUKV + (size_t)DEPTH * NUKV * RANK * 2);
constexpr size_t WS_XW    = al256(WS_WSP + (size_t)DEPTH * 4 * 128 * 128 * 2);
constexpr size_t WS_HN    = al256(WS_XW + (size_t)M * DM * 4);
constexpr size_t WS_QDA   = al256(WS_HN + (size_t)M * DM * 2);
constexpr size_t WS_KDA   = al256(WS_QDA + (size_t)M * 768 * 2);
constexpr size_t WS_VDA   = al256(WS_KDA + (size_t)M * 768 * 2);
constexpr size_t WS_U     = al256(WS_VDA + (size_t)M * 768 * 2);
constexpr size_t WS_GV    = al256(WS_U + (size_t)M * 512 * 4);
constexpr size_t WS_GVSS  = al256(WS_GV + (size_t)M * 512 * 4);
constexpr size_t WS_CQSS  = al256(WS_GVSS + (size_t)M * 16 * 4);
constexpr size_t WS_CKVSS = al256(WS_CQSS + (size_t)M * 8 * 4);
constexpr size_t WS_CQ    = al256(WS_CKVSS + (size_t)M * 8 * 4);
constexpr size_t WS_CKV   = al256(WS_CQ + (size_t)M * 512 * 2);
constexpr size_t WS_KMLA  = al256(WS_CKV + (size_t)M * 512 * 2);
constexpr size_t WS_VMLA  = al256(WS_KMLA + (size_t)M * 1152 * 2);
constexpr size_t WS_QMLA  = al256(WS_VMLA + (size_t)M * 768 * 2);
constexpr size_t WS_HEADS = al256(WS_QMLA + (size_t)M * 1152 * 2);
constexpr size_t WS_ACT   = al256(WS_HEADS + (size_t)M * DM * 2);
constexpr size_t WS_STASH = al256(WS_ACT + (size_t)M * FF * 2);
constexpr size_t WS_SLAB  = al256(WS_STASH + (size_t)256 * 64 * 512 * 4);
constexpr size_t WS_END   = al256(WS_SLAB + (size_t)8 * 1024 * DM * 4);

constexpr int LDS_BYTES = 131072 + 1024;

__device__ __forceinline__ unsigned cvtpk(float lo, float hi) { unsigned r; asm volatile("v_cvt_pk_bf16_f32 %0, %1, %2" : "=v"(r) : "v"(lo), "v"(hi)); return r; }
__device__ __forceinline__ u32x4 pack8(f32x4 a, f32x4 b) { u32x4 w; w.x = cvtpk(a[0], a[1]); w.y = cvtpk(a[2], a[3]); w.z = cvtpk(b[0], b[1]); w.w = cvtpk(b[2], b[3]); return w; }
__device__ __forceinline__ float wave_sum(float v) {
#pragma unroll
    for (int o = 1; o < 64; o <<= 1) v += __shfl_xor(v, o);
    return v;
}
__device__ __forceinline__ float bf2f(unsigned short h) { return __uint_as_float(((unsigned)h) << 16); }

struct Args { const float* in[N_IN]; float* out; unsigned char* ws; int ph_lo, ph_hi; };
struct Frame {
    LAS unsigned char* lds;
    int G, vcu;
    float* out; unsigned char* ws;
};
#define WSP(T, off) ((T*)(F.ws + (off)))
template <int I> __device__ __forceinline__ const float* inp() {
    unsigned long long p; asm volatile("s_load_dwordx2 %0, %1, %2\n\ts_waitcnt lgkmcnt(0)" : "=s"(p) : "s"(__builtin_amdgcn_kernarg_segment_ptr()), "n"(I * 8) : "memory"); return (const float*)p; }

__device__ __forceinline__ const float* xrow_in(const Args& A, const Frame& F, int row) {
    const int b = row / TOK, rr = row - b * TOK;
    return rr < CTX ? inp<I_CTX>() + (size_t)(b * CTX + rr) * DM : inp<I_X>() + (size_t)(b * SEQ + rr - CTX) * DM;
}

__device__ __forceinline__ void p0_transpose_item(const float* W, int K, int N, bf16* WT, const float* kscale, LAS float* scr, int item, int lane) {
    const int nblk = N / 32, kb = item / nblk, nb = item % nblk, k0 = 64 * kb, n0 = 32 * nb;
    { const int r8 = lane >> 3, c4 = (lane & 7) * 4; f32x4 v[8];
#pragma unroll
      for (int i = 0; i < 8; ++i) v[i] = *(const f32x4*)(W + (size_t)(k0 + r8 + 8 * i) * N + n0 + c4);
#pragma unroll
      for (int i = 0; i < 8; ++i) { const int kk = r8 + 8 * i; const float s = kscale ? kscale[k0 + kk] : 1.f; LAS float* d = scr + kk * 33 + c4;
          d[0] = v[i][0] * s; d[1] = v[i][1] * s; d[2] = v[i][2] * s; d[3] = v[i][3] * s; } }
    asm volatile("s_waitcnt lgkmcnt(0)" ::: "memory");
    const int c = lane & 7;
#pragma unroll
    for (int j = 0; j < 4; ++j) { const int n = (lane >> 3) + 8 * j; const LAS float* s = scr + (8 * c) * 33 + n;
        u32x4 o; o.x = cvtpk(s[0 * 33], s[1 * 33]); o.y = cvtpk(s[2 * 33], s[3 * 33]); o.z = cvtpk(s[4 * 33], s[5 * 33]); o.w = cvtpk(s[6 * 33], s[7 * 33]);
        *(u32x4*)(WT + (size_t)(n0 + n) * K + k0 + 8 * c) = o; }
    asm volatile("s_waitcnt lgkmcnt(0)" ::: "memory");
}
__device__ __forceinline__ float silu_f(float x) { return x / (1.f + __expf(-x)); }

__device__ __forceinline__ void p0_mod_item(const Args& A, const Frame& F, LAS float* scr, int item, int lane) {
    const int l = item / (32 * 48), r = item % (32 * 48), kc = r / 48, nc = r % 48;
    const int k = kc * 64 + lane;
#pragma unroll
    for (int bb = 0; bb < 5; ++bb) { const float cv = bb < 4 ? inp<I_C>()[bb * DM + k] : inp<I_CCTX>()[k]; scr[bb * 64 + lane] = silu_f(cv); }
    asm volatile("s_waitcnt lgkmcnt(0)" ::: "memory");
    const float* W = inp<I_WMOD>() + ((size_t)l * DM + kc * 64) * MODW + nc * 256 + lane * 4;
    f32x4 acc[5];
#pragma unroll
    for (int bb = 0; bb < 5; ++bb) acc[bb] = (f32x4){0.f, 0.f, 0.f, 0.f};
#pragma unroll 8
    for (int kk = 0; kk < 64; ++kk) { const f32x4 w = *(const f32x4*)(W + (size_t)kk * MODW);
#pragma unroll
        for (int bb = 0; bb < 5; ++bb) acc[bb] += w * scr[bb * 64 + kk]; }
    float* P = WSP(float, WS_MODP) + ((size_t)(l * 32 + kc) * 5) * MODW + nc * 256 + lane * 4;
#pragma unroll
    for (int bb = 0; bb < 5; ++bb) *(f32x4*)(P + (size_t)bb * MODW) = acc[bb];
    asm volatile("s_waitcnt lgkmcnt(0)" ::: "memory");
}

enum { J_IN = 1, J_OUT = 2, J_FC1 = 4, J_FC2 = 8, J_UQ = 16, J_UKV = 32 };
__device__ __forceinline__ void conv_weights(const Args& A, const Frame& F, int l, int jobs, int wcu, int ncu, int shift = 0) {
    int tid_ = threadIdx.x; asm volatile("" : "+v"(tid_)); const int ptid = tid_, plane = ptid & 63, pwave = __builtin_amdgcn_readfirstlane(ptid >> 6);
    LAS float* scr = (LAS float*)(F.lds + pwave * 16384);
    const int NGW = ncu * NWAVES, gw = (wcu * NWAVES + pwave + NGW - (shift % NGW)) % NGW;
    constexpr int T_IN = (DM / 64) * (NZ / 32), T_OUT = (DM / 64) * (DM / 32), T_FC1 = (DM / 64) * (FF / 32), T_FC2 = (FF / 64) * (DM / 32), T_UQ = (RANK / 64) * (NUQ / 32), T_UKV = (RANK / 64) * (NUKV / 32);
    const int n_in = (jobs & J_IN) ? T_IN : 0, n_out = (jobs & J_OUT) ? T_OUT : 0, n_fc1 = (jobs & J_FC1) ? T_FC1 : 0, n_fc2 = (jobs & J_FC2) ? T_FC2 : 0, n_uq = (jobs & J_UQ) ? T_UQ : 0, n_ukv = (jobs & J_UKV) ? T_UKV : 0;
    const int total = n_in + n_out + n_fc1 + n_fc2 + n_uq + n_ukv;
    for (int it = gw; it < total; it += NGW) {
        int r = it;
        if (r < n_in)  { p0_transpose_item(inp<I_WIN>() + (size_t)l * DM * NZ, DM, NZ, WSP(bf16, WS_WIN) + (size_t)l * NZP * DM, nullptr, scr, r, plane); continue; } r -= n_in;
        if (r < n_out) { p0_transpose_item(inp<I_WOUT>() + (size_t)l * DM * DM, DM, DM, WSP(bf16, WS_WOUT) + (size_t)l * DM * DM, nullptr, scr, r, plane); continue; } r -= n_out;
        if (r < n_fc1) { p0_transpose_item(inp<I_WFC1>() + (size_t)l * DM * FF, DM, FF, WSP(bf16, WS_WFC1) + (size_t)l * FF * DM, nullptr, scr, r, plane); continue; } r -= n_fc1;
        if (r < n_fc2) { p0_transpose_item(inp<I_WFC2>() + (size_t)l * FF * DM, FF, DM, WSP(bf16, WS_WFC2) + (size_t)l * DM * FF, nullptr, scr, r, plane); continue; } r -= n_fc2;
        if (r < n_uq)  { p0_transpose_item(inp<I_WUQ>() + (size_t)l * RANK * NUQ, RANK, NUQ, WSP(bf16, WS_WUQ) + (size_t)l * NUQP * RANK, inp<I_GMQ>() + l * RANK, scr, r, plane); continue; } r -= n_uq;
        p0_transpose_item(inp<I_WUKV>() + (size_t)l * RANK * NUKV, RANK, NUKV, WSP(bf16, WS_WUKV) + (size_t)l * NUKV * RANK, inp<I_GMKV>() + l * RANK, scr, r, plane);
    }
}
#ifndef DEFER_CONV
#define DEFER_CONV 1
#endif
__device__ __forceinline__ void p0_prologue(const Args& A, const Frame& F) {
    int tid_ = threadIdx.x; asm volatile("" : "+v"(tid_)); const int ptid = tid_, plane = ptid & 63, pwave = __builtin_amdgcn_readfirstlane(ptid >> 6);
    LAS float* scr = (LAS float*)(F.lds + pwave * 16384);
    const int gw = F.vcu * NWAVES + pwave, NGW = F.G * NWAVES;
    constexpr int I_MOD = DEPTH * 32 * 48;
    for (int it = gw; it < I_MOD; it += NGW) p0_mod_item(A, F, scr, it, plane);
    if (DEFER_CONV) conv_weights(A, F, 0, J_IN | J_UQ | J_UKV, F.vcu, F.G, I_MOD);
    else for (int l = 0; l < DEPTH; ++l) conv_weights(A, F, l, J_IN | J_OUT | J_FC1 | J_FC2 | J_UQ | J_UKV, F.vcu, F.G, I_MOD);
    const int gt = F.vcu * NTHR + ptid, NGT = F.G * NTHR;
    for (int i = gt; i < DEPTH * (NZP - NZ) * DM / 8; i += NGT) { const int l = i / ((NZP - NZ) * DM / 8), r = i % ((NZP - NZ) * DM / 8);
        *(u32x4*)(WSP(bf16, WS_WIN) + ((size_t)l * NZP + NZ) * DM + (size_t)r * 8) = (u32x4){0u, 0u, 0u, 0u}; }
    for (int i = gt; i < DEPTH * (NUQP - NUQ) * RANK / 8; i += NGT) { const int l = i / ((NUQP - NUQ) * RANK / 8), r = i % ((NUQP - NUQ) * RANK / 8);
        *(u32x4*)(WSP(bf16, WS_WUQ) + ((size_t)l * NUQP + NUQ) * RANK + (size_t)r * 8) = (u32x4){0u, 0u, 0u, 0u}; }
    for (int i = gt; i < DEPTH * 4 * 128 * 128 / 8; i += NGT) { const f32x4 a = *(const f32x4*)(inp<I_WSP>() + (size_t)i * 8), b = *(const f32x4*)(inp<I_WSP>() + (size_t)i * 8 + 4);
        *(u32x4*)(WSP(bf16, WS_WSP) + (size_t)i * 8) = pack8(a, b); }
    if (gt < 64 * 16) { const int pos = gt >> 4, f = gt & 15; const float inv = powf(10000.0f, -(float)f / 16.0f); const float ang = (float)pos * inv;
        WSP(float, WS_ROPE)[gt] = cosf(ang); WSP(float, WS_ROPE)[1024 + gt] = sinf(ang); }
    if (gt < 64 * DEPTH) {
        const int l = gt >> 6; const float a = inp<I_LQ1>()[l * 64 + plane] * inp<I_LK1>()[l * 64 + plane], b = inp<I_LQ2>()[l * 64 + plane] * inp<I_LK2>()[l * 64 + plane];
        const float sa = wave_sum(a), sb = wave_sum(b); const float lam_init = 0.8f - 0.6f * expf(-0.3f * (float)l);
        if (plane == 0) WSP(float, WS_SCAL)[l] = expf(sa) - expf(sb) + lam_init;
    }
}
__device__ __forceinline__ void p0b_modreduce(const Args& A, const Frame& F) {
    int tid_ = threadIdx.x; asm volatile("" : "+v"(tid_)); const int ptid = tid_, plane = ptid & 63, pwave = __builtin_amdgcn_readfirstlane(ptid >> 6);
    const int gt = F.vcu * NTHR + ptid, NGT = F.G * NTHR;
    for (int i = gt; i < DEPTH * 5 * MODW; i += NGT) { const int l = i / (5 * MODW), r = i % (5 * MODW), n = r % MODW;
        float s = inp<I_BMOD>()[l * MODW + n]; const float* P = WSP(float, WS_MODP) + (size_t)l * 32 * 5 * MODW + r;
#pragma unroll 8
        for (int kc = 0; kc < 32; ++kc) s += P[(size_t)kc * 5 * MODW];
        WSP(float, WS_MOD)[i] = s; }
}

__device__ __forceinline__ void norm_phase(const Args& A, const Frame& F, int l, int src_mode, const float* g, int shoff, const float* slab, bool skip_ctx) {
    int tid_ = threadIdx.x; asm volatile("" : "+v"(tid_)); const int ptid = tid_, plane = ptid & 63, pwave = __builtin_amdgcn_readfirstlane(ptid >> 6);
    const int gw = F.vcu * NWAVES + pwave, NGW = F.G * NWAVES;
    for (int row = gw; row < M; row += NGW) {
        const int b = row / TOK, rr = row - b * TOK; const bool isctx = rr < CTX; const int bsel = isctx ? 4 : b;
        if (isctx && skip_ctx) continue;
        const bool from_in = src_mode == 1 || (src_mode == 2 && isctx);
        const float* xr = from_in ? xrow_in(A, F, row) : WSP(float, WS_XW) + (size_t)row * DM;
        const float* md = WSP(float, WS_MOD) + ((size_t)l * 5 + bsel) * MODW + shoff;
        f32x4 v[8]; float s = 0.f;
#pragma unroll
        for (int j = 0; j < 8; ++j) v[j] = *(const f32x4*)(xr + 4 * plane + 256 * j);
        if (isctx && slab) {
            const float* sp = slab + (size_t)(b * CTX + rr) * DM + 4 * plane;
            for (int ks = 0; ks < 8; ++ks) {
#pragma unroll
                for (int j = 0; j < 8; ++j) v[j] += *(const f32x4*)(sp + (size_t)ks * 1024 * DM + 256 * j); }
            float* xo = WSP(float, WS_XW) + (size_t)row * DM + 4 * plane;
#pragma unroll
            for (int j = 0; j < 8; ++j) *(f32x4*)(xo + 256 * j) = v[j];
        }
#pragma unroll
        for (int j = 0; j < 8; ++j) s += (v[j].x * v[j].x + v[j].y * v[j].y) + (v[j].z * v[j].z + v[j].w * v[j].w);
        const float rstd = 1.0f / sqrtf(wave_sum(s) * (1.f / DM) + EPS);
        bf16* o = WSP(bf16, WS_HN) + (size_t)row * DM;
#pragma unroll
        for (int j = 0; j < 8; ++j) { const int c = 4 * plane + 256 * j; const f32x4 gg = *(const f32x4*)(g + c), sh = *(const f32x4*)(md + c), sc = *(const f32x4*)(md + DM + c);
            const f32x4 y = (v[j] * rstd) * gg * (sc + 1.0f) + sh; u32x2 w; w.x = cvtpk(y.x, y.y); w.y = cvtpk(y.z, y.w); *(u32x2*)(o + c) = w; }
    }
}
__device__ __forceinline__ void final_norm_phase(const Args& A, const Frame& F) {
    int tid_ = threadIdx.x; asm volatile("" : "+v"(tid_)); const int ptid = tid_, plane = ptid & 63, pwave = __builtin_amdgcn_readfirstlane(ptid >> 6);
    const int gw = F.vcu * NWAVES + pwave, NGW = F.G * NWAVES; const float* g = inp<I_GFINAL>();
    for (int r = gw; r < NB * SEQ; r += NGW) {
        const int b = r / SEQ, t = r - b * SEQ; const float* xr = WSP(float, WS_XW) + (size_t)(b * TOK + CTX + t) * DM;
        f32x4 v[8]; float s = 0.f;
#pragma unroll
        for (int j = 0; j < 8; ++j) { v[j] = *(const f32x4*)(xr + 4 * plane + 256 * j); s += (v[j].x * v[j].x + v[j].y * v[j].y) + (v[j].z * v[j].z + v[j].w * v[j].w); }
        const float rstd = 1.0f / sqrtf(wave_sum(s) * (1.f / DM) + EPS);
        float* o = F.out + (size_t)r * DM;
#pragma unroll
        for (int j = 0; j < 8; ++j) { const int c = 4 * plane + 256 * j; const f32x4 gg = *(const f32x4*)(g + c); *(f32x4*)(o + c) = (v[j] * rstd) * gg; }
    }
}

struct TileOrder {
    int nM, nN, nwg, G, c, mode, nsplit, kslice;
    __device__ void init(int N, int G_, int c_, int mode_, int nsplit_ = 1, int kslice_ = 0) { mode = mode_; nsplit = nsplit_; kslice = kslice_; nM = mode_ == 0 ? 36 : (mode_ == 1 ? 32 : 4); nN = N / 256; nwg = nM * nN * nsplit_; G = G_; c = c_; }
    __device__ bool next(int i, pg8::Unit& u) const {
        const long L = (long)i * G + c; if (L >= nwg) return false;
        int wgid = (int)L; { const int q = nwg / 8, r = nwg % 8, xcd = wgid % 8, off = wgid / 8; wgid = (xcd < r ? xcd * (q + 1) : r * (q + 1) + (xcd - r) * q) + off; }
        if (mode == 3) {
            const int per = 4 * nN, ks = wgid / per, rem = wgid - ks * per; u.ks = ks; u.k0 = ks * kslice; u.pn = rem >> 2; u.pm = (rem & 3) * 9; return true; }
        const int nig = 8 * nN, gid = wgid / nig, fm = gid * 8, gsz = (nM - fm) < 8 ? (nM - fm) : 8;
        int pm = fm + ((wgid % nig) % gsz); u.pn = (wgid % nig) / gsz;
        if (mode == 1) pm = (pm >> 3) * 9 + 1 + (pm & 7); else if (mode == 2) pm = pm * 9;
        u.pm = pm; u.k0 = 0; u.ks = 0; return true;
    }
    __device__ __forceinline__ void a_ready(const pg8::Unit&) const {}
    __device__ __forceinline__ void done(const pg8::Unit&) const {}
};

__device__ __forceinline__ void rope8(f32x4& v0, f32x4& v1, const float* ropetab, int pos, int f0) {
    const f32x4 c = *(const f32x4*)(ropetab + pos * 16 + f0), s = *(const f32x4*)(ropetab + 1024 + pos * 16 + f0);
    const f32x4 a = v0, b = v1;
    v0[0] = a[0] * c[0] - a[1] * s[0]; v0[1] = a[0] * s[0] + a[1] * c[0]; v0[2] = a[2] * c[1] - a[3] * s[1]; v0[3] = a[2] * s[1] + a[3] * c[1];
    v1[0] = b[0] * c[2] - b[1] * s[2]; v1[1] = b[0] * s[2] + b[1] * c[2]; v1[2] = b[2] * c[3] - b[3] * s[3]; v1[3] = b[2] * s[3] + b[3] * c[3];
}
__device__ __forceinline__ f32x4 gelu4(f32x4 v) { const f32x2 a = pg8::gelu_pk((f32x2){v[0], v[1]}), b = pg8::gelu_pk((f32x2){v[2], v[3]}); return (f32x4){a.x, a.y, b.x, b.y}; }
__device__ __forceinline__ float ss8(f32x4 a, f32x4 b) { return (a[0] * a[0] + a[1] * a[1]) + (a[2] * a[2] + a[3] * a[3]) + (b[0] * b[0] + b[1] * b[1]) + (b[2] * b[2] + b[3] * b[3]); }

struct EpiZ {
    static constexpr bool PERM = true, AFTER_DRAIN = false;
    unsigned char* ws; const float* ropetab;
    __device__ __forceinline__ void operator()(const f32x4 (&acc)[2][2][4][2], const pg8::Unit& u, int wr, int wc, int fr_, int fq_) const {
        int fr = fr_, fq = fq_; asm volatile("" : "+v"(fr), "+v"(fq));
        const int pn = u.pn;
#pragma unroll
        for (int ai = 0; ai < 2; ++ai)
#pragma unroll
            for (int m = 0; m < 4; ++m) {
                const int row = u.pm * 256 + ai * 128 + wr * 64 + m * 16 + fr;
                const int b = row / TOK, rr = row - b * TOK; const bool lat = rr >= CTX; const int t = rr - CTX, prow = (t >> 6) & 31, pcol = t & 63;
                float ssq = 0.f;
#pragma unroll
                for (int bj = 0; bj < 2; ++bj) {
                    const int colt = bj * 128 + wc * 32 + 8 * fq;
                    f32x4 v0 = acc[ai][bj][m][0], v1 = acc[ai][bj][m][1];
                    if (pn < 6) {
                        if (lat) { const int j0 = (colt & 63) >> 1; rope8(v0, v1, ropetab, j0 < 16 ? prow : pcol, j0 & 15); }
                        if (pn < 3) { v0 *= DA_QS; v1 *= DA_QS; *(u32x4*)((bf16*)(ws + WS_QDA) + (size_t)row * 768 + pn * 256 + colt) = pack8(v0, v1); }
                        else *(u32x4*)((bf16*)(ws + WS_KDA) + (size_t)row * 768 + (pn - 3) * 256 + colt) = pack8(v0, v1);
                    } else if (pn < 9) {
                        *(u32x4*)((bf16*)(ws + WS_VDA) + (size_t)row * 768 + (pn - 6) * 256 + colt) = pack8(v0, v1);
                    } else if (pn < 11) {
                        float* o = (float*)(ws + WS_U) + (size_t)row * 512 + (pn - 9) * 256 + colt; *(f32x4*)o = gelu4(v0); *(f32x4*)(o + 4) = gelu4(v1);
                    } else if (pn < 13) {
                        v0 = gelu4(v0); v1 = gelu4(v1);
                        float* o = (float*)(ws + WS_GV) + (size_t)row * 512 + (pn - 11) * 256 + colt; *(f32x4*)o = v0; *(f32x4*)(o + 4) = v1;
                        float s = ss8(v0, v1); s += __shfl_xor(s, 16); s += __shfl_xor(s, 32);
                        if (fq == 0) ((float*)(ws + WS_GVSS))[(size_t)row * 16 + ((pn - 11) * 2 + bj) * 4 + wc] = s;
                    } else if (pn < 15) {
                        *(u32x4*)((bf16*)(ws + WS_CQ) + (size_t)row * 512 + (pn - 13) * 256 + colt) = pack8(v0, v1); ssq += ss8(v0, v1);
                    } else if (pn < 17) {
                        *(u32x4*)((bf16*)(ws + WS_CKV) + (size_t)row * 512 + (pn - 15) * 256 + colt) = pack8(v0, v1); ssq += ss8(v0, v1);
                    } else {
                        if (colt < 64) {
                            if (lat) { const int j0 = colt >> 1; rope8(v0, v1, ropetab, j0 < 16 ? prow : pcol, j0 & 15); }
                            const u32x4 w = pack8(v0, v1); bf16* o = (bf16*)(ws + WS_KMLA) + (size_t)row * 1152 + 128 + colt;
#pragma unroll
                            for (int h = 0; h < 6; ++h) *(u32x4*)(o + h * 192) = w;
                        }
                    }
                }
                if (pn >= 13 && pn < 17) {
                    ssq += __shfl_xor(ssq, 16); ssq += __shfl_xor(ssq, 32);
                    if (fq == 0) { if (pn < 15) ((float*)(ws + WS_CQSS))[(size_t)row * 8 + (pn - 13) * 4 + wc] = ssq; else ((float*)(ws + WS_CKVSS))[(size_t)row * 8 + (pn - 15) * 4 + wc] = ssq; }
                }
            }
    }
};
__device__ __forceinline__ float rstd8(const float* p, float inv_n) { const f32x4 a = *(const f32x4*)p, b = *(const f32x4*)(p + 4); return 1.0f / sqrtf(((a[0] + a[1]) + (a[2] + a[3]) + (b[0] + b[1]) + (b[2] + b[3])) * inv_n + EPS); }

struct EpiKV {
    static constexpr bool PERM = true, AFTER_DRAIN = false;
    unsigned char* ws;
    __device__ __forceinline__ void operator()(const f32x4 (&acc)[2][2][4][2], const pg8::Unit& u, int wr, int wc, int fr_, int fq_) const {
        int fr = fr_, fq = fq_; asm volatile("" : "+v"(fr), "+v"(fq));
#pragma unroll
        for (int ai = 0; ai < 2; ++ai)
#pragma unroll
            for (int m = 0; m < 4; ++m) {
                const int row = u.pm * 256 + ai * 128 + wr * 64 + m * 16 + fr;
                const float rs = rstd8((const float*)(ws + WS_CKVSS) + (size_t)row * 8, 1.f / RANK);
                const int c = wc * 32 + 8 * fq;
                *(u32x4*)((bf16*)(ws + WS_KMLA) + (size_t)row * 1152 + u.pn * 192 + c) = pack8(acc[ai][0][m][0] * rs, acc[ai][0][m][1] * rs);
                *(u32x4*)((bf16*)(ws + WS_VMLA) + (size_t)row * 768 + u.pn * 128 + c) = pack8(acc[ai][1][m][0] * rs, acc[ai][1][m][1] * rs);
            }
    }
};
struct EpiQ {
    static constexpr bool PERM = true, AFTER_DRAIN = false;
    unsigned char* ws; const float* ropetab;
    __device__ __forceinline__ void operator()(const f32x4 (&acc)[2][2][4][2], const pg8::Unit& u, int wr, int wc, int fr_, int fq_) const {
        int fr = fr_, fq = fq_; asm volatile("" : "+v"(fr), "+v"(fq));
#pragma unroll
        for (int ai = 0; ai < 2; ++ai)
#pragma unroll
            for (int m = 0; m < 4; ++m) {
                const int row = u.pm * 256 + ai * 128 + wr * 64 + m * 16 + fr;
                const int b = row / TOK, rr = row - b * TOK; const bool lat = rr >= CTX; const int t = rr - CTX, prow = (t >> 6) & 31, pcol = t & 63;
                const float rs = rstd8((const float*)(ws + WS_CQSS) + (size_t)row * 8, 1.f / RANK) * MLA_QS;
#pragma unroll
                for (int bj = 0; bj < 2; ++bj) {
                    const int col = u.pn * 256 + bj * 128 + wc * 32 + 8 * fq;
                    if (col < NUQ) {
                        f32x4 v0 = acc[ai][bj][m][0] * rs, v1 = acc[ai][bj][m][1] * rs;
                        const int hd = col / 192, i = col - hd * 192;
                        if (lat && i >= 128) { const int j0 = (i - 128) >> 1; rope8(v0, v1, ropetab, j0 < 16 ? prow : pcol, j0 & 15); }
                        *(u32x4*)((bf16*)(ws + WS_QMLA) + (size_t)row * 1152 + col) = pack8(v0, v1);
                    }
                }
            }
    }
};
struct EpiResid {
    static constexpr bool PERM = true, AFTER_DRAIN = false;
    unsigned char* ws; const float* xin; const float* cin; const float* gate; bool from_inputs;
    __device__ __forceinline__ void operator()(const f32x4 (&acc)[2][2][4][2], const pg8::Unit& u, int wr, int wc, int fr_, int fq_) const {
        int fr = fr_, fq = fq_; asm volatile("" : "+v"(fr), "+v"(fq));
        const int b = u.pm / 9; const bool isctx = (u.pm - b * 9) == 0; const int bsel = isctx ? 4 : b;
        const int c0 = u.pn * 256 + wc * 32 + 8 * fq;
        const float* gp = gate + (size_t)bsel * MODW + c0;
        const int row0 = u.pm * 256 + wr * 64 + fr, rr0 = row0 - b * TOK;
        const float* bp = (from_inputs ? (isctx ? cin + (size_t)(b * CTX + rr0) * DM : xin + (size_t)(b * SEQ + rr0 - CTX) * DM) : (const float*)(ws + WS_XW) + (size_t)row0 * DM) + c0;
        float* op = (float*)(ws + WS_XW) + (size_t)row0 * DM + c0;
        f32x4 g[2][2];
#pragma unroll
        for (int bj = 0; bj < 2; ++bj) { g[bj][0] = *(const f32x4*)(gp + bj * 128); g[bj][1] = *(const f32x4*)(gp + bj * 128 + 4); }
#pragma unroll
        for (int ai = 0; ai < 2; ++ai)
#pragma unroll
            for (int m = 0; m < 4; ++m) {
#pragma unroll
                for (int bj = 0; bj < 2; ++bj) {
                    const f32x4 b0 = *(const f32x4*)(bp + bj * 128), b1 = *(const f32x4*)(bp + bj * 128 + 4);
                    *(f32x4*)(op + bj * 128) = b0 + g[bj][0] * acc[ai][bj][m][0]; *(f32x4*)(op + bj * 128 + 4) = b1 + g[bj][1] * acc[ai][bj][m][1]; }
                const int adv = (m == 3 ? 80 : 16) * DM; bp += adv; op += adv; asm volatile("" : "+v"(bp), "+v"(op));
            }
    }
};
struct EpiSlab {
    static constexpr bool PERM = true, AFTER_DRAIN = false;
    float* slab; const float* gate;
    __device__ __forceinline__ void operator()(const f32x4 (&acc)[2][2][4][2], const pg8::Unit& u, int wr, int wc, int fr_, int fq_) const {
        int fr = fr_, fq = fq_; asm volatile("" : "+v"(fr), "+v"(fq));
        const int b = u.pm / 9; const int c0 = u.pn * 256 + wc * 32 + 8 * fq; const float* gp = gate + c0;
        float* op = slab + ((size_t)u.ks * 1024 + b * CTX + wr * 64 + fr) * DM + c0;
        f32x4 g[2][2];
#pragma unroll
        for (int bj = 0; bj < 2; ++bj) { g[bj][0] = *(const f32x4*)(gp + bj * 128); g[bj][1] = *(const f32x4*)(gp + bj * 128 + 4); }
#pragma unroll
        for (int ai = 0; ai < 2; ++ai)
#pragma unroll
            for (int m = 0; m < 4; ++m) {
#pragma unroll
                for (int bj = 0; bj < 2; ++bj) { *(f32x4*)(op + bj * 128) = g[bj][0] * acc[ai][bj][m][0]; *(f32x4*)(op + bj * 128 + 4) = g[bj][1] * acc[ai][bj][m][1]; }
                op += (m == 3 ? 80 : 16) * DM; asm volatile("" : "+v"(op));
            }
    }
};
struct EpiFc1 {
    static constexpr bool PERM = true, AFTER_DRAIN = false;
    unsigned char* ws;
    __device__ __forceinline__ void operator()(const f32x4 (&acc)[2][2][4][2], const pg8::Unit& u, int wr, int wc, int fr_, int fq_) const {
        int fr = fr_, fq = fq_; asm volatile("" : "+v"(fr), "+v"(fq));
#pragma unroll
        for (int ai = 0; ai < 2; ++ai)
#pragma unroll
            for (int m = 0; m < 4; ++m) {
                const int row = u.pm * 256 + ai * 128 + wr * 64 + m * 16 + fr;
#pragma unroll
                for (int bj = 0; bj < 2; ++bj) { const int c = u.pn * 256 + bj * 128 + wc * 32 + 8 * fq;
                    f32x4 v0 = __builtin_elementwise_max(acc[ai][bj][m][0], (f32x4){0.f, 0.f, 0.f, 0.f}), v1 = __builtin_elementwise_max(acc[ai][bj][m][1], (f32x4){0.f, 0.f, 0.f, 0.f});
                    *(u32x4*)((bf16*)(ws + WS_ACT) + (size_t)row * FF + c) = pack8(v0 * v0, v1 * v1); }
            }
    }
};
#define XB_TMO      128
#define XB_XCNT(j)  (256  + 64 * (j))
#define XB_XSUB(j)  (1280 + 64 * (j))
#define XB_XGEN(j)  (2304 + 64 * (j))
#define XB_TOP      3328
#define XB_TOPGEN   3392
#define XCD_BAR_WORDS 3456
#define XB_SPIN_CAP (1u << 18)

__device__ __forceinline__ unsigned xb_ld(unsigned* p)              { return __hip_atomic_load(p, __ATOMIC_RELAXED, __HIP_MEMORY_SCOPE_AGENT); }
__device__ __forceinline__ unsigned xb_add(unsigned* p, unsigned v) { return __hip_atomic_fetch_add(p, v, __ATOMIC_RELAXED, __HIP_MEMORY_SCOPE_AGENT); }
__device__ __forceinline__ unsigned xb_xcc_id() { return (unsigned)__builtin_amdgcn_s_getreg((3 << 11) | 20) & 0xFu; }
#define XB_SPIN(cond, bar) do { unsigned _sp = 0; while (cond) { __builtin_amdgcn_s_sleep(1); \
    if ((++_sp & 255u) == 0u) { if (xb_ld(&(bar)[XB_TMO])) break; if (_sp > XB_SPIN_CAP) { atomicAdd(&(bar)[XB_TMO], 1u); break; } } } } while (0)

struct XcdBarrier {
    unsigned* bar; unsigned x;
    volatile LAS unsigned* st;
};

__device__ __forceinline__ XcdBarrier xcd_barrier_post(unsigned* bar, volatile LAS unsigned* st) {
    XcdBarrier b; b.bar = bar; b.x = xb_xcc_id(); b.st = st;
    if (threadIdx.x == 0) (void)xb_add(&bar[XB_XCNT(b.x)], 1u);
    return b;
}
__device__ __forceinline__ void xcd_barrier_complete(unsigned* bar, unsigned x, unsigned& nloc, unsigned& nx) {
    const unsigned G = gridDim.x * gridDim.y * gridDim.z;
    unsigned sum, cnt, mine, sp = 0u;
    for (;;) {
        sum = 0u; cnt = 0u; mine = 0u;
#pragma unroll
        for (unsigned j = 0; j < 16; ++j) { const unsigned c = xb_ld(&bar[XB_XCNT(j)]); sum += c; cnt += (c > 0u) ? 1u : 0u; mine = (j == x) ? c : mine; }
        if (sum == G) break;
        __builtin_amdgcn_s_sleep(1);
        if ((++sp & 255u) == 0u) { if (xb_ld(&bar[XB_TMO])) break; if (sp > XB_SPIN_CAP) { atomicAdd(&bar[XB_TMO], 1u); break; } }
    }
    nloc = mine > 0u ? mine : 1u; nx = cnt > 0u ? cnt : 1u;
}

__device__ __forceinline__ void xcd_barrier(const XcdBarrier& b) {
    asm volatile("s_waitcnt vmcnt(0)" ::: "memory");
    __syncthreads();
    if (threadIdx.x == 0) {
        unsigned* bar = b.bar;
        __builtin_amdgcn_s_waitcnt(0);
        unsigned nloc = b.st[0], nx = b.st[1];
        if (nloc == 0u) { xcd_barrier_complete(bar, b.x, nloc, nx); b.st[0] = nloc; b.st[1] = nx; }
        const unsigned old = xb_add(&bar[XB_XSUB(b.x)], 1u);
        const unsigned gen = old / nloc;
        if (old + 1u == (gen + 1u) * nloc) {
            __builtin_amdgcn_fence(__ATOMIC_RELEASE, "agent");
            asm volatile("s_waitcnt vmcnt(0)" ::: "memory");
            const unsigned og = xb_add(&bar[XB_TOP], 1u);
            const unsigned tg = og / nx;
            if (og + 1u == (tg + 1u) * nx) xb_add(&bar[XB_TOPGEN], 1u);
            else XB_SPIN(xb_ld(&bar[XB_TOPGEN]) == tg, bar);
            __builtin_amdgcn_fence(__ATOMIC_ACQUIRE, "agent");
            xb_add(&bar[XB_XGEN(b.x)], 1u);
            asm volatile("s_waitcnt vmcnt(0)" ::: "memory");
        } else {
            XB_SPIN(xb_ld(&bar[XB_XGEN(b.x)]) == gen, bar);
            __builtin_amdgcn_fence(__ATOMIC_ACQUIRE, "agent");
            asm volatile("s_waitcnt vmcnt(0)" ::: "memory");
        }
    }
    __syncthreads();
}

namespace att {
#define SBAR() __builtin_amdgcn_sched_barrier(0)
constexpr int V_TILE = 64 * 128 * 2, K_OFF = 2 * V_TILE, K_TILE_MAX = 64 * 192 * 2, WS_OFF = K_OFF + 2 * K_TILE_MAX;
constexpr int QR_OFF = WS_OFF + 2048;
constexpr float THR = 6.0f;
__device__ __forceinline__ int crow(int r, int hi) { return (r & 3) + 8 * (r >> 2) + 4 * hi; }
__device__ __forceinline__ int v_st(int k, int c) { const int kk = (k & ~0xC) | ((k & 4) << 1) | ((k & 8) >> 1); return ((kk >> 3) * 4 + (c >> 5)) * 512 + ((kk & 7) * 32 + (c & 31)) * 2; }
__device__ __forceinline__ int v_rd_base(int lane) { return ((lane & 3) << 3) | (((lane >> 2) & 3) << 6) | (((lane >> 4) & 1) << 5) | (((lane >> 5) & 1) << 8); }
constexpr int v_rd_off(int d0, int ks, int half) { return d0 * 512 + ks * 4096 + half * 2048; }
template <int OFF> __device__ __forceinline__ s16x4 tr_read(int vb) { s16x4 r; asm volatile("ds_read_b64_tr_b16 %0, %1 offset:%2" : "=&v"(r) : "v"(vb), "i"(OFF) : "memory"); return r; }
template <int D0> __device__ __forceinline__ void pv_one(f32x16& od, int vb, bf16x8 pa0, bf16x8 pa1, bf16x8 pa2, bf16x8 pa3) {
    const s16x4 l0 = tr_read<v_rd_off(D0, 0, 0)>(vb), h0 = tr_read<v_rd_off(D0, 0, 1)>(vb), l1 = tr_read<v_rd_off(D0, 1, 0)>(vb), h1 = tr_read<v_rd_off(D0, 1, 1)>(vb);
    const s16x4 l2 = tr_read<v_rd_off(D0, 2, 0)>(vb), h2 = tr_read<v_rd_off(D0, 2, 1)>(vb), l3 = tr_read<v_rd_off(D0, 3, 0)>(vb), h3 = tr_read<v_rd_off(D0, 3, 1)>(vb);
    asm volatile("s_waitcnt lgkmcnt(0)" ::: "memory"); SBAR();
#define PK(L, H) (bf16x8){L[0], L[1], L[2], L[3], H[0], H[1], H[2], H[3]}
    od = __builtin_amdgcn_mfma_f32_32x32x16_bf16(pa0, PK(l0, h0), od, 0, 0, 0);
    od = __builtin_amdgcn_mfma_f32_32x32x16_bf16(pa1, PK(l1, h1), od, 0, 0, 0);
    od = __builtin_amdgcn_mfma_f32_32x32x16_bf16(pa2, PK(l2, h2), od, 0, 0, 0);
    od = __builtin_amdgcn_mfma_f32_32x32x16_bf16(pa3, PK(l3, h3), od, 0, 0, 0);
#undef PK
}

template <int KS> __device__ __forceinline__ void v_read8(int vb, s16x4 (&L)[4], s16x4 (&H)[4]) {
    L[0] = tr_read<v_rd_off(0, KS, 0)>(vb); H[0] = tr_read<v_rd_off(0, KS, 1)>(vb); L[1] = tr_read<v_rd_off(1, KS, 0)>(vb); H[1] = tr_read<v_rd_off(1, KS, 1)>(vb);
    L[2] = tr_read<v_rd_off(2, KS, 0)>(vb); H[2] = tr_read<v_rd_off(2, KS, 1)>(vb); L[3] = tr_read<v_rd_off(3, KS, 0)>(vb); H[3] = tr_read<v_rd_off(3, KS, 1)>(vb);
}
#define PKV(L, H) (bf16x8){L[0], L[1], L[2], L[3], H[0], H[1], H[2], H[3]}
__device__ __forceinline__ void pv_mma4(f32x16 (&o)[4], bf16x8 pa, const s16x4 (&L)[4], const s16x4 (&H)[4]) {
    o[0] = __builtin_amdgcn_mfma_f32_32x32x16_bf16(pa, PKV(L[0], H[0]), o[0], 0, 0, 0);
    o[1] = __builtin_amdgcn_mfma_f32_32x32x16_bf16(pa, PKV(L[1], H[1]), o[1], 0, 0, 0);
    o[2] = __builtin_amdgcn_mfma_f32_32x32x16_bf16(pa, PKV(L[2], H[2]), o[2], 0, 0, 0);
    o[3] = __builtin_amdgcn_mfma_f32_32x32x16_bf16(pa, PKV(L[3], H[3]), o[3], 0, 0, 0);
}
__device__ __forceinline__ void pv_all(f32x16 (&o)[4], int vb, bf16x8 pa0, bf16x8 pa1, bf16x8 pa2, bf16x8 pa3) {
    s16x4 LA[4], HA[4], LB[4], HB[4];
    v_read8<0>(vb, LA, HA); v_read8<1>(vb, LB, HB);
    asm volatile("s_waitcnt lgkmcnt(8)" ::: "memory"); SBAR(); pv_mma4(o, pa0, LA, HA); SBAR();
    v_read8<2>(vb, LA, HA);
    asm volatile("s_waitcnt lgkmcnt(8)" ::: "memory"); SBAR(); pv_mma4(o, pa1, LB, HB); SBAR();
    v_read8<3>(vb, LB, HB);
    asm volatile("s_waitcnt lgkmcnt(8)" ::: "memory"); SBAR(); pv_mma4(o, pa2, LA, HA); SBAR();
    asm volatile("s_waitcnt lgkmcnt(0)" ::: "memory"); SBAR(); pv_mma4(o, pa3, LB, HB);
}
#undef PKV
template <int DQK> __device__ __forceinline__ int k_off(int r, int c) { return r * (DQK * 2) + ((c ^ ((r >> 1) & 7)) << 4); }

template <int DQK>
__device__ __forceinline__ void attn_pass(f32x16 (&o)[4], const bf16* __restrict__ Qw, int ldq, const bf16* __restrict__ Kb, int ldk, const bf16* __restrict__ Vb, int ldv, int NT, LAS unsigned char* lds) {
    constexpr int KT = 64 * DQK * 2, NKC = DQK / 8, NKS = (64 * NKC) / NTHR, ND = DQK / 16;
    int tid_ = threadIdx.x; asm volatile("" : "+v"(tid_)); const int tid = tid_, wid = tid >> 6, lane = tid & 63, r32 = lane & 31, hi = lane >> 5;
    LAS unsigned char* V_lds = lds; LAS unsigned char* K_lds = lds + K_OFF;
    LAS float* wsf = (LAS float*)(lds + WS_OFF) + wid * 64;
    constexpr int NDR = ND < 8 ? ND : 8;
    bf16x8 qr[NDR];
#pragma unroll
    for (int d0 = 0; d0 < NDR; ++d0) qr[d0] = *(const bf16x8*)(Qw + (size_t)r32 * ldq + d0 * 16 + hi * 8);
    LAS unsigned char* qpark = lds + QR_OFF + wid * 4096 + lane * 16;
#pragma unroll
    for (int d0 = NDR; d0 < ND; ++d0) *(LAS bf16x8*)(qpark + (d0 - NDR) * 1024) = *(const bf16x8*)(Qw + (size_t)r32 * ldq + d0 * 16 + hi * 8);
    unsigned kgo[NKS]; int klo[NKS];
#pragma unroll
    for (int i = 0; i < NKS; ++i) { const int idx = tid + NTHR * i, r = idx / NKC, c = idx - r * NKC; kgo[i] = (unsigned)(r * ldk + c * 8) * 2u; klo[i] = k_off<DQK>(r, c); }
    const int sr = tid >> 4, sc = (tid & 15) * 8, vst0 = v_st(sr, sc), vst1 = v_st(32 + sr, sc);
    const unsigned vgo0 = (unsigned)(sr * ldv + sc) * 2u, vgo1 = (unsigned)((32 + sr) * ldv + sc) * 2u;
    const int vb0 = (int)(uintptr_t)V_lds + v_rd_base(lane);
    bf16x8 ksA[NKS], vsA0, vsA1, ksB[NKS], vsB0, vsB1;
#define SLOAD(S, k0) do { const char* kt_ = (const char*)(Kb + (size_t)(k0) * ldk); const char* vt_ = (const char*)(Vb + (size_t)(k0) * ldv); \
        _Pragma("unroll") for (int i_ = 0; i_ < NKS; ++i_) ks##S[i_] = *(const bf16x8*)(kt_ + kgo[i_]); \
        vs##S##0 = *(const bf16x8*)(vt_ + vgo0); vs##S##1 = *(const bf16x8*)(vt_ + vgo1); } while (0)
#define SWRITE(S, buf) do { _Pragma("unroll") for (int i_ = 0; i_ < NKS; ++i_) *(LAS bf16x8*)(K_lds + (buf) * KT + klo[i_]) = ks##S[i_]; \
        *(LAS bf16x8*)(V_lds + (buf) * V_TILE + vst0) = vs##S##0; *(LAS bf16x8*)(V_lds + (buf) * V_TILE + vst1) = vs##S##1; } while (0)
    float m_reg = -1e30f, l_reg = 0.f;
#pragma unroll
    for (int d = 0; d < 4; ++d) o[d] = f32x16{};
#define TILE(buf) do { \
        f32x16 p0 = f32x16{}, p1 = f32x16{}; \
        { const LAS unsigned char* Kt = K_lds + (buf) * KT; \
          _Pragma("unroll") for (int d0 = 0; d0 < ND; ++d0) { \
              const bf16x8 b0 = *(const LAS bf16x8*)(Kt + k_off<DQK>(r32, 2 * d0 + hi)), b1 = *(const LAS bf16x8*)(Kt + k_off<DQK>(32 + r32, 2 * d0 + hi)); \
              bf16x8 qf; if (d0 < NDR) qf = qr[d0 < NDR ? d0 : 0]; else qf = *(const LAS bf16x8*)(qpark + (d0 - NDR) * 1024); \
              p0 = __builtin_amdgcn_mfma_f32_32x32x16_bf16(b0, qf, p0, 0, 0, 0); \
              p1 = __builtin_amdgcn_mfma_f32_32x32x16_bf16(b1, qf, p1, 0, 0, 0); } } \
        float pmax = p0[0]; \
        _Pragma("unroll") for (int r = 1; r < 16; ++r) pmax = fmaxf(pmax, p0[r]); \
        _Pragma("unroll") for (int r = 0; r < 16; ++r) pmax = fmaxf(pmax, p1[r]); \
        { auto rr = __builtin_amdgcn_permlane32_swap(__float_as_uint(pmax), __float_as_uint(pmax), false, false); pmax = fmaxf(__uint_as_float(rr[0]), __uint_as_float(rr[1])); } \
        float alpha = 1.f; \
        if (!__all(pmax - m_reg <= THR)) { const float mn = fmaxf(m_reg, pmax); alpha = __builtin_amdgcn_exp2f(m_reg - mn); m_reg = mn; \
            if (hi == 0) wsf[r32] = alpha; asm volatile("s_waitcnt lgkmcnt(0)" ::: "memory"); \
            _Pragma("unroll") for (int r = 0; r < 16; ++r) { const float a = wsf[crow(r, hi)]; \
                _Pragma("unroll") for (int d = 0; d < 4; ++d) o[d][r] *= a; } \
            asm volatile("s_waitcnt lgkmcnt(0)" ::: "memory"); } \
        float ps = 0.f; \
        _Pragma("unroll") for (int r = 0; r < 16; ++r) { p0[r] = __builtin_amdgcn_exp2f(p0[r] - m_reg); p1[r] = __builtin_amdgcn_exp2f(p1[r] - m_reg); ps += p0[r] + p1[r]; } \
        { auto rr = __builtin_amdgcn_permlane32_swap(__float_as_uint(ps), __float_as_uint(ps), false, false); ps = __uint_as_float(rr[0]) + __uint_as_float(rr[1]); } \
        l_reg = l_reg * alpha + ps; \
        bf16x8 pa0, pa1, pa2, pa3; \
        PK4(p0, 0, pa0); PK4(p0, 8, pa1); PK4(p1, 0, pa2); PK4(p1, 8, pa3); \
        SBAR(); \
        { const int vb = vb0 + (buf) * V_TILE; \
          if constexpr (DQK == 64) pv_all(o, vb, pa0, pa1, pa2, pa3); else { pv_one<0>(o[0], vb, pa0, pa1, pa2, pa3); pv_one<1>(o[1], vb, pa0, pa1, pa2, pa3); pv_one<2>(o[2], vb, pa0, pa1, pa2, pa3); pv_one<3>(o[3], vb, pa0, pa1, pa2, pa3); } } \
    } while (0)
#define PK4(P, BASE, OUT) do { unsigned a0 = cvtpk(P[BASE + 0], P[BASE + 1]), a1 = cvtpk(P[BASE + 2], P[BASE + 3]); \
        unsigned b0 = cvtpk(P[BASE + 4], P[BASE + 5]), b1 = cvtpk(P[BASE + 6], P[BASE + 7]); \
        auto r0 = __builtin_amdgcn_permlane32_swap(a0, b0, false, false); auto r1 = __builtin_amdgcn_permlane32_swap(a1, b1, false, false); \
        u32x4 w = {r0[0], r1[0], r0[1], r1[1]}; OUT = __builtin_bit_cast(bf16x8, w); } while (0)
    if constexpr (DQK == 64) {
    SLOAD(A, 0); SLOAD(B, 64); SWRITE(A, 0); __syncthreads();
    for (int j = 0; j < NT; j += 2) {
        { const int t2 = (j + 2 < NT) ? j + 2 : NT - 2; SLOAD(A, t2 * 64); }
        TILE(0);
        SWRITE(B, 1);
        __syncthreads();
        { const int t3 = (j + 3 < NT) ? j + 3 : NT - 1; SLOAD(B, t3 * 64); }
        TILE(1);
        SWRITE(A, 0);
        __syncthreads();
    }
    } else {
    SLOAD(A, 0); SWRITE(A, 0); __syncthreads();
    for (int j = 0; j < NT; j += 2) {
        SLOAD(A, (j + 1) * 64);
        TILE(0);
        SWRITE(A, 1);
        __syncthreads();
        if (j + 2 < NT) SLOAD(A, (j + 2) * 64);
        TILE(1);
        if (j + 2 < NT) SWRITE(A, 0);
        __syncthreads();
    }
    }
#undef PK4
#undef TILE
    if (hi == 0) wsf[32 + r32] = l_reg; asm volatile("s_waitcnt lgkmcnt(0)" ::: "memory");
#pragma unroll
    for (int r = 0; r < 16; ++r) { const float rl = 1.0f / wsf[32 + crow(r, hi)];
#pragma unroll
        for (int d = 0; d < 4; ++d) o[d][r] *= rl; }
    asm volatile("s_waitcnt lgkmcnt(0)" ::: "memory");
#undef SLOAD
#undef SWRITE
}


__device__ __forceinline__ void store_o(const f32x16 (&o)[4], const float (&rs)[16], const float (&gcol)[4], bf16* dst, int ld, LAS unsigned char* lds, int wid, int lane) {
    const int r32 = lane & 31, hi = lane >> 5;
    LAS unsigned short* stg = (LAS unsigned short*)(lds + wid * 8192);
#pragma unroll
    for (int d = 0; d < 4; ++d)
#pragma unroll
        for (int r = 0; r < 16; ++r) stg[crow(r, hi) * 128 + d * 32 + r32] = (unsigned short)(cvtpk(o[d][r] * rs[r] * gcol[d], 0.f) & 0xffffu);
    asm volatile("s_waitcnt lgkmcnt(0)" ::: "memory");
    bf16* p = dst + (size_t)(lane >> 4) * ld + (lane & 15) * 8;
#pragma unroll
    for (int i = 0; i < 8; ++i) { const u32x4 v = *(const LAS u32x4*)(stg + (i * 4 + (lane >> 4)) * 128 + (lane & 15) * 8); *(u32x4*)p = v; p += 4 * (size_t)ld; asm volatile("" : "+v"(p)); }
}

__device__ __forceinline__ void da_unit(const Args& A, const Frame& F, int l, int q0, int k0, int NT, int h) {
    int tid_ = threadIdx.x; asm volatile("" : "+v"(tid_)); const int tid = tid_, wid = tid >> 6, lane = tid & 63, r32 = lane & 31, hi = lane >> 5;
    const bf16* Q = WSP(bf16, WS_QDA); const bf16* K = WSP(bf16, WS_KDA); const bf16* V = WSP(bf16, WS_VDA);
    float* stash = WSP(float, WS_STASH) + ((size_t)blockIdx.x * NTHR + tid) * 64;
    const float lam = WSP(float, WS_SCAL)[l]; const float lam_init = 0.8f - 0.6f * expf(-0.3f * (float)l);
    f32x16 o[4];
    attn_pass<64>(o, Q + (size_t)(q0 + wid * 32) * 768 + (2 * h) * 64, 768, K + (size_t)k0 * 768 + (2 * h) * 64, 768, V + (size_t)k0 * 768 + h * 128, 768, NT, F.lds);
#pragma unroll
    for (int d = 0; d < 4; ++d)
#pragma unroll
        for (int r = 0; r < 16; r += 4) *(f32x4*)(stash + d * 16 + r) = (f32x4){o[d][r], o[d][r + 1], o[d][r + 2], o[d][r + 3]};
    attn_pass<64>(o, Q + (size_t)(q0 + wid * 32) * 768 + (2 * h + 1) * 64, 768, K + (size_t)k0 * 768 + (2 * h + 1) * 64, 768, V + (size_t)k0 * 768 + h * 128, 768, NT, F.lds);
    float ss[16];
#pragma unroll
    for (int r = 0; r < 16; ++r) ss[r] = 0.f;
#pragma unroll
    for (int d = 0; d < 4; ++d) {
#pragma unroll
        for (int r = 0; r < 16; r += 4) { const f32x4 s4 = *(const f32x4*)(stash + d * 16 + r);
#pragma unroll
            for (int e = 0; e < 4; ++e) { const float v = s4[e] - lam * o[d][r + e]; o[d][r + e] = v; ss[r + e] += v * v; } }
        asm volatile("" ::: "memory"); SBAR(); }
#pragma unroll
    for (int r = 0; r < 16; ++r) { float s = ss[r]; s += __shfl_xor(s, 1); s += __shfl_xor(s, 2); s += __shfl_xor(s, 4); s += __shfl_xor(s, 8); s += __shfl_xor(s, 16);
        ss[r] = (1.0f / sqrtf(s * (1.f / 128.f) + EPS)) * (1.f - lam_init); }
    const float* gs = inp<I_GDASUB>() + l * 128;
    float gcol[4];
#pragma unroll
    for (int d = 0; d < 4; ++d) gcol[d] = gs[d * 32 + r32];
    store_o(o, ss, gcol, WSP(bf16, WS_HEADS) + (size_t)(q0 + wid * 32) * DM + h * 128, DM, F.lds, wid, lane);
    __syncthreads();
}
__device__ __forceinline__ void mla_unit(const Args& A, const Frame& F, int q0, int k0, int NT, int h) {
    int tid_ = threadIdx.x; asm volatile("" : "+v"(tid_)); const int tid = tid_, wid = tid >> 6, lane = tid & 63, r32 = lane & 31, hi = lane >> 5;
    f32x16 o[4];
    attn_pass<192>(o, WSP(bf16, WS_QMLA) + (size_t)(q0 + wid * 32) * 1152 + h * 192, 1152, WSP(bf16, WS_KMLA) + (size_t)k0 * 1152 + h * 192, 1152, WSP(bf16, WS_VMLA) + (size_t)k0 * 768 + h * 128, 768, NT, F.lds);
    float rs[16], gcol[4];
#pragma unroll
    for (int r = 0; r < 16; ++r) rs[r] = 1.f;
#pragma unroll
    for (int d = 0; d < 4; ++d) gcol[d] = 1.f;
    store_o(o, rs, gcol, WSP(bf16, WS_HEADS) + (size_t)(q0 + wid * 32) * DM + 1280 + h * 128, DM, F.lds, wid, lane);
    __syncthreads();
}
__device__ __forceinline__ void da_latent(const Args& A, const Frame& F, int l, int v) { const int bh = v >> 3, qb = v & 7, b = bh / 6, h = bh - b * 6; da_unit(A, F, l, b * TOK + CTX + qb * 256, b * TOK, 36, h); }
__device__ __forceinline__ void da_ctx(const Args& A, const Frame& F, int l, int v) { const int b = v / 6, h = v - b * 6; da_unit(A, F, l, b * TOK, b * TOK, 4, h); }
__device__ __forceinline__ void mla_latent(const Args& A, const Frame& F, int v) { const int bh = v >> 3, qb = v & 7, b = bh / 6, h = bh - b * 6; mla_unit(A, F, b * TOK + CTX + qb * 256, b * TOK, 36, h); }
__device__ __forceinline__ void mla_ctx(const Args& A, const Frame& F, int v) { const int b = v / 6, h = v - b * 6; mla_unit(A, F, b * TOK, b * TOK, 4, h); }
__device__ __forceinline__ void mla_phase(const Args& A, const Frame& F, bool with_ctx) {
    const int nun = with_ctx ? 216 : 192;
    for (int un = F.vcu; un < nun; un += F.G) {
        if (un < 192) { const int bh = un >> 3, qb = un & 7, b = bh / 6, h = bh - b * 6; mla_unit(A, F, b * TOK + CTX + qb * 256, b * TOK, 36, h); }
        else { const int v = un - 192, b = v / 6, h = v - b * 6; mla_unit(A, F, b * TOK, b * TOK, 4, h); }
    }
}

__device__ __forceinline__ void gate_unit(const Args& A, const Frame& F, int l, int ch, int g) {
    int tid_ = threadIdx.x; asm volatile("" : "+v"(tid_)); const int tid = tid_, wid = tid >> 6, lane = tid & 63, r32 = lane & 31, hi = lane >> 5;
    const int r0 = ch * 128;
    LAS unsigned char* img = F.lds;
    { const int sc = (tid & 15) * 8; const float* gain = inp<I_GGMV>() + (l * 4 + g) * 128 + sc; const f32x4 g0 = *(const f32x4*)gain, g1 = *(const f32x4*)(gain + 4);
#pragma unroll
      for (int i = 0; i < 4; ++i) { const int q = (tid >> 4) + 32 * i, row = r0 + q;
          const float* src = WSP(float, WS_GV) + (size_t)row * 512 + g * 128 + sc; const f32x4 a = *(const f32x4*)src, b = *(const f32x4*)(src + 4);
          const f32x4 sq = *(const f32x4*)(WSP(float, WS_GVSS) + (size_t)row * 16 + g * 4); const float rs = 1.0f / sqrtf(((sq[0] + sq[1]) + (sq[2] + sq[3])) * (1.f / 128.f) + EPS);
          *(LAS u32x4*)(img + (q >> 6) * V_TILE + v_st(q & 63, sc)) = pack8(a * rs * g0, b * rs * g1); } }
    __syncthreads();
    const int pb = wid & 3, chh = wid >> 2;
    const bf16* Wsg = WSP(bf16, WS_WSP) + ((size_t)(l * 4 + g) * 128 + pb * 32 + r32) * 128 + hi * 8;
    f32x16 acc0 = f32x16{}, acc1 = f32x16{};
    const int vb0 = (int)(uintptr_t)img + v_rd_base(lane);
#pragma unroll
    for (int t = 0; t < 2; ++t) {
        const bf16x8 a0 = *(const bf16x8*)(Wsg + t * 64), a1 = *(const bf16x8*)(Wsg + t * 64 + 16), a2 = *(const bf16x8*)(Wsg + t * 64 + 32), a3 = *(const bf16x8*)(Wsg + t * 64 + 48);
        const int vb = vb0 + t * V_TILE;
        if (chh == 0) { pv_one<0>(acc0, vb, a0, a1, a2, a3); pv_one<1>(acc1, vb, a0, a1, a2, a3); }
        else          { pv_one<2>(acc0, vb, a0, a1, a2, a3); pv_one<3>(acc1, vb, a0, a1, a2, a3); }
    }
    const float* bs = inp<I_BSP>() + (l * 4 + g) * 128 + pb * 32;
    LAS float* mix = (LAS float*)(F.lds + 2 * V_TILE);
#pragma unroll
    for (int r = 0; r < 16; ++r) { const int p = crow(r, hi); const float bias = bs[p]; LAS float* mp = mix + (pb * 32 + p) * 128 + chh * 64 + r32; mp[0] = acc0[r] + bias; mp[32] = acc1[r] + bias; }
    __syncthreads();
    { const int sc = (tid & 15) * 8; const float* up = WSP(float, WS_U) + (size_t)(r0 + (tid >> 4)) * 512 + g * 128 + sc; bf16* hp = WSP(bf16, WS_HEADS) + (size_t)(r0 + (tid >> 4)) * DM + 768 + g * 128 + sc;
#pragma unroll
      for (int i = 0; i < 4; ++i) { const LAS float* mp = mix + ((tid >> 4) + 32 * i) * 128 + sc; const f32x4 m0 = *(const LAS f32x4*)mp, m1 = *(const LAS f32x4*)(mp + 4);
          const f32x4 u0 = *(const f32x4*)up, u1 = *(const f32x4*)(up + 4); *(u32x4*)hp = pack8(u0 * m0, u1 * m1);
          up += 32 * 512; hp += 32 * (size_t)DM; asm volatile("" : "+v"(up), "+v"(hp)); } }
    __syncthreads();
}
#undef SBAR
}

#ifndef MK_SPLIT
#define MK_SPLIT 0
#endif
constexpr int PH_PER_LAYER = 8, PH_FINAL = 2 + PH_PER_LAYER * DEPTH, N_PHASES = PH_FINAL + 1;

__global__ void __launch_bounds__(NTHR, 2) fwd_kernel(Args args) {
    extern __shared__ __attribute__((aligned(16))) unsigned char lds_raw[];
    cg::grid_group grid = cg::this_grid();
    Frame F;
    F.lds = (LAS unsigned char*)lds_raw;
    F.G = gridDim.x; { const int bx = blockIdx.x; F.vcu = (F.G % 8 == 0) ? (bx % 8) * (F.G / 8) + bx / 8 : bx; }
    const Args& A = args;
    F.out = args.out; F.ws = args.ws;
    const int lo = args.ph_lo, hi = args.ph_hi;
#ifndef PH_MASK
#define PH_MASK 0x7ff
#endif
#define PHM(j) (((PH_MASK) >> (j)) & 1)
#ifndef RPT_MASK
#define RPT_MASK 0
#endif
#define NREP(j) ((((RPT_MASK) >> (j)) & 1) ? 2 : 1)
#define IN(k) (lo <= (k) && (k) < hi)
#define SEAM(k) do { if (IN(k) && IN((k) + 1)) xcd_barrier(xb); } while (0)
    const float* ropetab = WSP(float, WS_ROPE);
    volatile LAS unsigned* MISC = (volatile LAS unsigned*)(F.lds + 131072);
    if (threadIdx.x < 64) MISC[threadIdx.x] = 0u;
    unsigned* barw = (unsigned*)(F.ws + WS_BAR);
    if (blockIdx.x == 0) for (int i = threadIdx.x; i < XCD_BAR_WORDS; i += NTHR) barw[i] = 0u;
    __syncthreads();
    XcdBarrier xb; xb.bar = barw; xb.x = 0; xb.st = MISC + 8;

    for (int rep_ = 0; rep_ < NREP(0); ++rep_) { if (rep_) xcd_barrier(xb); if (PHM(0) && IN(0)) { p0_prologue(A, F); } }
    if (IN(0) && IN(1)) { grid.sync(); }
    xb = xcd_barrier_post(barw, MISC + 8);
    for (int rep_ = 0; rep_ < NREP(1); ++rep_) { if (rep_) xcd_barrier(xb); if (PHM(1) && IN(1)) { p0b_modreduce(A, F); } } SEAM(1);

    for (int l = 0; l < DEPTH; ++l) {
        const int pb = 2 + PH_PER_LAYER * l; const bool last = (l == DEPTH - 1); const bool first = (l == 0);
        const float* modl = WSP(float, WS_MOD) + (size_t)l * 5 * MODW;
        for (int rep_ = 0; rep_ < NREP(2); ++rep_) { if (rep_) xcd_barrier(xb); if (PHM(2) && IN(pb + 0)) { norm_phase(A, F, l, first ? 1 : 0, inp<I_GMIX>() + l * DM, 0, first ? nullptr : WSP(float, WS_SLAB), false); } } SEAM(pb + 0);
        for (int rep_ = 0; rep_ < NREP(3); ++rep_) { if (rep_) xcd_barrier(xb); if (PHM(3) && IN(pb + 1)) {
            pg8::Gemm g{WSP(bf16, WS_HN), WSP(bf16, WS_WIN) + (size_t)l * NZP * DM, M, NZP, DM, DM}; TileOrder S; S.init(NZP, F.G, (int)blockIdx.x, 0);
            EpiZ E{F.ws, ropetab};
            pg8::gemm_phase<EpiZ, TileOrder, true, true>(F.lds, g, S, E);
        } } SEAM(pb + 1);
        for (int rep_ = 0; rep_ < NREP(4); ++rep_) { if (rep_) xcd_barrier(xb); if (PHM(4) && IN(pb + 2)) {
            const bool split = F.G == 256; const int xg = F.vcu >> 5, xl = F.vcu & 31; const bool isaux = !split || xl >= 24;
            const int naux = split ? 64 : F.G, caux = split ? xg * 8 + (xl - 24) : F.vcu, catt = xg * 24 + xl;
            if (!isaux) { att::da_latent(A, F, l, catt); }
            else {
                { pg8::Gemm g{WSP(bf16, WS_CKV), WSP(bf16, WS_WUKV) + (size_t)l * NUKV * RANK, M, NUKV, RANK, RANK}; TileOrder S; S.init(NUKV, naux, split ? (xl - 24) * 8 + xg : caux, 0);
                  EpiKV E{F.ws}; pg8::gemm_phase<EpiKV, TileOrder, true, true>(F.lds, g, S, E); }
                { pg8::Gemm g{WSP(bf16, WS_CQ), WSP(bf16, WS_WUQ) + (size_t)l * NUQP * RANK, M, NUQP, RANK, RANK}; TileOrder S; S.init(NUQP, naux, split ? (xl - 24) * 8 + xg : caux, last ? 1 : 0);
                  EpiQ E{F.ws, ropetab}; pg8::gemm_phase<EpiQ, TileOrder, true, true>(F.lds, g, S, E); }
                for (int un = caux; un < 72 * 4; un += naux) { const int ch = un >> 2, g = un & 3; if (last && (ch % 18) < 2) continue; att::gate_unit(A, F, l, ch, g); }
                if (!last) for (int un = caux; un < 24; un += naux) att::da_ctx(A, F, l, un);
                if (!split) for (int un = caux; un < 192; un += naux) att::da_latent(A, F, l, un);
                if (DEFER_CONV) { __syncthreads(); conv_weights(A, F, l, J_OUT, caux, naux); __syncthreads(); }
            }
        } } SEAM(pb + 2);
        for (int rep_ = 0; rep_ < NREP(5); ++rep_) { if (rep_) xcd_barrier(xb); if (PHM(5) && IN(pb + 3)) {
            const bool split = F.G == 256; const int xg = F.vcu >> 5, xl = F.vcu & 31; const bool isaux = !split || xl >= 24;
            const int naux = split ? 64 : F.G, caux = split ? xg * 8 + (xl - 24) : F.vcu, catt = xg * 24 + xl;
            if (split) { if (!isaux) att::mla_latent(A, F, catt); else if (!last && caux < 24) att::mla_ctx(A, F, caux); }
            else att::mla_phase(A, F, !last);
            if (DEFER_CONV && isaux) { __syncthreads(); conv_weights(A, F, l, last ? (J_FC1 | J_FC2) : J_FC1, caux, naux); __syncthreads(); }
        } } SEAM(pb + 3);
        for (int rep_ = 0; rep_ < NREP(6); ++rep_) { if (rep_) xcd_barrier(xb); if (PHM(6) && IN(pb + 4)) {
            { pg8::Gemm g{WSP(bf16, WS_HEADS), WSP(bf16, WS_WOUT) + (size_t)l * DM * DM, M, DM, DM, DM}; TileOrder S; S.init(DM, F.G, (int)blockIdx.x, 1);
              EpiResid E{F.ws, inp<I_X>(), inp<I_CTX>(), modl + 2 * DM, first};
              pg8::gemm_phase<EpiResid, TileOrder, true, true>(F.lds, g, S, E); }
            if (!last) {
              pg8::Gemm g{WSP(bf16, WS_HEADS), WSP(bf16, WS_WOUT) + (size_t)l * DM * DM, M, DM, DM / 8, DM}; TileOrder S; S.init(DM, F.G, (int)blockIdx.x, 3, 8, DM / 8);
              EpiSlab E{WSP(float, WS_SLAB), modl + 4 * MODW + 2 * DM};
              pg8::gemm_phase<EpiSlab, TileOrder, true, true>(F.lds, g, S, E); }
        } } SEAM(pb + 4);
        for (int rep_ = 0; rep_ < NREP(7); ++rep_) { if (rep_) xcd_barrier(xb); if (PHM(7) && IN(pb + 5)) { norm_phase(A, F, l, first ? 2 : 0, inp<I_GMLP>() + l * DM, 3 * DM, last ? nullptr : WSP(float, WS_SLAB), last); } } SEAM(pb + 5);
        for (int rep_ = 0; rep_ < NREP(8); ++rep_) { if (rep_) xcd_barrier(xb); if (PHM(8) && IN(pb + 6)) {
            pg8::Gemm g{WSP(bf16, WS_HN), WSP(bf16, WS_WFC1) + (size_t)l * FF * DM, M, FF, DM, DM}; TileOrder S; S.init(FF, F.G, (int)blockIdx.x, last ? 1 : 0);
            EpiFc1 E{F.ws};
            pg8::gemm_phase<EpiFc1, TileOrder, true, true>(F.lds, g, S, E);
            if (DEFER_CONV && !last) {
                const int nun = 36 * (FF / 256), rem = nun % F.G, nidle = rem ? F.G - rem : F.G, cid = rem ? (int)blockIdx.x - rem : (int)blockIdx.x;
                if (cid >= 0) { __syncthreads(); conv_weights(A, F, l, J_FC2, cid, nidle); conv_weights(A, F, l + 1, J_IN | J_UQ | J_UKV, cid, nidle); __syncthreads(); }
            }
        } } SEAM(pb + 6);
        for (int rep_ = 0; rep_ < NREP(9); ++rep_) { if (rep_) xcd_barrier(xb); if (PHM(9) && IN(pb + 7)) {
            { pg8::Gemm g{WSP(bf16, WS_ACT), WSP(bf16, WS_WFC2) + (size_t)l * DM * FF, M, DM, FF, FF}; TileOrder S; S.init(DM, F.G, (int)blockIdx.x, 1);
              EpiResid E{F.ws, inp<I_X>(), inp<I_CTX>(), modl + 5 * DM, false};
              pg8::gemm_phase<EpiResid, TileOrder, true, true>(F.lds, g, S, E); }
            if (!last) {
              pg8::Gemm g{WSP(bf16, WS_ACT), WSP(bf16, WS_WFC2) + (size_t)l * DM * FF, M, DM, FF / 8, FF}; TileOrder S; S.init(DM, F.G, (int)blockIdx.x, 3, 8, FF / 8);
              EpiSlab E{WSP(float, WS_SLAB), modl + 4 * MODW + 5 * DM};
              pg8::gemm_phase<EpiSlab, TileOrder, true, true>(F.lds, g, S, E); }
        } } SEAM(pb + 7);
    }
    for (int rep_ = 0; rep_ < NREP(10); ++rep_) { if (rep_) xcd_barrier(xb); if (PHM(10) && IN(PH_FINAL)) { final_norm_phase(A, F); } }
#undef IN
#undef SEAM
}

extern "C" void kernel_launch(void* const* d_in, const int* in_sizes, int n_in, void* d_out, int out_size, void* d_ws, size_t ws_size, hipStream_t stream) {
    static int grid = 0;
    if (grid == 0) {
        if (n_in != N_IN || ws_size < WS_END || out_size != NB * SEQ * DM) { fprintf(stderr, "kernel_launch: unexpected shapes: n_in %d ws %zu (need %zu) out %d\n", n_in, ws_size, (size_t)WS_END, out_size); grid = -1; return; }
        int dev = 0, cus = 0, per_cu = 0;
        if (hipGetDevice(&dev) != hipSuccess || hipDeviceGetAttribute(&cus, hipDeviceAttributeMultiprocessorCount, dev) != hipSuccess) { fprintf(stderr, "kernel_launch: device query failed\n"); grid = -1; return; }
        if (hipFuncSetAttribute((const void*)fwd_kernel, hipFuncAttributeMaxDynamicSharedMemorySize, LDS_BYTES) != hipSuccess) { fprintf(stderr, "kernel_launch: hipFuncSetAttribute failed\n"); grid = -1; return; }
        if (hipOccupancyMaxActiveBlocksPerMultiprocessor(&per_cu, (const void*)fwd_kernel, NTHR, LDS_BYTES) != hipSuccess || per_cu < 1) { fprintf(stderr, "kernel_launch: occupancy query says %d blocks/CU\n", per_cu); (void)hipGetLastError(); per_cu = 1; }
        grid = cus * per_cu; if (grid > 256) grid = 256;
        grid -= grid % 8;
        fprintf(stderr, "kernel_launch: cus %d per_cu %d grid %d\n", cus, per_cu, grid);
    }
    if (grid <= 0) return;
    Args a{};
    for (int i = 0; i < N_IN; ++i) a.in[i] = (const float*)d_in[i];
    a.out = (float*)d_out; a.ws = (unsigned char*)d_ws;
#if MK_SPLIT
    for (int p = 0; p < N_PHASES; ++p) {
        a.ph_lo = p; a.ph_hi = p + 1; void* kargs[] = {&a};
        hipError_t e = hipLaunchCooperativeKernel((const void*)fwd_kernel, dim3(grid), dim3(NTHR), kargs, LDS_BYTES, stream);
        if (e != hipSuccess) { fprintf(stderr, "kernel_launch: launch of phase %d failed: %s\n", p, hipGetErrorString(e)); break; }
    }
#else
    a.ph_lo = 0; a.ph_hi = N_PHASES; void* kargs[] = {&a};
    hipError_t e = hipLaunchCooperativeKernel((const void*)fwd_kernel, dim3(grid), dim3(NTHR), kargs, LDS_BYTES, stream);
    if (e != hipSuccess) fprintf(stderr, "kernel_launch: cooperative launch failed: %s (grid %d)\n", hipGetErrorString(e), grid);
#endif
}
```

```cpp
#include <hip/hip_runtime.h>
#include <hip/hip_cooperative_groups.h>
#include <cstdio>
#include <cstdint>
namespace cg = cooperative_groups;
namespace pg8 {
#define PG8_LAS __attribute__((address_space(3)))
typedef unsigned short bf16_t;
typedef short bf16x8 __attribute__((ext_vector_type(8)));
typedef float f32x4 __attribute__((ext_vector_type(4)));
typedef unsigned u32x4 __attribute__((ext_vector_type(4)));
constexpr int BM = 256, BK = 64, HALF = 128, HTB = HALF * BK * 2  , STAGE_BYTES = 8 * HTB, NXCD = 8, WGM = 8;

__host__ __device__ __forceinline__ int lds_byte(int r, int c) { const int st = (r >> 4) * 2 + (c >> 5), rr = r & 15, cc = c & 31, ob = rr * 64 + cc * 2; return st * 1024 + (ob ^ (((ob >> 9) & 1) << 5)); }
__host__ __device__ __forceinline__ void stage_rc(int b, int& R, int& C) { const int st = b / 1024, sb = b % 1024, swz = sb ^ (((sb >> 9) & 1) << 5); R = (st >> 1) * 16 + swz / 64; C = (st & 1) * 32 + (swz % 64) / 2; }
__host__ __device__ __forceinline__ int perm32(int rho) { const int n = rho >> 4, i = rho & 15; return 8 * (i >> 2) + 4 * n + (i & 3); }

struct Unit { int pm, pn, k0, ks; };
struct Gemm { const bf16_t* A; const bf16_t* Bt; int M, N, K, ld; };

__device__ __forceinline__ unsigned cvt_pk_bf16(float lo, float hi) { unsigned r; asm volatile("v_cvt_pk_bf16_f32 %0, %1, %2" : "=v"(r) : "v"(lo), "v"(hi)); return r; }
typedef float f32x2 __attribute__((ext_vector_type(2)));
__device__ __forceinline__ f32x2 gelu_pk(f32x2 v) {
    const f32x2 av = __builtin_elementwise_abs(v), d = av * 0.2316418882f + 1.0f;
    f32x2 t; t.x = __builtin_amdgcn_rcpf(d.x); t.y = __builtin_amdgcn_rcpf(d.y);
    f32x2 q = t * 0.5307027145f + (-0.7265760135f); q = q * t + 0.7107068705f; q = q * t + (-0.142248368f); q = q * t + 0.127414796f; q = q * t;
    const f32x2 s = (v * v) * (-0.72134752044f);
    f32x2 e; e.x = __builtin_amdgcn_exp2f(s.x); e.y = __builtin_amdgcn_exp2f(s.y);
    const f32x2 m = v * (q * e), r = v - m;
    f32x2 o; o.x = v.x < 0.f ? m.x : r.x; o.y = v.y < 0.f ? m.y : r.y; return o;
}
template <class Epi, class Sched, bool ALIGN_EPI = false, bool SP2 = false>
__device__ __forceinline__ void gemm_phase(PG8_LAS unsigned char* lds, const Gemm g, const Sched& S, const Epi& E) {
    int tid_ = threadIdx.x; asm volatile("" : "+v"(tid_)); const int tid = tid_, wid = __builtin_amdgcn_readfirstlane(tid >> 6), lane = tid & 63, wr = wid >> 2, wc = wid & 3, fr = lane & 15, fq = lane >> 4;
    const int K = g.K, nt = K / BK;
    unsigned voffA[2], voffB[2];
#pragma unroll
    for (int i = 0; i < 2; ++i) { int R, C; stage_rc(tid * 16 + i * 8192, R, C); const int Rb = Epi::PERM ? ((R & ~31) + perm32(R & 31)) : R;
        voffA[i] = (unsigned)(R * g.ld + C) * 2u; voffB[i] = (unsigned)(Rb * g.ld + C) * 2u; }
    const size_t kstep = (size_t)(BK * 2);
    const size_t hstep = (size_t)HALF * g.ld * 2;
    const size_t tstep = 2 * hstep;
    const unsigned ldsw = (unsigned)wid * 1024u;
    const int aoff = lds_byte(wr * 64 + fr, fq * 8), boff = lds_byte(wc * 32 + fr, fq * 8);
#define PG8_SA(b, h) (((b) * 2 + (h)) * HTB)
#define PG8_SB(b, h) ((4 + (b) * 2 + (h)) * HTB)
#define PG8_STAGE(bufoff, gbase, voff) do { _Pragma("unroll") for (int _i = 0; _i < 2; ++_i) \
        __builtin_amdgcn_global_load_lds((const unsigned*)((const char*)(gbase) + (voff)[_i]), (PG8_LAS unsigned*)(lds + (bufoff) + ldsw + _i * 8192), 16, 0, 0); } while (0)
#define PG8_LDA(dst, b, h) do { _Pragma("unroll") for (int m = 0; m < 4; ++m) _Pragma("unroll") for (int k = 0; k < 2; ++k) dst[m][k] = *(const PG8_LAS bf16x8*)(lds + PG8_SA(b, h) + aoff + m * 2048 + k * 1024); } while (0)
#define PG8_LDB(dst, b, h) do { _Pragma("unroll") for (int n = 0; n < 2; ++n) _Pragma("unroll") for (int k = 0; k < 2; ++k) dst[n][k] = *(const PG8_LAS bf16x8*)(lds + PG8_SB(b, h) + boff + n * 2048 + k * 1024); } while (0)
#define PG8_MMA(ai, bj, At, Bt) do { __builtin_amdgcn_s_setprio(1); _Pragma("unroll") for (int m = 0; m < 4; ++m) _Pragma("unroll") for (int n = 0; n < 2; ++n) _Pragma("unroll") for (int k = 0; k < 2; ++k) \
        acc[ai][bj][m][n] = __builtin_amdgcn_mfma_f32_16x16x32_bf16(Bt[n][k], At[m][k], acc[ai][bj][m][n], 0, 0, 0); __builtin_amdgcn_s_setprio(0); } while (0)
#define PG8_WAIT_V(n) asm volatile("s_waitcnt vmcnt(" #n ")" ::: "memory")
#define PG8_WAIT_L(n) asm volatile("s_waitcnt lgkmcnt(" #n ")" ::: "memory")
#define PG8_BAR __builtin_amdgcn_s_barrier()
#define PG8_SCHED __builtin_amdgcn_sched_barrier(0)
    Unit cur, nxt; int ui = 0;
    if (!S.next(0, cur)) return;
    f32x4 acc[2][2][4][2];
#pragma unroll
    for (int a = 0; a < 2; ++a)
#pragma unroll
        for (int b = 0; b < 2; ++b)
#pragma unroll
            for (int m = 0; m < 4; ++m)
#pragma unroll
                for (int n = 0; n < 2; ++n) acc[a][b][m][n] = (f32x4){0.f, 0.f, 0.f, 0.f};
    bf16x8 At[4][2], B0[2][2], B1[2][2];
    const char* cA = (const char*)g.A + (size_t)cur.pm * tstep + (size_t)cur.k0 * 2; const char* cB = (const char*)g.Bt + (size_t)cur.pn * tstep + (size_t)cur.k0 * 2;
    S.a_ready(cur);
    if constexpr (SP2) {
        PG8_STAGE(PG8_SB(0, 0), cB, voffB); PG8_STAGE(PG8_SB(0, 1), cB + hstep, voffB); PG8_STAGE(PG8_SA(0, 0), cA, voffA); PG8_STAGE(PG8_SA(0, 1), cA + hstep, voffA);
        if (wr == 1) PG8_BAR;
        PG8_WAIT_V(2); PG8_BAR;
        PG8_STAGE(PG8_SB(1, 0), cB + kstep, voffB); PG8_STAGE(PG8_SA(1, 0), cA + kstep, voffA); PG8_STAGE(PG8_SB(1, 1), cB + hstep + kstep, voffB);
        PG8_WAIT_V(6); PG8_BAR;
    } else {
        PG8_STAGE(PG8_SB(0, 0), cB, voffB); PG8_STAGE(PG8_SA(0, 0), cA, voffA); PG8_STAGE(PG8_SB(0, 1), cB + hstep, voffB); PG8_STAGE(PG8_SA(0, 1), cA + hstep, voffA);
        if (wr == 1) PG8_BAR;
        PG8_WAIT_V(4); PG8_BAR;
        PG8_STAGE(PG8_SB(1, 0), cB + kstep, voffB); PG8_STAGE(PG8_SA(1, 0), cA + kstep, voffA); PG8_STAGE(PG8_SB(1, 1), cB + hstep + kstep, voffB);
        PG8_WAIT_V(6); PG8_BAR;
    }
    for (;;) {
        const bool has_next = S.next(ui + 1, nxt);
        const char* nA = has_next ? (const char*)g.A + (size_t)nxt.pm * tstep + (size_t)nxt.k0 * 2 : cA; const char* nB = has_next ? (const char*)g.Bt + (size_t)nxt.pn * tstep + (size_t)nxt.k0 * 2 : cB;
        for (int t = 0; t < nt; t += 2) {
            const bool last = (t == nt - 2);
            const char* a1 = cA + (size_t)(t + 1) * kstep;
            const char* a2 = last ? nA : cA + (size_t)(t + 2) * kstep; const char* b2 = last ? nB : cB + (size_t)(t + 2) * kstep;
            const char* a3 = a2 + kstep; const char* b3 = b2 + kstep;
            if (last && has_next) S.a_ready(nxt);
            if constexpr (SP2) {
            PG8_LDB(B0, 0, 0); PG8_LDB(B1, 0, 1); PG8_SCHED; PG8_LDA(At, 0, 0); PG8_STAGE(PG8_SA(1, 1), a1 + hstep, voffA);
            PG8_WAIT_V(8); PG8_WAIT_L(0); PG8_BAR; PG8_MMA(0, 0, At, B0); PG8_MMA(0, 1, At, B1); PG8_BAR; PG8_SCHED;
            PG8_LDA(At, 0, 1); PG8_STAGE(PG8_SB(0, 0), b2, voffB); PG8_STAGE(PG8_SB(0, 1), b2 + hstep, voffB); PG8_STAGE(PG8_SA(0, 0), a2, voffA);
            PG8_WAIT_V(8); PG8_WAIT_L(0); PG8_BAR; PG8_MMA(1, 0, At, B0); PG8_MMA(1, 1, At, B1); PG8_BAR; PG8_SCHED;
            PG8_LDB(B0, 1, 0); PG8_LDB(B1, 1, 1); PG8_SCHED; PG8_LDA(At, 1, 0); PG8_STAGE(PG8_SA(0, 1), a2 + hstep, voffA);
            PG8_WAIT_V(8); PG8_WAIT_L(0); PG8_BAR; PG8_MMA(0, 0, At, B0); PG8_MMA(0, 1, At, B1); PG8_BAR; PG8_SCHED;
            PG8_LDA(At, 1, 1); PG8_STAGE(PG8_SB(1, 0), b3, voffB); PG8_STAGE(PG8_SB(1, 1), b3 + hstep, voffB); PG8_STAGE(PG8_SA(1, 0), a3, voffA);
            PG8_WAIT_V(8); PG8_WAIT_L(0); PG8_BAR; PG8_MMA(1, 0, At, B0); PG8_MMA(1, 1, At, B1); PG8_BAR; PG8_SCHED;
            } else {
            PG8_LDB(B0, 0, 0); PG8_SCHED; PG8_LDA(At, 0, 0); PG8_STAGE(PG8_SA(1, 1), a1 + hstep, voffA);
            PG8_WAIT_L(8); PG8_BAR; PG8_WAIT_L(0); PG8_MMA(0, 0, At, B0); PG8_BAR; PG8_SCHED;
            PG8_LDB(B1, 0, 1); PG8_STAGE(PG8_SB(0, 0), b2, voffB);
            PG8_BAR; PG8_WAIT_L(0); PG8_MMA(0, 1, At, B1); PG8_BAR;
            PG8_LDA(At, 0, 1); PG8_STAGE(PG8_SA(0, 0), a2, voffA);
            PG8_BAR; PG8_WAIT_L(0); PG8_MMA(1, 0, At, B0); PG8_BAR; PG8_SCHED;
            PG8_STAGE(PG8_SB(0, 1), b2 + hstep, voffB);
            PG8_WAIT_V(6); PG8_BAR; PG8_MMA(1, 1, At, B1); PG8_BAR;
            PG8_LDB(B0, 1, 0); PG8_SCHED; PG8_LDA(At, 1, 0); PG8_STAGE(PG8_SA(0, 1), a2 + hstep, voffA);
            PG8_WAIT_L(8); PG8_BAR; PG8_WAIT_L(0); PG8_MMA(0, 0, At, B0); PG8_BAR; PG8_SCHED;
            PG8_LDB(B1, 1, 1); PG8_STAGE(PG8_SB(1, 0), b3, voffB);
            PG8_BAR; PG8_WAIT_L(0); PG8_MMA(0, 1, At, B1); PG8_BAR;
            PG8_LDA(At, 1, 1); PG8_STAGE(PG8_SA(1, 0), a3, voffA);
            PG8_BAR; PG8_WAIT_L(0); PG8_MMA(1, 0, At, B0); PG8_BAR; PG8_SCHED;
            PG8_STAGE(PG8_SB(1, 1), b3 + hstep, voffB);
            PG8_WAIT_V(6); PG8_BAR; PG8_MMA(1, 1, At, B1); PG8_BAR;
            }
        }
        if constexpr (ALIGN_EPI) { if (wr == 0) PG8_BAR; }
        if constexpr (!Epi::AFTER_DRAIN) { E(acc, cur, wr, wc, fr, fq); S.done(cur); }
        if (!has_next) break;
#pragma unroll
        for (int a = 0; a < 2; ++a)
#pragma unroll
            for (int b = 0; b < 2; ++b)
#pragma unroll
                for (int m = 0; m < 4; ++m)
#pragma unroll
                    for (int n = 0; n < 2; ++n) acc[a][b][m][n] = (f32x4){0.f, 0.f, 0.f, 0.f};
        cur = nxt; cA = nA; cB = nB; ++ui;
        if constexpr (ALIGN_EPI) { if (wr == 1) PG8_BAR; }
    }
    PG8_WAIT_V(0);
    if constexpr (!ALIGN_EPI) { if (wr == 0) PG8_BAR; }
    PG8_BAR;
    if constexpr (Epi::AFTER_DRAIN) { E.fused(acc, cur, wr, wc, fr, fq, lds, wid, lane); S.done(cur); }
#undef PG8_SA
#undef PG8_SB
#undef PG8_STAGE
#undef PG8_LDA
#undef PG8_LDB
#undef PG8_MMA
#undef PG8_WAIT_V
#undef PG8_WAIT_L
#undef PG8_BAR
#undef PG8_SCHED
}
}

#define GAS __attribute__((address_space(1)))
#define LAS __attribute__((address_space(3)))
typedef unsigned short bf16;
typedef float f32x4 __attribute__((ext_vector_type(4)));
typedef float f32x2 __attribute__((ext_vector_type(2)));
typedef float f32x16 __attribute__((ext_vector_type(16)));
typedef short bf16x8 __attribute__((ext_vector_type(8)));
typedef short s16x4 __attribute__((ext_vector_type(4)));
typedef unsigned u32x4 __attribute__((ext_vector_type(4)));
typedef unsigned u32x2 __attribute__((ext_vector_type(2)));

constexpr int NB = 4, SEQ = 2048, CTX = 256, DM = 2048, DEPTH = 2, FF = 8192;
constexpr int TOK = CTX + SEQ;
constexpr int M = NB * TOK;
constexpr int NZ = 4416, NZP = 4608;
constexpr int NUQ = 1152, NUQP = 1280, NUKV = 1536, RANK = 512;
constexpr int MODW = 6 * DM;
constexpr float EPS = 1e-6f;
constexpr float LOG2E = 1.4426950408889634f;
constexpr float DA_QS = 0.125f * LOG2E;
constexpr float MLA_QS = 0.07216878364870322f * LOG2E;
constexpr int NWAVES = 8, NTHR = 512;

enum { I_X = 0, I_C, I_CTX, I_CCTX, I_WMOD, I_BMOD, I_GMIX, I_GMLP, I_WIN, I_LQ1, I_LK1, I_LQ2, I_LK2, I_GDASUB, I_GGMV, I_WSP, I_BSP,
       I_GMQ, I_WUQ, I_GMKV, I_WUKV, I_WOUT, I_WFC1, I_WFC2, I_GFINAL, N_IN };

constexpr size_t al256(size_t x) { return (x + 255) / 256 * 256; }
constexpr size_t WS_ROPE  = 0;
constexpr size_t WS_SCAL  = WS_ROPE + 8192;
constexpr size_t WS_BAR   = WS_SCAL + 256;
constexpr size_t WS_MOD   = WS_BAR + 16384;
constexpr size_t WS_MODP  = al256(WS_MOD + (size_t)DEPTH * 5 * MODW * 4);
constexpr size_t WS_WIN   = al256(WS_MODP + 256);
constexpr size_t WS_WOUT  = al256(WS_WIN + (size_t)DEPTH * NZP * DM * 2);
constexpr size_t WS_WFC1  = al256(WS_WOUT + (size_t)DEPTH * DM * DM * 2);
constexpr size_t WS_WFC2  = al256(WS_WFC1 + (size_t)DEPTH * FF * DM * 2);
constexpr size_t WS_WUQ   = al256(WS_WFC2 + (size_t)DEPTH * DM * FF * 2);
constexpr size_t WS_WUKV  = al256(WS_WUQ + (size_t)DEPTH * NUQP * RANK * 2);
constexpr size_t WS_WSP   = al256(WS_WUKV + (size_t)DEPTH * NUKV * RANK * 2);
constexpr size_t WS_XW    = al256(WS_WSP + (size_t)DEPTH * 4 * 128 * 128 * 2);
constexpr size_t WS_HN    = al256(WS_XW + (size_t)M * DM * 4);
constexpr size_t WS_QDA   = al256(WS_HN + (size_t)M * DM * 2);
constexpr size_t WS_KDA   = al256(WS_QDA + (size_t)M * 768 * 2);
constexpr size_t WS_VDA   = al256(WS_KDA + (size_t)M * 768 * 2);
constexpr size_t WS_U     = al256(WS_VDA + (size_t)M * 768 * 2);
constexpr size_t WS_GV    = al256(WS_U + (size_t)M * 512 * 4);
constexpr size_t WS_GVSS  = al256(WS_GV + (size_t)M * 512 * 4);
constexpr size_t WS_CQSS  = al256(WS_GVSS + (size_t)M * 16 * 4);
constexpr size_t WS_CKVSS = al256(WS_CQSS + (size_t)M * 8 * 4);
constexpr size_t WS_CQ    = al256(WS_CKVSS + (size_t)M * 8 * 4);
constexpr size_t WS_CKV   = al256(WS_CQ + (size_t)M * 512 * 2);
constexpr size_t WS_KMLA  = al256(WS_CKV + (size_t)M * 512 * 2);
constexpr size_t WS_VMLA  = al256(WS_KMLA + (size_t)M * 1152 * 2);
constexpr size_t WS_QMLA  = al256(WS_VMLA + (size_t)M * 768 * 2);
constexpr size_t WS_HEADS = al256(WS_QMLA + (size_t)M * 1152 * 2);
constexpr size_t WS_ACT   = al256(WS_HEADS + (size_t)M * DM * 2);
constexpr size_t WS_STASH = al256(WS_ACT + (size_t)M * FF * 2);
constexpr size_t WS_SLAB  = al256(WS_STASH + (size_t)256 * 64 * 512 * 4);
constexpr size_t WS_END   = al256(WS_SLAB + (size_t)8 * 1024 * DM * 4);

constexpr int LDS_BYTES = 131072 + 1024;

__device__ __forceinline__ unsigned cvtpk(float lo, float hi) { unsigned r; asm volatile("v_cvt_pk_bf16_f32 %0, %1, %2" : "=v"(r) : "v"(lo), "v"(hi)); return r; }
__device__ __forceinline__ u32x4 pack8(f32x4 a, f32x4 b) { u32x4 w; w.x = cvtpk(a[0], a[1]); w.y = cvtpk(a[2], a[3]); w.z = cvtpk(b[0], b[1]); w.w = cvtpk(b[2], b[3]); return w; }
__device__ __forceinline__ float wave_sum(float v) {
#pragma unroll
    for (int o = 1; o < 64; o <<= 1) v += __shfl_xor(v, o);
    return v;
}
__device__ __forceinline__ float bf2f(unsigned short h) { return __uint_as_float(((unsigned)h) << 16); }

struct Args { const float* in[N_IN]; float* out; unsigned char* ws; int ph_lo, ph_hi; };
struct Frame {
    LAS unsigned char* lds;
    int G, vcu;
    float* out; unsigned char* ws;
};
#define WSP(T, off) ((T*)(F.ws + (off)))
template <int I> __device__ __forceinline__ const float* inp() {
    unsigned long long p; asm volatile("s_load_dwordx2 %0, %1, %2\n\ts_waitcnt lgkmcnt(0)" : "=s"(p) : "s"(__builtin_amdgcn_kernarg_segment_ptr()), "n"(I * 8) : "memory"); return (const float*)p; }

__device__ __forceinline__ const float* xrow_in(const Args& A, const Frame& F, int row) {
    const int b = row / TOK, rr = row - b * TOK;
    return rr < CTX ? inp<I_CTX>() + (size_t)(b * CTX + rr) * DM : inp<I_X>() + (size_t)(b * SEQ + rr - CTX) * DM;
}

__device__ __forceinline__ void p0_transpose_item(const float* W, int K, int N, bf16* WT, const float* kscale, LAS float* scr, int item, int lane) {
    const int nblk = N / 32, kb = item / nblk, nb = item % nblk, k0 = 64 * kb, n0 = 32 * nb;
    { const int r8 = lane >> 3, c4 = (lane & 7) * 4; f32x4 v[8];
#pragma unroll
      for (int i = 0; i < 8; ++i) v[i] = *(const f32x4*)(W + (size_t)(k0 + r8 + 8 * i) * N + n0 + c4);
#pragma unroll
      for (int i = 0; i < 8; ++i) { const int kk = r8 + 8 * i; const float s = kscale ? kscale[k0 + kk] : 1.f; LAS float* d = scr + kk * 33 + c4;
          d[0] = v[i][0] * s; d[1] = v[i][1] * s; d[2] = v[i][2] * s; d[3] = v[i][3] * s; } }
    asm volatile("s_waitcnt lgkmcnt(0)" ::: "memory");
    const int c = lane & 7;
#pragma unroll
    for (int j = 0; j < 4; ++j) { const int n = (lane >> 3) + 8 * j; const LAS float* s = scr + (8 * c) * 33 + n;
        u32x4 o; o.x = cvtpk(s[0 * 33], s[1 * 33]); o.y = cvtpk(s[2 * 33], s[3 * 33]); o.z = cvtpk(s[4 * 33], s[5 * 33]); o.w = cvtpk(s[6 * 33], s[7 * 33]);
        *(u32x4*)(WT + (size_t)(n0 + n) * K + k0 + 8 * c) = o; }
    asm volatile("s_waitcnt lgkmcnt(0)" ::: "memory");
}
__device__ __forceinline__ float silu_f(float x) { return x / (1.f + __expf(-x)); }

__device__ __forceinline__ void p0_mod_item(const Args& A, const Frame& F, LAS float* scr, int l, int item, int lane) {
    const int kc = item / 48, nc = item % 48;
    const int k = kc * 64 + lane;
#pragma unroll
    for (int bb = 0; bb < 5; ++bb) { const float cv = bb < 4 ? inp<I_C>()[bb * DM + k] : inp<I_CCTX>()[k]; scr[bb * 64 + lane] = silu_f(cv); }
    asm volatile("s_waitcnt lgkmcnt(0)" ::: "memory");
    const float* W = inp<I_WMOD>() + ((size_t)l * DM + kc * 64) * MODW + nc * 256 + lane * 4;
    f32x4 acc[5];
#pragma unroll
    for (int bb = 0; bb < 5; ++bb) acc[bb] = (f32x4){0.f, 0.f, 0.f, 0.f};
#pragma unroll 8
    for (int kk = 0; kk < 64; ++kk) { const f32x4 w = *(const f32x4*)(W + (size_t)kk * MODW);
#pragma unroll
        for (int bb = 0; bb < 5; ++bb) acc[bb] += w * scr[bb * 64 + kk]; }
    if (kc == 0) { const f32x4 bv = *(const f32x4*)(inp<I_BMOD>() + l * MODW + nc * 256 + lane * 4);
#pragma unroll
        for (int bb = 0; bb < 5; ++bb) acc[bb] += bv; }
    LAS float* t = scr + 512;
    float* Mo = WSP(float, WS_MOD) + (size_t)l * 5 * MODW + nc * 256 + lane;
#pragma unroll
    for (int bb = 0; bb < 5; ++bb) {
        *(LAS f32x4*)(t + lane * 4) = acc[bb]; asm volatile("s_waitcnt lgkmcnt(0)" ::: "memory");
#pragma unroll
        for (int e = 0; e < 4; ++e) { const float v = t[e * 64 + lane]; __hip_atomic_fetch_add(Mo + (size_t)bb * MODW + e * 64, v, __ATOMIC_RELAXED, __HIP_MEMORY_SCOPE_AGENT); }
        asm volatile("s_waitcnt lgkmcnt(0)" ::: "memory");
    }
}
__device__ __forceinline__ void mod_gemv(const Args& A, const Frame& F, int l, int wcu, int ncu) {
    int tid_ = threadIdx.x; asm volatile("" : "+v"(tid_)); const int ptid = tid_, plane = ptid & 63, pwave = __builtin_amdgcn_readfirstlane(ptid >> 6);
    LAS float* scr = (LAS float*)(F.lds + pwave * 16384);
    for (int it = wcu * NWAVES + pwave; it < 32 * 48; it += ncu * NWAVES) p0_mod_item(A, F, scr, l, it, plane);
}

enum { J_IN = 1, J_OUT = 2, J_FC1 = 4, J_FC2 = 8, J_UQ = 16, J_UKV = 32 };
__device__ __forceinline__ void conv_weights(const Args& A, const Frame& F, int l, int jobs, int wcu, int ncu, int shift = 0) {
    int tid_ = threadIdx.x; asm volatile("" : "+v"(tid_)); const int ptid = tid_, plane = ptid & 63, pwave = __builtin_amdgcn_readfirstlane(ptid >> 6);
    LAS float* scr = (LAS float*)(F.lds + pwave * 16384);
    const int NGW = ncu * NWAVES, gw = (wcu * NWAVES + pwave + NGW - (shift % NGW)) % NGW;
    constexpr int T_IN = (DM / 64) * (NZ / 32), T_OUT = (DM / 64) * (DM / 32), T_FC1 = (DM / 64) * (FF / 32), T_FC2 = (FF / 64) * (DM / 32), T_UQ = (RANK / 64) * (NUQ / 32), T_UKV = (RANK / 64) * (NUKV / 32);
    const int n_in = (jobs & J_IN) ? T_IN : 0, n_out = (jobs & J_OUT) ? T_OUT : 0, n_fc1 = (jobs & J_FC1) ? T_FC1 : 0, n_fc2 = (jobs & J_FC2) ? T_FC2 : 0, n_uq = (jobs & J_UQ) ? T_UQ : 0, n_ukv = (jobs & J_UKV) ? T_UKV : 0;
    const int total = n_in + n_out + n_fc1 + n_fc2 + n_uq + n_ukv;
    for (int it = gw; it < total; it += NGW) {
        int r = it;
        if (r < n_in)  { p0_transpose_item(inp<I_WIN>() + (size_t)l * DM * NZ, DM, NZ, WSP(bf16, WS_WIN) + (size_t)l * NZP * DM, nullptr, scr, r, plane); continue; } r -= n_in;
        if (r < n_out) { p0_transpose_item(inp<I_WOUT>() + (size_t)l * DM * DM, DM, DM, WSP(bf16, WS_WOUT) + (size_t)l * DM * DM, nullptr, scr, r, plane); continue; } r -= n_out;
        if (r < n_fc1) { p0_transpose_item(inp<I_WFC1>() + (size_t)l * DM * FF, DM, FF, WSP(bf16, WS_WFC1) + (size_t)l * FF * DM, nullptr, scr, r, plane); continue; } r -= n_fc1;
        if (r < n_fc2) { p0_transpose_item(inp<I_WFC2>() + (size_t)l * FF * DM, FF, DM, WSP(bf16, WS_WFC2) + (size_t)l * DM * FF, nullptr, scr, r, plane); continue; } r -= n_fc2;
        if (r < n_uq)  { p0_transpose_item(inp<I_WUQ>() + (size_t)l * RANK * NUQ, RANK, NUQ, WSP(bf16, WS_WUQ) + (size_t)l * NUQP * RANK, inp<I_GMQ>() + l * RANK, scr, r, plane); continue; } r -= n_uq;
        p0_transpose_item(inp<I_WUKV>() + (size_t)l * RANK * NUKV, RANK, NUKV, WSP(bf16, WS_WUKV) + (size_t)l * NUKV * RANK, inp<I_GMKV>() + l * RANK, scr, r, plane);
    }
}
#ifndef DEFER_CONV
#define DEFER_CONV 1
#endif
__device__ __forceinline__ void p0_prologue(const Args& A, const Frame& F) {
    int tid_ = threadIdx.x; asm volatile("" : "+v"(tid_)); const int ptid = tid_, plane = ptid & 63, pwave = __builtin_amdgcn_readfirstlane(ptid >> 6);
    LAS float* scr = (LAS float*)(F.lds + pwave * 16384);
    const int gw = F.vcu * NWAVES + pwave, NGW = F.G * NWAVES;
    constexpr int I_MOD = 32 * 48;
    mod_gemv(A, F, 0, F.vcu, F.G);
    if (!DEFER_CONV) for (int l = 1; l < DEPTH; ++l) mod_gemv(A, F, l, F.vcu, F.G);
    if (DEFER_CONV) conv_weights(A, F, 0, J_IN | J_UQ | J_UKV, F.vcu, F.G, I_MOD);
    else for (int l = 0; l < DEPTH; ++l) conv_weights(A, F, l, J_IN | J_OUT | J_FC1 | J_FC2 | J_UQ | J_UKV, F.vcu, F.G, I_MOD);
    const int gt = F.vcu * NTHR + ptid, NGT = F.G * NTHR;
    for (int i = gt; i < DEPTH * (NZP - NZ) * DM / 8; i += NGT) { const int l = i / ((NZP - NZ) * DM / 8), r = i % ((NZP - NZ) * DM / 8);
        *(u32x4*)(WSP(bf16, WS_WIN) + ((size_t)l * NZP + NZ) * DM + (size_t)r * 8) = (u32x4){0u, 0u, 0u, 0u}; }
    for (int i = gt; i < DEPTH * (NUQP - NUQ) * RANK / 8; i += NGT) { const int l = i / ((NUQP - NUQ) * RANK / 8), r = i % ((NUQP - NUQ) * RANK / 8);
        *(u32x4*)(WSP(bf16, WS_WUQ) + ((size_t)l * NUQP + NUQ) * RANK + (size_t)r * 8) = (u32x4){0u, 0u, 0u, 0u}; }
    for (int i = gt; i < DEPTH * 4 * 128 * 128 / 8; i += NGT) { const f32x4 a = *(const f32x4*)(inp<I_WSP>() + (size_t)i * 8), b = *(const f32x4*)(inp<I_WSP>() + (size_t)i * 8 + 4);
        *(u32x4*)(WSP(bf16, WS_WSP) + (size_t)i * 8) = pack8(a, b); }
    if (gt < 64 * 16) { const int pos = gt >> 4, f = gt & 15; const float inv = powf(10000.0f, -(float)f / 16.0f); const float ang = (float)pos * inv;
        WSP(float, WS_ROPE)[gt] = cosf(ang); WSP(float, WS_ROPE)[1024 + gt] = sinf(ang); }
    if (gt < 64 * DEPTH) {
        const int l = gt >> 6; const float a = inp<I_LQ1>()[l * 64 + plane] * inp<I_LK1>()[l * 64 + plane], b = inp<I_LQ2>()[l * 64 + plane] * inp<I_LK2>()[l * 64 + plane];
        const float sa = wave_sum(a), sb = wave_sum(b); const float lam_init = 0.8f - 0.6f * expf(-0.3f * (float)l);
        if (plane == 0) WSP(float, WS_SCAL)[l] = expf(sa) - expf(sb) + lam_init;
    }
}
__device__ __forceinline__ void norm_phase(const Args& A, const Frame& F, int l, int src_mode, const float* g, int shoff, const float* slab, bool skip_ctx) {
    int tid_ = threadIdx.x; asm volatile("" : "+v"(tid_)); const int ptid = tid_, plane = ptid & 63, pwave = __builtin_amdgcn_readfirstlane(ptid >> 6);
    const int gw = F.vcu * NWAVES + pwave, NGW = F.G * NWAVES;
    for (int row = gw; row < M; row += NGW) {
        const int b = row / TOK, rr = row - b * TOK; const bool isctx = rr < CTX; const int bsel = isctx ? 4 : b;
        if (isctx && skip_ctx) continue;
        const bool from_in = src_mode == 1 || (src_mode == 2 && isctx);
        const float* xr = from_in ? xrow_in(A, F, row) : WSP(float, WS_XW) + (size_t)row * DM;
        const float* md = WSP(float, WS_MOD) + ((size_t)l * 5 + bsel) * MODW + shoff;
        f32x4 v[8]; float s = 0.f;
#pragma unroll
        for (int j = 0; j < 8; ++j) v[j] = *(const f32x4*)(xr + 4 * plane + 256 * j);
        if (isctx && slab) {
            const float* sp = slab + (size_t)(b * CTX + rr) * DM + 4 * plane;
            for (int ks = 0; ks < 8; ++ks) {
#pragma unroll
                for (int j = 0; j < 8; ++j) v[j] += *(const f32x4*)(sp + (size_t)ks * 1024 * DM + 256 * j); }
            float* xo = WSP(float, WS_XW) + (size_t)row * DM + 4 * plane;
#pragma unroll
            for (int j = 0; j < 8; ++j) *(f32x4*)(xo + 256 * j) = v[j];
        }
#pragma unroll
        for (int j = 0; j < 8; ++j) s += (v[j].x * v[j].x + v[j].y * v[j].y) + (v[j].z * v[j].z + v[j].w * v[j].w);
        const float rstd = 1.0f / sqrtf(wave_sum(s) * (1.f / DM) + EPS);
        bf16* o = WSP(bf16, WS_HN) + (size_t)row * DM;
#pragma unroll
        for (int j = 0; j < 8; ++j) { const int c = 4 * plane + 256 * j; const f32x4 gg = *(const f32x4*)(g + c), sh = *(const f32x4*)(md + c), sc = *(const f32x4*)(md + DM + c);
            const f32x4 y = (v[j] * rstd) * gg * (sc + 1.0f) + sh; u32x2 w; w.x = cvtpk(y.x, y.y); w.y = cvtpk(y.z, y.w); *(u32x2*)(o + c) = w; }
    }
}
__device__ __forceinline__ void final_norm_phase(const Args& A, const Frame& F) {
    int tid_ = threadIdx.x; asm volatile("" : "+v"(tid_)); const int ptid = tid_, plane = ptid & 63, pwave = __builtin_amdgcn_readfirstlane(ptid >> 6);
    const int gw = F.vcu * NWAVES + pwave, NGW = F.G * NWAVES; const float* g = inp<I_GFINAL>();
    for (int r = gw; r < NB * SEQ; r += NGW) {
        const int b = r / SEQ, t = r - b * SEQ; const float* xr = WSP(float, WS_XW) + (size_t)(b * TOK + CTX + t) * DM;
        f32x4 v[8]; float s = 0.f;
#pragma unroll
        for (int j = 0; j < 8; ++j) { v[j] = *(const f32x4*)(xr + 4 * plane + 256 * j); s += (v[j].x * v[j].x + v[j].y * v[j].y) + (v[j].z * v[j].z + v[j].w * v[j].w); }
        const float rstd = 1.0f / sqrtf(wave_sum(s) * (1.f / DM) + EPS);
        float* o = F.out + (size_t)r * DM;
#pragma unroll
        for (int j = 0; j < 8; ++j) { const int c = 4 * plane + 256 * j; const f32x4 gg = *(const f32x4*)(g + c); *(f32x4*)(o + c) = (v[j] * rstd) * gg; }
    }
}

struct TileOrder {
    int nM, nN, nwg, G, c, mode, nsplit, kslice;
    __device__ void init(int N, int G_, int c_, int mode_, int nsplit_ = 1, int kslice_ = 0) { mode = mode_; nsplit = nsplit_; kslice = kslice_; nM = mode_ == 0 ? 36 : (mode_ == 1 ? 32 : 4); nN = N / 256; nwg = nM * nN * nsplit_; G = G_; c = c_; }
    __device__ bool next(int i, pg8::Unit& u) const {
        const long L = (long)i * G + c; if (L >= nwg) return false;
        int wgid = (int)L; { const int q = nwg / 8, r = nwg % 8, xcd = wgid % 8, off = wgid / 8; wgid = (xcd < r ? xcd * (q + 1) : r * (q + 1) + (xcd - r) * q) + off; }
        if (mode == 3) {
            const int per = 4 * nN, ks = wgid / per, rem = wgid - ks * per; u.ks = ks; u.k0 = ks * kslice; u.pn = rem >> 2; u.pm = (rem & 3) * 9; return true; }
        const int nig = 8 * nN, gid = wgid / nig, fm = gid * 8, gsz = (nM - fm) < 8 ? (nM - fm) : 8;
        int pm = fm + ((wgid % nig) % gsz); u.pn = (wgid % nig) / gsz;
        if (mode == 1) pm = (pm >> 3) * 9 + 1 + (pm & 7); else if (mode == 2) pm = pm * 9;
        u.pm = pm; u.k0 = 0; u.ks = 0; return true;
    }
    __device__ __forceinline__ void a_ready(const pg8::Unit&) const {}
    __device__ __forceinline__ void done(const pg8::Unit&) const {}
};

__device__ __forceinline__ void rope8(f32x4& v0, f32x4& v1, const float* ropetab, int pos, int f0) {
    const f32x4 c = *(const f32x4*)(ropetab + pos * 16 + f0), s = *(const f32x4*)(ropetab + 1024 + pos * 16 + f0);
    const f32x4 a = v0, b = v1;
    v0[0] = a[0] * c[0] - a[1] * s[0]; v0[1] = a[0] * s[0] + a[1] * c[0]; v0[2] = a[2] * c[1] - a[3] * s[1]; v0[3] = a[2] * s[1] + a[3] * c[1];
    v1[0] = b[0] * c[2] - b[1] * s[2]; v1[1] = b[0] * s[2] + b[1] * c[2]; v1[2] = b[2] * c[3] - b[3] * s[3]; v1[3] = b[2] * s[3] + b[3] * c[3];
}
__device__ __forceinline__ f32x4 gelu4(f32x4 v) { const f32x2 a = pg8::gelu_pk((f32x2){v[0], v[1]}), b = pg8::gelu_pk((f32x2){v[2], v[3]}); return (f32x4){a.x, a.y, b.x, b.y}; }
__device__ __forceinline__ float ss8(f32x4 a, f32x4 b) { return (a[0] * a[0] + a[1] * a[1]) + (a[2] * a[2] + a[3] * a[3]) + (b[0] * b[0] + b[1] * b[1]) + (b[2] * b[2] + b[3] * b[3]); }

struct EpiZ {
    static constexpr bool PERM = true, AFTER_DRAIN = false;
    unsigned char* ws; const float* ropetab;
    __device__ __forceinline__ void operator()(const f32x4 (&acc)[2][2][4][2], const pg8::Unit& u, int wr, int wc, int fr_, int fq_) const {
        int fr = fr_, fq = fq_; asm volatile("" : "+v"(fr), "+v"(fq));
        const int pn = u.pn;
#pragma unroll
        for (int ai = 0; ai < 2; ++ai)
#pragma unroll
            for (int m = 0; m < 4; ++m) {
                const int row = u.pm * 256 + ai * 128 + wr * 64 + m * 16 + fr;
                const int b = row / TOK, rr = row - b * TOK; const bool lat = rr >= CTX; const int t = rr - CTX, prow = (t >> 6) & 31, pcol = t & 63;
                float ssq = 0.f;
#pragma unroll
                for (int bj = 0; bj < 2; ++bj) {
                    const int colt = bj * 128 + wc * 32 + 8 * fq;
                    f32x4 v0 = acc[ai][bj][m][0], v1 = acc[ai][bj][m][1];
                    if (pn < 6) {
                        if (lat) { const int j0 = (colt & 63) >> 1; rope8(v0, v1, ropetab, j0 < 16 ? prow : pcol, j0 & 15); }
                        if (pn < 3) { v0 *= DA_QS; v1 *= DA_QS; *(u32x4*)((bf16*)(ws + WS_QDA) + (size_t)row * 768 + pn * 256 + colt) = pack8(v0, v1); }
                        else *(u32x4*)((bf16*)(ws + WS_KDA) + (size_t)row * 768 + (pn - 3) * 256 + colt) = pack8(v0, v1);
                    } else if (pn < 9) {
                        *(u32x4*)((bf16*)(ws + WS_VDA) + (size_t)row * 768 + (pn - 6) * 256 + colt) = pack8(v0, v1);
                    } else if (pn < 11) {
                        float* o = (float*)(ws + WS_U) + (size_t)row * 512 + (pn - 9) * 256 + colt; *(f32x4*)o = gelu4(v0); *(f32x4*)(o + 4) = gelu4(v1);
                    } else if (pn < 13) {
                        v0 = gelu4(v0); v1 = gelu4(v1);
                        float* o = (float*)(ws + WS_GV) + (size_t)row * 512 + (pn - 11) * 256 + colt; *(f32x4*)o = v0; *(f32x4*)(o + 4) = v1;
                        float s = ss8(v0, v1); s += __shfl_xor(s, 16); s += __shfl_xor(s, 32);
                        if (fq == 0) ((float*)(ws + WS_GVSS))[(size_t)row * 16 + ((pn - 11) * 2 + bj) * 4 + wc] = s;
                    } else if (pn < 15) {
                        *(u32x4*)((bf16*)(ws + WS_CQ) + (size_t)row * 512 + (pn - 13) * 256 + colt) = pack8(v0, v1); ssq += ss8(v0, v1);
                    } else if (pn < 17) {
                        *(u32x4*)((bf16*)(ws + WS_CKV) + (size_t)row * 512 + (pn - 15) * 256 + colt) = pack8(v0, v1); ssq += ss8(v0, v1);
                    } else {
                        if (colt < 64) {
                            if (lat) { const int j0 = colt >> 1; rope8(v0, v1, ropetab, j0 < 16 ? prow : pcol, j0 & 15); }
                            const u32x4 w = pack8(v0, v1); bf16* o = (bf16*)(ws + WS_KMLA) + (size_t)row * 1152 + 128 + colt;
#pragma unroll
                            for (int h = 0; h < 6; ++h) *(u32x4*)(o + h * 192) = w;
                        }
                    }
                }
                if (pn >= 13 && pn < 17) {
                    ssq += __shfl_xor(ssq, 16); ssq += __shfl_xor(ssq, 32);
                    if (fq == 0) { if (pn < 15) ((float*)(ws + WS_CQSS))[(size_t)row * 8 + (pn - 13) * 4 + wc] = ssq; else ((float*)(ws + WS_CKVSS))[(size_t)row * 8 + (pn - 15) * 4 + wc] = ssq; }
                }
            }
    }
};
__device__ __forceinline__ float rstd8(const float* p, float inv_n) { const f32x4 a = *(const f32x4*)p, b = *(const f32x4*)(p + 4); return 1.0f / sqrtf(((a[0] + a[1]) + (a[2] + a[3]) + (b[0] + b[1]) + (b[2] + b[3])) * inv_n + EPS); }

struct EpiKV {
    static constexpr bool PERM = true, AFTER_DRAIN = false;
    unsigned char* ws;
    __device__ __forceinline__ void operator()(const f32x4 (&acc)[2][2][4][2], const pg8::Unit& u, int wr, int wc, int fr_, int fq_) const {
        int fr = fr_, fq = fq_; asm volatile("" : "+v"(fr), "+v"(fq));
#pragma unroll
        for (int ai = 0; ai < 2; ++ai)
#pragma unroll
            for (int m = 0; m < 4; ++m) {
                const int row = u.pm * 256 + ai * 128 + wr * 64 + m * 16 + fr;
                const float rs = rstd8((const float*)(ws + WS_CKVSS) + (size_t)row * 8, 1.f / RANK);
                const int c = wc * 32 + 8 * fq;
                *(u32x4*)((bf16*)(ws + WS_KMLA) + (size_t)row * 1152 + u.pn * 192 + c) = pack8(acc[ai][0][m][0] * rs, acc[ai][0][m][1] * rs);
                *(u32x4*)((bf16*)(ws + WS_VMLA) + (size_t)row * 768 + u.pn * 128 + c) = pack8(acc[ai][1][m][0] * rs, acc[ai][1][m][1] * rs);
            }
    }
};
struct EpiQ {
    static constexpr bool PERM = true, AFTER_DRAIN = false;
    unsigned char* ws; const float* ropetab;
    __device__ __forceinline__ void operator()(const f32x4 (&acc)[2][2][4][2], const pg8::Unit& u, int wr, int wc, int fr_, int fq_) const {
        int fr = fr_, fq = fq_; asm volatile("" : "+v"(fr), "+v"(fq));
#pragma unroll
        for (int ai = 0; ai < 2; ++ai)
#pragma unroll
            for (int m = 0; m < 4; ++m) {
                const int row = u.pm * 256 + ai * 128 + wr * 64 + m * 16 + fr;
                const int b = row / TOK, rr = row - b * TOK; const bool lat = rr >= CTX; const int t = rr - CTX, prow = (t >> 6) & 31, pcol = t & 63;
                const float rs = rstd8((const float*)(ws + WS_CQSS) + (size_t)row * 8, 1.f / RANK) * MLA_QS;
#pragma unroll
                for (int bj = 0; bj < 2; ++bj) {
                    const int col = u.pn * 256 + bj * 128 + wc * 32 + 8 * fq;
                    if (col < NUQ) {
                        f32x4 v0 = acc[ai][bj][m][0] * rs, v1 = acc[ai][bj][m][1] * rs;
                        const int hd = col / 192, i = col - hd * 192;
                        if (lat && i >= 128) { const int j0 = (i - 128) >> 1; rope8(v0, v1, ropetab, j0 < 16 ? prow : pcol, j0 & 15); }
                        *(u32x4*)((bf16*)(ws + WS_QMLA) + (size_t)row * 1152 + col) = pack8(v0, v1);
                    }
                }
            }
    }
};
struct EpiResid {
    static constexpr bool PERM = true, AFTER_DRAIN = false;
    unsigned char* ws; const float* xin; const float* cin; const float* gate; bool from_inputs; bool dry = false;
    __device__ __forceinline__ void operator()(const f32x4 (&acc)[2][2][4][2], const pg8::Unit& u, int wr, int wc, int fr_, int fq_) const {
        int fr = fr_, fq = fq_; asm volatile("" : "+v"(fr), "+v"(fq));
        const int b = u.pm / 9; const bool isctx = (u.pm - b * 9) == 0; const int bsel = isctx ? 4 : b;
        const int c0 = u.pn * 256 + wc * 32 + 8 * fq;
        const float* gp = gate + (size_t)bsel * MODW + c0;
        const int row0 = u.pm * 256 + wr * 64 + fr, rr0 = row0 - b * TOK;
        const float* bp = (from_inputs ? (isctx ? cin + (size_t)(b * CTX + rr0) * DM : xin + (size_t)(b * SEQ + rr0 - CTX) * DM) : (const float*)(ws + WS_XW) + (size_t)row0 * DM) + c0;
        float* op = (float*)(ws + (dry ? WS_QDA : WS_XW)) + (size_t)row0 * DM + c0;
        f32x4 g[2][2];
#pragma unroll
        for (int bj = 0; bj < 2; ++bj) { g[bj][0] = *(const f32x4*)(gp + bj * 128); g[bj][1] = *(const f32x4*)(gp + bj * 128 + 4); }
#pragma unroll
        for (int ai = 0; ai < 2; ++ai)
#pragma unroll
            for (int m = 0; m < 4; ++m) {
#pragma unroll
                for (int bj = 0; bj < 2; ++bj) {
                    const f32x4 b0 = *(const f32x4*)(bp + bj * 128), b1 = *(const f32x4*)(bp + bj * 128 + 4);
                    *(f32x4*)(op + bj * 128) = b0 + g[bj][0] * acc[ai][bj][m][0]; *(f32x4*)(op + bj * 128 + 4) = b1 + g[bj][1] * acc[ai][bj][m][1]; }
                const int adv = (m == 3 ? 80 : 16) * DM; bp += adv; op += adv; asm volatile("" : "+v"(bp), "+v"(op));
            }
    }
};
struct EpiSlab {
    static constexpr bool PERM = true, AFTER_DRAIN = false;
    float* slab; const float* gate;
    __device__ __forceinline__ void operator()(const f32x4 (&acc)[2][2][4][2], const pg8::Unit& u, int wr, int wc, int fr_, int fq_) const {
        int fr = fr_, fq = fq_; asm volatile("" : "+v"(fr), "+v"(fq));
        const int b = u.pm / 9; const int c0 = u.pn * 256 + wc * 32 + 8 * fq; const float* gp = gate + c0;
        float* op = slab + ((size_t)u.ks * 1024 + b * CTX + wr * 64 + fr) * DM + c0;
        f32x4 g[2][2];
#pragma unroll
        for (int bj = 0; bj < 2; ++bj) { g[bj][0] = *(const f32x4*)(gp + bj * 128); g[bj][1] = *(const f32x4*)(gp + bj * 128 + 4); }
#pragma unroll
        for (int ai = 0; ai < 2; ++ai)
#pragma unroll
            for (int m = 0; m < 4; ++m) {
#pragma unroll
                for (int bj = 0; bj < 2; ++bj) { *(f32x4*)(op + bj * 128) = g[bj][0] * acc[ai][bj][m][0]; *(f32x4*)(op + bj * 128 + 4) = g[bj][1] * acc[ai][bj][m][1]; }
                op += (m == 3 ? 80 : 16) * DM; asm volatile("" : "+v"(op));
            }
    }
};
struct EpiFc1 {
    static constexpr bool PERM = true, AFTER_DRAIN = false;
    unsigned char* ws;
    __device__ __forceinline__ void operator()(const f32x4 (&acc)[2][2][4][2], const pg8::Unit& u, int wr, int wc, int fr_, int fq_) const {
        int fr = fr_, fq = fq_; asm volatile("" : "+v"(fr), "+v"(fq));
#pragma unroll
        for (int ai = 0; ai < 2; ++ai)
#pragma unroll
            for (int m = 0; m < 4; ++m) {
                const int row = u.pm * 256 + ai * 128 + wr * 64 + m * 16 + fr;
#pragma unroll
                for (int bj = 0; bj < 2; ++bj) { const int c = u.pn * 256 + bj * 128 + wc * 32 + 8 * fq;
                    f32x4 v0 = __builtin_elementwise_max(acc[ai][bj][m][0], (f32x4){0.f, 0.f, 0.f, 0.f}), v1 = __builtin_elementwise_max(acc[ai][bj][m][1], (f32x4){0.f, 0.f, 0.f, 0.f});
                    *(u32x4*)((bf16*)(ws + WS_ACT) + (size_t)row * FF + c) = pack8(v0 * v0, v1 * v1); }
            }
    }
};
#define XB_TMO      128
#define XB_XCNT(j)  (256  + 64 * (j))
#define XB_XSUB(j)  (1280 + 64 * (j))
#define XB_XGEN(j)  (2304 + 64 * (j))
#define XB_TOP      3328
#define XB_TOPGEN   3392
#define XCD_BAR_WORDS 3456
#define XB_SPIN_CAP (1u << 18)

__device__ __forceinline__ unsigned xb_ld(unsigned* p)              { return __hip_atomic_load(p, __ATOMIC_RELAXED, __HIP_MEMORY_SCOPE_AGENT); }
__device__ __forceinline__ unsigned xb_add(unsigned* p, unsigned v) { return __hip_atomic_fetch_add(p, v, __ATOMIC_RELAXED, __HIP_MEMORY_SCOPE_AGENT); }
__device__ __forceinline__ unsigned xb_xcc_id() { return (unsigned)__builtin_amdgcn_s_getreg((3 << 11) | 20) & 0xFu; }
#define XB_SPIN(cond, bar) do { unsigned _sp = 0; while (cond) { __builtin_amdgcn_s_sleep(1); \
    if ((++_sp & 255u) == 0u) { if (xb_ld(&(bar)[XB_TMO])) break; if (_sp > XB_SPIN_CAP) { atomicAdd(&(bar)[XB_TMO], 1u); break; } } } } while (0)

struct XcdBarrier {
    unsigned* bar; unsigned x;
    volatile LAS unsigned* st;
};

__device__ __forceinline__ XcdBarrier xcd_barrier_post(unsigned* bar, volatile LAS unsigned* st) {
    XcdBarrier b; b.bar = bar; b.x = xb_xcc_id(); b.st = st;
    if (threadIdx.x == 0) (void)xb_add(&bar[XB_XCNT(b.x)], 1u);
    return b;
}
__device__ __forceinline__ void xcd_barrier_complete(unsigned* bar, unsigned x, unsigned& nloc, unsigned& nx) {
    const unsigned G = gridDim.x * gridDim.y * gridDim.z;
    unsigned sum, cnt, mine, sp = 0u;
    for (;;) {
        sum = 0u; cnt = 0u; mine = 0u;
#pragma unroll
        for (unsigned j = 0; j < 16; ++j) { const unsigned c = xb_ld(&bar[XB_XCNT(j)]); sum += c; cnt += (c > 0u) ? 1u : 0u; mine = (j == x) ? c : mine; }
        if (sum == G) break;
        __builtin_amdgcn_s_sleep(1);
        if ((++sp & 255u) == 0u) { if (xb_ld(&bar[XB_TMO])) break; if (sp > XB_SPIN_CAP) { atomicAdd(&bar[XB_TMO], 1u); break; } }
    }
    nloc = mine > 0u ? mine : 1u; nx = cnt > 0u ? cnt : 1u;
}

__device__ __forceinline__ void xcd_barrier(const XcdBarrier& b) {
    asm volatile("s_waitcnt vmcnt(0)" ::: "memory");
    __syncthreads();
    if (threadIdx.x == 0) {
        unsigned* bar = b.bar;
        __builtin_amdgcn_s_waitcnt(0);
        unsigned nloc = b.st[0], nx = b.st[1];
        if (nloc == 0u) { xcd_barrier_complete(bar, b.x, nloc, nx); b.st[0] = nloc; b.st[1] = nx; }
        const unsigned old = xb_add(&bar[XB_XSUB(b.x)], 1u);
        const unsigned gen = old / nloc;
        if (old + 1u == (gen + 1u) * nloc) {
            __builtin_amdgcn_fence(__ATOMIC_RELEASE, "agent");
            asm volatile("s_waitcnt vmcnt(0)" ::: "memory");
            const unsigned og = xb_add(&bar[XB_TOP], 1u);
            const unsigned tg = og / nx;
            if (og + 1u == (tg + 1u) * nx) xb_add(&bar[XB_TOPGEN], 1u);
            else XB_SPIN(xb_ld(&bar[XB_TOPGEN]) == tg, bar);
            __builtin_amdgcn_fence(__ATOMIC_ACQUIRE, "agent");
            xb_add(&bar[XB_XGEN(b.x)], 1u);
            asm volatile("s_waitcnt vmcnt(0)" ::: "memory");
        } else {
            XB_SPIN(xb_ld(&bar[XB_XGEN(b.x)]) == gen, bar);
            __builtin_amdgcn_fence(__ATOMIC_ACQUIRE, "agent");
            asm volatile("s_waitcnt vmcnt(0)" ::: "memory");
        }
    }
    __syncthreads();
}

namespace att {
#define SBAR() __builtin_amdgcn_sched_barrier(0)
constexpr int V_TILE = 64 * 128 * 2, K_OFF = 2 * V_TILE, K_TILE_MAX = 64 * 192 * 2, WS_OFF = K_OFF + 2 * K_TILE_MAX;
constexpr int QR_OFF = WS_OFF + 2048;
constexpr float THR = 6.0f;
__device__ __forceinline__ int crow(int r, int hi) { return (r & 3) + 8 * (r >> 2) + 4 * hi; }
__device__ __forceinline__ int v_st(int k, int c) { const int kk = (k & ~0xC) | ((k & 4) << 1) | ((k & 8) >> 1); return ((kk >> 3) * 4 + (c >> 5)) * 512 + ((kk & 7) * 32 + (c & 31)) * 2; }
__device__ __forceinline__ int v_rd_base(int lane) { return ((lane & 3) << 3) | (((lane >> 2) & 3) << 6) | (((lane >> 4) & 1) << 5) | (((lane >> 5) & 1) << 8); }
constexpr int v_rd_off(int d0, int ks, int half) { return d0 * 512 + ks * 4096 + half * 2048; }
template <int OFF> __device__ __forceinline__ s16x4 tr_read(int vb) { s16x4 r; asm volatile("ds_read_b64_tr_b16 %0, %1 offset:%2" : "=&v"(r) : "v"(vb), "i"(OFF) : "memory"); return r; }
template <int D0> __device__ __forceinline__ void pv_one(f32x16& od, int vb, bf16x8 pa0, bf16x8 pa1, bf16x8 pa2, bf16x8 pa3) {
    const s16x4 l0 = tr_read<v_rd_off(D0, 0, 0)>(vb), h0 = tr_read<v_rd_off(D0, 0, 1)>(vb), l1 = tr_read<v_rd_off(D0, 1, 0)>(vb), h1 = tr_read<v_rd_off(D0, 1, 1)>(vb);
    const s16x4 l2 = tr_read<v_rd_off(D0, 2, 0)>(vb), h2 = tr_read<v_rd_off(D0, 2, 1)>(vb), l3 = tr_read<v_rd_off(D0, 3, 0)>(vb), h3 = tr_read<v_rd_off(D0, 3, 1)>(vb);
    asm volatile("s_waitcnt lgkmcnt(0)" ::: "memory"); SBAR();
#define PK(L, H) (bf16x8){L[0], L[1], L[2], L[3], H[0], H[1], H[2], H[3]}
    od = __builtin_amdgcn_mfma_f32_32x32x16_bf16(pa0, PK(l0, h0), od, 0, 0, 0);
    od = __builtin_amdgcn_mfma_f32_32x32x16_bf16(pa1, PK(l1, h1), od, 0, 0, 0);
    od = __builtin_amdgcn_mfma_f32_32x32x16_bf16(pa2, PK(l2, h2), od, 0, 0, 0);
    od = __builtin_amdgcn_mfma_f32_32x32x16_bf16(pa3, PK(l3, h3), od, 0, 0, 0);
#undef PK
}

template <int KS> __device__ __forceinline__ void v_read8(int vb, s16x4 (&L)[4], s16x4 (&H)[4]) {
    L[0] = tr_read<v_rd_off(0, KS, 0)>(vb); H[0] = tr_read<v_rd_off(0, KS, 1)>(vb); L[1] = tr_read<v_rd_off(1, KS, 0)>(vb); H[1] = tr_read<v_rd_off(1, KS, 1)>(vb);
    L[2] = tr_read<v_rd_off(2, KS, 0)>(vb); H[2] = tr_read<v_rd_off(2, KS, 1)>(vb); L[3] = tr_read<v_rd_off(3, KS, 0)>(vb); H[3] = tr_read<v_rd_off(3, KS, 1)>(vb);
}
#define PKV(L, H) (bf16x8){L[0], L[1], L[2], L[3], H[0], H[1], H[2], H[3]}
__device__ __forceinline__ void pv_mma4(f32x16 (&o)[4], bf16x8 pa, const s16x4 (&L)[4], const s16x4 (&H)[4]) {
    o[0] = __builtin_amdgcn_mfma_f32_32x32x16_bf16(pa, PKV(L[0], H[0]), o[0], 0, 0, 0);
    o[1] = __builtin_amdgcn_mfma_f32_32x32x16_bf16(pa, PKV(L[1], H[1]), o[1], 0, 0, 0);
    o[2] = __builtin_amdgcn_mfma_f32_32x32x16_bf16(pa, PKV(L[2], H[2]), o[2], 0, 0, 0);
    o[3] = __builtin_amdgcn_mfma_f32_32x32x16_bf16(pa, PKV(L[3], H[3]), o[3], 0, 0, 0);
}
__device__ __forceinline__ void pv_all(f32x16 (&o)[4], int vb, bf16x8 pa0, bf16x8 pa1, bf16x8 pa2, bf16x8 pa3) {
    s16x4 LA[4], HA[4], LB[4], HB[4];
    v_read8<0>(vb, LA, HA); v_read8<1>(vb, LB, HB);
    asm volatile("s_waitcnt lgkmcnt(8)" ::: "memory"); SBAR(); pv_mma4(o, pa0, LA, HA); SBAR();
    v_read8<2>(vb, LA, HA);
    asm volatile("s_waitcnt lgkmcnt(8)" ::: "memory"); SBAR(); pv_mma4(o, pa1, LB, HB); SBAR();
    v_read8<3>(vb, LB, HB);
    asm volatile("s_waitcnt lgkmcnt(8)" ::: "memory"); SBAR(); pv_mma4(o, pa2, LA, HA); SBAR();
    asm volatile("s_waitcnt lgkmcnt(0)" ::: "memory"); SBAR(); pv_mma4(o, pa3, LB, HB);
}
#undef PKV
template <int DQK> __device__ __forceinline__ int k_off(int r, int c) { return r * (DQK * 2) + ((c ^ ((r >> 1) & 7)) << 4); }

template <int DQK>
__device__ __forceinline__ void attn_pass(f32x16 (&o)[4], const bf16* __restrict__ Qw, int ldq, const bf16* __restrict__ Kb, int ldk, const bf16* __restrict__ Vb, int ldv, int NT, LAS unsigned char* lds) {
    constexpr int KT = 64 * DQK * 2, NKC = DQK / 8, NKS = (64 * NKC) / NTHR, ND = DQK / 16;
    int tid_ = threadIdx.x; asm volatile("" : "+v"(tid_)); const int tid = tid_, wid = tid >> 6, lane = tid & 63, r32 = lane & 31, hi = lane >> 5;
    LAS unsigned char* V_lds = lds; LAS unsigned char* K_lds = lds + K_OFF;
    LAS float* wsf = (LAS float*)(lds + WS_OFF) + wid * 64;
    constexpr int NDR = ND < 8 ? ND : 8;
    bf16x8 qr[NDR];
#pragma unroll
    for (int d0 = 0; d0 < NDR; ++d0) qr[d0] = *(const bf16x8*)(Qw + (size_t)r32 * ldq + d0 * 16 + hi * 8);
    LAS unsigned char* qpark = lds + QR_OFF + wid * 4096 + lane * 16;
#pragma unroll
    for (int d0 = NDR; d0 < ND; ++d0) *(LAS bf16x8*)(qpark + (d0 - NDR) * 1024) = *(const bf16x8*)(Qw + (size_t)r32 * ldq + d0 * 16 + hi * 8);
    unsigned kgo[NKS]; int klo[NKS];
#pragma unroll
    for (int i = 0; i < NKS; ++i) { const int idx = tid + NTHR * i, r = idx / NKC, c = idx - r * NKC; kgo[i] = (unsigned)(r * ldk + c * 8) * 2u; klo[i] = k_off<DQK>(r, c); }
    const int sr = tid >> 4, sc = (tid & 15) * 8, vst0 = v_st(sr, sc), vst1 = v_st(32 + sr, sc);
    const unsigned vgo0 = (unsigned)(sr * ldv + sc) * 2u, vgo1 = (unsigned)((32 + sr) * ldv + sc) * 2u;
    const int vb0 = (int)(uintptr_t)V_lds + v_rd_base(lane);
    bf16x8 ksA[NKS], vsA0, vsA1, ksB[NKS], vsB0, vsB1;
#define SLOAD(S, k0) do { const char* kt_ = (const char*)(Kb + (size_t)(k0) * ldk); const char* vt_ = (const char*)(Vb + (size_t)(k0) * ldv); \
        _Pragma("unroll") for (int i_ = 0; i_ < NKS; ++i_) ks##S[i_] = *(const bf16x8*)(kt_ + kgo[i_]); \
        vs##S##0 = *(const bf16x8*)(vt_ + vgo0); vs##S##1 = *(const bf16x8*)(vt_ + vgo1); } while (0)
#define SWRITE(S, buf) do { _Pragma("unroll") for (int i_ = 0; i_ < NKS; ++i_) *(LAS bf16x8*)(K_lds + (buf) * KT + klo[i_]) = ks##S[i_]; \
        *(LAS bf16x8*)(V_lds + (buf) * V_TILE + vst0) = vs##S##0; *(LAS bf16x8*)(V_lds + (buf) * V_TILE + vst1) = vs##S##1; } while (0)
    float m_reg = -1e30f, l_reg = 0.f;
#pragma unroll
    for (int d = 0; d < 4; ++d) o[d] = f32x16{};
#define TILE(buf) do { \
        f32x16 p0 = f32x16{}, p1 = f32x16{}; \
        { const LAS unsigned char* Kt = K_lds + (buf) * KT; \
          _Pragma("unroll") for (int d0 = 0; d0 < ND; ++d0) { \
              const bf16x8 b0 = *(const LAS bf16x8*)(Kt + k_off<DQK>(r32, 2 * d0 + hi)), b1 = *(const LAS bf16x8*)(Kt + k_off<DQK>(32 + r32, 2 * d0 + hi)); \
              bf16x8 qf; if (d0 < NDR) qf = qr[d0 < NDR ? d0 : 0]; else qf = *(const LAS bf16x8*)(qpark + (d0 - NDR) * 1024); \
              p0 = __builtin_amdgcn_mfma_f32_32x32x16_bf16(b0, qf, p0, 0, 0, 0); \
              p1 = __builtin_amdgcn_mfma_f32_32x32x16_bf16(b1, qf, p1, 0, 0, 0); } } \
        float pmax = p0[0]; \
        _Pragma("unroll") for (int r = 1; r < 16; ++r) pmax = fmaxf(pmax, p0[r]); \
        _Pragma("unroll") for (int r = 0; r < 16; ++r) pmax = fmaxf(pmax, p1[r]); \
        { auto rr = __builtin_amdgcn_permlane32_swap(__float_as_uint(pmax), __float_as_uint(pmax), false, false); pmax = fmaxf(__uint_as_float(rr[0]), __uint_as_float(rr[1])); } \
        float alpha = 1.f; \
        if (!__all(pmax - m_reg <= THR)) { const float mn = fmaxf(m_reg, pmax); alpha = __builtin_amdgcn_exp2f(m_reg - mn); m_reg = mn; \
            if (hi == 0) wsf[r32] = alpha; asm volatile("s_waitcnt lgkmcnt(0)" ::: "memory"); \
            _Pragma("unroll") for (int r = 0; r < 16; ++r) { const float a = wsf[crow(r, hi)]; \
                _Pragma("unroll") for (int d = 0; d < 4; ++d) o[d][r] *= a; } \
            asm volatile("s_waitcnt lgkmcnt(0)" ::: "memory"); } \
        float ps = 0.f; \
        _Pragma("unroll") for (int r = 0; r < 16; ++r) { p0[r] = __builtin_amdgcn_exp2f(p0[r] - m_reg); p1[r] = __builtin_amdgcn_exp2f(p1[r] - m_reg); ps += p0[r] + p1[r]; } \
        { auto rr = __builtin_amdgcn_permlane32_swap(__float_as_uint(ps), __float_as_uint(ps), false, false); ps = __uint_as_float(rr[0]) + __uint_as_float(rr[1]); } \
        l_reg = l_reg * alpha + ps; \
        bf16x8 pa0, pa1, pa2, pa3; \
        PK4(p0, 0, pa0); PK4(p0, 8, pa1); PK4(p1, 0, pa2); PK4(p1, 8, pa3); \
        SBAR(); \
        { const int vb = vb0 + (buf) * V_TILE; \
          if constexpr (DQK == 64) pv_all(o, vb, pa0, pa1, pa2, pa3); else { pv_one<0>(o[0], vb, pa0, pa1, pa2, pa3); pv_one<1>(o[1], vb, pa0, pa1, pa2, pa3); pv_one<2>(o[2], vb, pa0, pa1, pa2, pa3); pv_one<3>(o[3], vb, pa0, pa1, pa2, pa3); } } \
    } while (0)
#define PK4(P, BASE, OUT) do { unsigned a0 = cvtpk(P[BASE + 0], P[BASE + 1]), a1 = cvtpk(P[BASE + 2], P[BASE + 3]); \
        unsigned b0 = cvtpk(P[BASE + 4], P[BASE + 5]), b1 = cvtpk(P[BASE + 6], P[BASE + 7]); \
        auto r0 = __builtin_amdgcn_permlane32_swap(a0, b0, false, false); auto r1 = __builtin_amdgcn_permlane32_swap(a1, b1, false, false); \
        u32x4 w = {r0[0], r1[0], r0[1], r1[1]}; OUT = __builtin_bit_cast(bf16x8, w); } while (0)
    if constexpr (DQK == 64) {
    SLOAD(A, 0); SLOAD(B, 64); SWRITE(A, 0); __syncthreads();
    for (int j = 0; j < NT; j += 2) {
        { const int t2 = (j + 2 < NT) ? j + 2 : NT - 2; SLOAD(A, t2 * 64); }
        TILE(0);
        SWRITE(B, 1);
        __syncthreads();
        { const int t3 = (j + 3 < NT) ? j + 3 : NT - 1; SLOAD(B, t3 * 64); }
        TILE(1);
        SWRITE(A, 0);
        __syncthreads();
    }
    } else {
    SLOAD(A, 0); SWRITE(A, 0); __syncthreads();
    for (int j = 0; j < NT; j += 2) {
        SLOAD(A, (j + 1) * 64);
        TILE(0);
        SWRITE(A, 1);
        __syncthreads();
        if (j + 2 < NT) SLOAD(A, (j + 2) * 64);
        TILE(1);
        if (j + 2 < NT) SWRITE(A, 0);
        __syncthreads();
    }
    }
#undef PK4
#undef TILE
    if (hi == 0) wsf[32 + r32] = l_reg; asm volatile("s_waitcnt lgkmcnt(0)" ::: "memory");
#pragma unroll
    for (int r = 0; r < 16; ++r) { const float rl = 1.0f / wsf[32 + crow(r, hi)];
#pragma unroll
        for (int d = 0; d < 4; ++d) o[d][r] *= rl; }
    asm volatile("s_waitcnt lgkmcnt(0)" ::: "memory");
#undef SLOAD
#undef SWRITE
}


__device__ __forceinline__ void store_o(const f32x16 (&o)[4], const float (&rs)[16], const float (&gcol)[4], bf16* dst, int ld, LAS unsigned char* lds, int wid, int lane) {
    const int r32 = lane & 31, hi = lane >> 5;
    LAS unsigned short* stg = (LAS unsigned short*)(lds + wid * 8192);
#pragma unroll
    for (int d = 0; d < 4; ++d)
#pragma unroll
        for (int r = 0; r < 16; ++r) stg[crow(r, hi) * 128 + d * 32 + r32] = (unsigned short)(cvtpk(o[d][r] * rs[r] * gcol[d], 0.f) & 0xffffu);
    asm volatile("s_waitcnt lgkmcnt(0)" ::: "memory");
    bf16* p = dst + (size_t)(lane >> 4) * ld + (lane & 15) * 8;
#pragma unroll
    for (int i = 0; i < 8; ++i) { const u32x4 v = *(const LAS u32x4*)(stg + (i * 4 + (lane >> 4)) * 128 + (lane & 15) * 8); *(u32x4*)p = v; p += 4 * (size_t)ld; asm volatile("" : "+v"(p)); }
}

__device__ __forceinline__ void da_unit(const Args& A, const Frame& F, int l, int q0, int k0, int NT, int h) {
    int tid_ = threadIdx.x; asm volatile("" : "+v"(tid_)); const int tid = tid_, wid = tid >> 6, lane = tid & 63, r32 = lane & 31, hi = lane >> 5;
    const bf16* Q = WSP(bf16, WS_QDA); const bf16* K = WSP(bf16, WS_KDA); const bf16* V = WSP(bf16, WS_VDA);
    float* stash = WSP(float, WS_STASH) + ((size_t)blockIdx.x * NTHR + tid) * 64;
    const float lam = WSP(float, WS_SCAL)[l]; const float lam_init = 0.8f - 0.6f * expf(-0.3f * (float)l);
    f32x16 o[4];
    attn_pass<64>(o, Q + (size_t)(q0 + wid * 32) * 768 + (2 * h) * 64, 768, K + (size_t)k0 * 768 + (2 * h) * 64, 768, V + (size_t)k0 * 768 + h * 128, 768, NT, F.lds);
#pragma unroll
    for (int d = 0; d < 4; ++d)
#pragma unroll
        for (int r = 0; r < 16; r += 4) *(f32x4*)(stash + d * 16 + r) = (f32x4){o[d][r], o[d][r + 1], o[d][r + 2], o[d][r + 3]};
    attn_pass<64>(o, Q + (size_t)(q0 + wid * 32) * 768 + (2 * h + 1) * 64, 768, K + (size_t)k0 * 768 + (2 * h + 1) * 64, 768, V + (size_t)k0 * 768 + h * 128, 768, NT, F.lds);
    float ss[16];
#pragma unroll
    for (int r = 0; r < 16; ++r) ss[r] = 0.f;
#pragma unroll
    for (int d = 0; d < 4; ++d) {
#pragma unroll
        for (int r = 0; r < 16; r += 4) { const f32x4 s4 = *(const f32x4*)(stash + d * 16 + r);
#pragma unroll
            for (int e = 0; e < 4; ++e) { const float v = s4[e] - lam * o[d][r + e]; o[d][r + e] = v; ss[r + e] += v * v; } }
        asm volatile("" ::: "memory"); SBAR(); }
#pragma unroll
    for (int r = 0; r < 16; ++r) { float s = ss[r]; s += __shfl_xor(s, 1); s += __shfl_xor(s, 2); s += __shfl_xor(s, 4); s += __shfl_xor(s, 8); s += __shfl_xor(s, 16);
        ss[r] = (1.0f / sqrtf(s * (1.f / 128.f) + EPS)) * (1.f - lam_init); }
    const float* gs = inp<I_GDASUB>() + l * 128;
    float gcol[4];
#pragma unroll
    for (int d = 0; d < 4; ++d) gcol[d] = gs[d * 32 + r32];
    store_o(o, ss, gcol, WSP(bf16, WS_HEADS) + (size_t)(q0 + wid * 32) * DM + h * 128, DM, F.lds, wid, lane);
    __syncthreads();
}
__device__ __forceinline__ void mla_unit(const Args& A, const Frame& F, int q0, int k0, int NT, int h) {
    int tid_ = threadIdx.x; asm volatile("" : "+v"(tid_)); const int tid = tid_, wid = tid >> 6, lane = tid & 63, r32 = lane & 31, hi = lane >> 5;
    f32x16 o[4];
    attn_pass<192>(o, WSP(bf16, WS_QMLA) + (size_t)(q0 + wid * 32) * 1152 + h * 192, 1152, WSP(bf16, WS_KMLA) + (size_t)k0 * 1152 + h * 192, 1152, WSP(bf16, WS_VMLA) + (size_t)k0 * 768 + h * 128, 768, NT, F.lds);
    float rs[16], gcol[4];
#pragma unroll
    for (int r = 0; r < 16; ++r) rs[r] = 1.f;
#pragma unroll
    for (int d = 0; d < 4; ++d) gcol[d] = 1.f;
    store_o(o, rs, gcol, WSP(bf16, WS_HEADS) + (size_t)(q0 + wid * 32) * DM + 1280 + h * 128, DM, F.lds, wid, lane);
    __syncthreads();
}
__device__ __forceinline__ void da_latent(const Args& A, const Frame& F, int l, int v) { const int bh = v >> 3, qb = v & 7, b = bh / 6, h = bh - b * 6; da_unit(A, F, l, b * TOK + CTX + qb * 256, b * TOK, 36, h); }
__device__ __forceinline__ void da_ctx(const Args& A, const Frame& F, int l, int v) { const int b = v / 6, h = v - b * 6; da_unit(A, F, l, b * TOK, b * TOK, 4, h); }
__device__ __forceinline__ void mla_latent(const Args& A, const Frame& F, int v) { const int bh = v >> 3, qb = v & 7, b = bh / 6, h = bh - b * 6; mla_unit(A, F, b * TOK + CTX + qb * 256, b * TOK, 36, h); }
__device__ __forceinline__ void mla_ctx(const Args& A, const Frame& F, int v) { const int b = v / 6, h = v - b * 6; mla_unit(A, F, b * TOK, b * TOK, 4, h); }
__device__ __forceinline__ void mla_phase(const Args& A, const Frame& F, bool with_ctx) {
    const int nun = with_ctx ? 216 : 192;
    for (int un = F.vcu; un < nun; un += F.G) {
        if (un < 192) { const int bh = un >> 3, qb = un & 7, b = bh / 6, h = bh - b * 6; mla_unit(A, F, b * TOK + CTX + qb * 256, b * TOK, 36, h); }
        else { const int v = un - 192, b = v / 6, h = v - b * 6; mla_unit(A, F, b * TOK, b * TOK, 4, h); }
    }
}

__device__ __forceinline__ void gate_unit(const Args& A, const Frame& F, int l, int ch, int g) {
    int tid_ = threadIdx.x; asm volatile("" : "+v"(tid_)); const int tid = tid_, wid = tid >> 6, lane = tid & 63, r32 = lane & 31, hi = lane >> 5;
    const int r0 = ch * 128;
    LAS unsigned char* img = F.lds;
    { const int sc = (tid & 15) * 8; const float* gain = inp<I_GGMV>() + (l * 4 + g) * 128 + sc; const f32x4 g0 = *(const f32x4*)gain, g1 = *(const f32x4*)(gain + 4);
#pragma unroll
      for (int i = 0; i < 4; ++i) { const int q = (tid >> 4) + 32 * i, row = r0 + q;
          const float* src = WSP(float, WS_GV) + (size_t)row * 512 + g * 128 + sc; const f32x4 a = *(const f32x4*)src, b = *(const f32x4*)(src + 4);
          const f32x4 sq = *(const f32x4*)(WSP(float, WS_GVSS) + (size_t)row * 16 + g * 4); const float rs = 1.0f / sqrtf(((sq[0] + sq[1]) + (sq[2] + sq[3])) * (1.f / 128.f) + EPS);
          *(LAS u32x4*)(img + (q >> 6) * V_TILE + v_st(q & 63, sc)) = pack8(a * rs * g0, b * rs * g1); } }
    __syncthreads();
    const int pb = wid & 3, chh = wid >> 2;
    const bf16* Wsg = WSP(bf16, WS_WSP) + ((size_t)(l * 4 + g) * 128 + pb * 32 + r32) * 128 + hi * 8;
    f32x16 acc0 = f32x16{}, acc1 = f32x16{};
    const int vb0 = (int)(uintptr_t)img + v_rd_base(lane);
#pragma unroll
    for (int t = 0; t < 2; ++t) {
        const bf16x8 a0 = *(const bf16x8*)(Wsg + t * 64), a1 = *(const bf16x8*)(Wsg + t * 64 + 16), a2 = *(const bf16x8*)(Wsg + t * 64 + 32), a3 = *(const bf16x8*)(Wsg + t * 64 + 48);
        const int vb = vb0 + t * V_TILE;
        if (chh == 0) { pv_one<0>(acc0, vb, a0, a1, a2, a3); pv_one<1>(acc1, vb, a0, a1, a2, a3); }
        else          { pv_one<2>(acc0, vb, a0, a1, a2, a3); pv_one<3>(acc1, vb, a0, a1, a2, a3); }
    }
    const float* bs = inp<I_BSP>() + (l * 4 + g) * 128 + pb * 32;
    LAS float* mix = (LAS float*)(F.lds + 2 * V_TILE);
#pragma unroll
    for (int r = 0; r < 16; ++r) { const int p = crow(r, hi); const float bias = bs[p]; LAS float* mp = mix + (pb * 32 + p) * 128 + chh * 64 + r32; mp[0] = acc0[r] + bias; mp[32] = acc1[r] + bias; }
    __syncthreads();
    { const int sc = (tid & 15) * 8; const float* up = WSP(float, WS_U) + (size_t)(r0 + (tid >> 4)) * 512 + g * 128 + sc; bf16* hp = WSP(bf16, WS_HEADS) + (size_t)(r0 + (tid >> 4)) * DM + 768 + g * 128 + sc;
#pragma unroll
      for (int i = 0; i < 4; ++i) { const LAS float* mp = mix + ((tid >> 4) + 32 * i) * 128 + sc; const f32x4 m0 = *(const LAS f32x4*)mp, m1 = *(const LAS f32x4*)(mp + 4);
          const f32x4 u0 = *(const f32x4*)up, u1 = *(const f32x4*)(up + 4); *(u32x4*)hp = pack8(u0 * m0, u1 * m1);
          up += 32 * 512; hp += 32 * (size_t)DM; asm volatile("" : "+v"(up), "+v"(hp)); } }
    __syncthreads();
}
#undef SBAR
}

#ifndef MK_SPLIT
#define MK_SPLIT 0
#endif
constexpr int PH_PER_LAYER = 8, PH_FINAL = 2 + PH_PER_LAYER * DEPTH, N_PHASES = PH_FINAL + 1;

__global__ void __launch_bounds__(NTHR, 2) fwd_kernel(Args args) {
    extern __shared__ __attribute__((aligned(16))) unsigned char lds_raw[];
    cg::grid_group grid = cg::this_grid();
    Frame F;
    F.lds = (LAS unsigned char*)lds_raw;
    F.G = gridDim.x; { const int bx = blockIdx.x; F.vcu = (F.G % 8 == 0) ? (bx % 8) * (F.G / 8) + bx / 8 : bx; }
    const Args& A = args;
    F.out = args.out; F.ws = args.ws;
    const int lo = args.ph_lo, hi = args.ph_hi;
#ifndef PH_MASK
#define PH_MASK 0x7ff
#endif
#define PHM(j) (((PH_MASK) >> (j)) & 1)
#ifndef RPT_MASK
#define RPT_MASK 0
#endif
#define NREP(j) ((((RPT_MASK) >> (j)) & 1) ? 2 : 1)
#define IN(k) (lo <= (k) && (k) < hi)
#define SEAM(k) do { if (IN(k) && IN((k) + ((k) == 0 ? 2 : 1))) xcd_barrier(xb); } while (0)
    const float* ropetab = WSP(float, WS_ROPE);
    volatile LAS unsigned* MISC = (volatile LAS unsigned*)(F.lds + 131072);
    if (threadIdx.x < 64) MISC[threadIdx.x] = 0u;
    unsigned* barw = (unsigned*)(F.ws + WS_BAR);
    __syncthreads();
    if (args.ph_lo < 0) grid.sync();
    XcdBarrier xb = xcd_barrier_post(barw, MISC + 8);

    for (int rep_ = 0; rep_ < NREP(0); ++rep_) { if (rep_) xcd_barrier(xb); if (PHM(0) && IN(0)) { p0_prologue(A, F); } } SEAM(0);

    for (int l = 0; l < DEPTH; ++l) {
        const int pb = 2 + PH_PER_LAYER * l; const bool last = (l == DEPTH - 1); const bool first = (l == 0);
        const float* modl = WSP(float, WS_MOD) + (size_t)l * 5 * MODW;
        for (int rep_ = 0; rep_ < NREP(2); ++rep_) { if (rep_) xcd_barrier(xb); if (PHM(2) && IN(pb + 0)) { norm_phase(A, F, l, first ? 1 : 0, inp<I_GMIX>() + l * DM, 0, first ? nullptr : WSP(float, WS_SLAB), false); } } SEAM(pb + 0);
        for (int rep_ = 0; rep_ < NREP(3); ++rep_) { if (rep_) xcd_barrier(xb); if (PHM(3) && IN(pb + 1)) {
            pg8::Gemm g{WSP(bf16, WS_HN), WSP(bf16, WS_WIN) + (size_t)l * NZP * DM, M, NZP, DM, DM}; TileOrder S; S.init(NZP, F.G, (int)blockIdx.x, 0);
            EpiZ E{F.ws, ropetab};
            pg8::gemm_phase<EpiZ, TileOrder, true, true>(F.lds, g, S, E);
            if (DEFER_CONV && !last) {
                const int nun = 36 * (NZP / 256), rem = nun % F.G, nidle = rem ? F.G - rem : F.G, cid = rem ? (int)blockIdx.x - rem : (int)blockIdx.x;
                if (cid >= 0) { __syncthreads(); mod_gemv(A, F, l + 1, cid, nidle); __syncthreads(); }
            }
        } } SEAM(pb + 1);
        for (int rep_ = 0; rep_ < NREP(4); ++rep_) { if (rep_) xcd_barrier(xb); if (PHM(4) && IN(pb + 2)) {
            const bool split = F.G == 256; const int xg = F.vcu >> 5, xl = F.vcu & 31; const bool isaux = !split || xl >= 24;
            const int naux = split ? 64 : F.G, caux = split ? xg * 8 + (xl - 24) : F.vcu, catt = xg * 24 + xl;
            if (!isaux) { att::da_latent(A, F, l, catt); }
            else {
                { pg8::Gemm g{WSP(bf16, WS_CKV), WSP(bf16, WS_WUKV) + (size_t)l * NUKV * RANK, M, NUKV, RANK, RANK}; TileOrder S; S.init(NUKV, naux, split ? (xl - 24) * 8 + xg : caux, 0);
                  EpiKV E{F.ws}; pg8::gemm_phase<EpiKV, TileOrder, true, true>(F.lds, g, S, E); }
                { pg8::Gemm g{WSP(bf16, WS_CQ), WSP(bf16, WS_WUQ) + (size_t)l * NUQP * RANK, M, NUQP, RANK, RANK}; TileOrder S; S.init(NUQP, naux, split ? (xl - 24) * 8 + xg : caux, last ? 1 : 0);
                  EpiQ E{F.ws, ropetab}; pg8::gemm_phase<EpiQ, TileOrder, true, true>(F.lds, g, S, E); }
                for (int un = caux; un < 72 * 4; un += naux) { const int ch = un >> 2, g = un & 3; if (last && (ch % 18) < 2) continue; att::gate_unit(A, F, l, ch, g); }
                if (!last) for (int un = caux; un < 24; un += naux) att::da_ctx(A, F, l, un);
                if (!split) for (int un = caux; un < 192; un += naux) att::da_latent(A, F, l, un);
                if (DEFER_CONV) { __syncthreads(); conv_weights(A, F, l, J_OUT, caux, naux); __syncthreads(); }
            }
        } } SEAM(pb + 2);
        for (int rep_ = 0; rep_ < NREP(5); ++rep_) { if (rep_) xcd_barrier(xb); if (PHM(5) && IN(pb + 3)) {
            const bool split = F.G == 256; const int xg = F.vcu >> 5, xl = F.vcu & 31; const bool isaux = !split || xl >= 24;
            const int naux = split ? 64 : F.G, caux = split ? xg * 8 + (xl - 24) : F.vcu, catt = xg * 24 + xl;
            if (split) { if (!isaux) att::mla_latent(A, F, catt); else if (!last && caux < 24) att::mla_ctx(A, F, caux); }
            else att::mla_phase(A, F, !last);
            if (DEFER_CONV && isaux) { __syncthreads(); conv_weights(A, F, l, last ? (J_FC1 | J_FC2) : J_FC1, caux, naux); __syncthreads(); }
        } } SEAM(pb + 3);
        for (int rep_ = 0; rep_ < NREP(6); ++rep_) { if (rep_) xcd_barrier(xb); if (PHM(6) && IN(pb + 4)) {
            { pg8::Gemm g{WSP(bf16, WS_HEADS), WSP(bf16, WS_WOUT) + (size_t)l * DM * DM, M, DM, DM, DM}; TileOrder S; S.init(DM, F.G, (int)blockIdx.x, 1);
              EpiResid E{F.ws, inp<I_X>(), inp<I_CTX>(), modl + 2 * DM, first, NREP(6) == 2 && rep_ == 0};
              pg8::gemm_phase<EpiResid, TileOrder, true, true>(F.lds, g, S, E); }
            if (!last) {
              pg8::Gemm g{WSP(bf16, WS_HEADS), WSP(bf16, WS_WOUT) + (size_t)l * DM * DM, M, DM, DM / 8, DM}; TileOrder S; S.init(DM, F.G, (int)blockIdx.x, 3, 8, DM / 8);
              EpiSlab E{WSP(float, WS_SLAB), modl + 4 * MODW + 2 * DM};
              pg8::gemm_phase<EpiSlab, TileOrder, true, true>(F.lds, g, S, E); }
        } } SEAM(pb + 4);
        for (int rep_ = 0; rep_ < NREP(7); ++rep_) { if (rep_) xcd_barrier(xb); if (PHM(7) && IN(pb + 5)) { norm_phase(A, F, l, first ? 2 : 0, inp<I_GMLP>() + l * DM, 3 * DM, last ? nullptr : WSP(float, WS_SLAB), last); } } SEAM(pb + 5);
        for (int rep_ = 0; rep_ < NREP(8); ++rep_) { if (rep_) xcd_barrier(xb); if (PHM(8) && IN(pb + 6)) {
            pg8::Gemm g{WSP(bf16, WS_HN), WSP(bf16, WS_WFC1) + (size_t)l * FF * DM, M, FF, DM, DM}; TileOrder S; S.init(FF, F.G, (int)blockIdx.x, last ? 1 : 0);
            EpiFc1 E{F.ws};
            pg8::gemm_phase<EpiFc1, TileOrder, true, true>(F.lds, g, S, E);
            if (DEFER_CONV && !last) {
                const int nun = 36 * (FF / 256), rem = nun % F.G, nidle = rem ? F.G - rem : F.G, cid = rem ? (int)blockIdx.x - rem : (int)blockIdx.x;
                if (cid >= 0) { __syncthreads(); conv_weights(A, F, l, J_FC2, cid, nidle); conv_weights(A, F, l + 1, J_IN | J_UQ | J_UKV, cid, nidle); __syncthreads(); }
            }
        } } SEAM(pb + 6);
        for (int rep_ = 0; rep_ < NREP(9); ++rep_) { if (rep_) xcd_barrier(xb); if (PHM(9) && IN(pb + 7)) {
            { pg8::Gemm g{WSP(bf16, WS_ACT), WSP(bf16, WS_WFC2) + (size_t)l * DM * FF, M, DM, FF, FF}; TileOrder S; S.init(DM, F.G, (int)blockIdx.x, 1);
              EpiResid E{F.ws, inp<I_X>(), inp<I_CTX>(), modl + 5 * DM, false, NREP(9) == 2 && rep_ == 0};
              pg8::gemm_phase<EpiResid, TileOrder, true, true>(F.lds, g, S, E); }
            if (!last) {
              pg8::Gemm g{WSP(bf16, WS_ACT), WSP(bf16, WS_WFC2) + (size_t)l * DM * FF, M, DM, FF / 8, FF}; TileOrder S; S.init(DM, F.G, (int)blockIdx.x, 3, 8, FF / 8);
              EpiSlab E{WSP(float, WS_SLAB), modl + 4 * MODW + 5 * DM};
              pg8::gemm_phase<EpiSlab, TileOrder, true, true>(F.lds, g, S, E); }
        } } SEAM(pb + 7);
    }
    for (int rep_ = 0; rep_ < NREP(10); ++rep_) { if (rep_) xcd_barrier(xb); if (PHM(10) && IN(PH_FINAL)) { final_norm_phase(A, F); } }
#undef IN
#undef SEAM
}

extern "C" void kernel_launch(void* const* d_in, const int* in_sizes, int n_in, void* d_out, int out_size, void* d_ws, size_t ws_size, hipStream_t stream) {
    static int grid = 0;
    if (grid == 0) {
        if (n_in != N_IN || ws_size < WS_END || out_size != NB * SEQ * DM) { fprintf(stderr, "kernel_launch: unexpected shapes: n_in %d ws %zu (need %zu) out %d\n", n_in, ws_size, (size_t)WS_END, out_size); grid = -1; return; }
        int dev = 0, cus = 0, per_cu = 0;
        if (hipGetDevice(&dev) != hipSuccess || hipDeviceGetAttribute(&cus, hipDeviceAttributeMultiprocessorCount, dev) != hipSuccess) { fprintf(stderr, "kernel_launch: device query failed\n"); grid = -1; return; }
        if (hipFuncSetAttribute((const void*)fwd_kernel, hipFuncAttributeMaxDynamicSharedMemorySize, LDS_BYTES) != hipSuccess) { fprintf(stderr, "kernel_launch: hipFuncSetAttribute failed\n"); grid = -1; return; }
        if (hipOccupancyMaxActiveBlocksPerMultiprocessor(&per_cu, (const void*)fwd_kernel, NTHR, LDS_BYTES) != hipSuccess || per_cu < 1) { fprintf(stderr, "kernel_launch: occupancy query says %d blocks/CU\n", per_cu); (void)hipGetLastError(); per_cu = 1; }
        grid = cus * per_cu; if (grid > 256) grid = 256;
        grid -= grid % 8;
        fprintf(stderr, "kernel_launch: cus %d per_cu %d grid %d\n", cus, per_cu, grid);
    }
    if (grid <= 0) return;
    if (hipMemsetAsync((char*)d_ws + WS_BAR, 0, 16384 + (size_t)DEPTH * 5 * MODW * 4, stream) != hipSuccess) { fprintf(stderr, "kernel_launch: memset failed\n"); return; }
    Args a{};
    for (int i = 0; i < N_IN; ++i) a.in[i] = (const float*)d_in[i];
    a.out = (float*)d_out; a.ws = (unsigned char*)d_ws;
#if MK_SPLIT
    for (int p = 0; p < N_PHASES; ++p) {
        a.ph_lo = p; a.ph_hi = p + 1; void* kargs[] = {&a};
        hipError_t e = hipLaunchCooperativeKernel((const void*)fwd_kernel, dim3(grid), dim3(NTHR), kargs, LDS_BYTES, stream);
        if (e != hipSuccess) { fprintf(stderr, "kernel_launch: launch of phase %d failed: %s\n", p, hipGetErrorString(e)); break; }
    }
#else
    a.ph_lo = 0; a.ph_hi = N_PHASES; void* kargs[] = {&a};
    hipError_t e = hipLaunchCooperativeKernel((const void*)fwd_kernel, dim3(grid), dim3(NTHR), kargs, LDS_BYTES, stream);
    if (e != hipSuccess) fprintf(stderr, "kernel_launch: cooperative launch failed: %s (grid %d)\n", hipGetErrorString(e), grid);
#endif
}
```

```cpp
#include <hip/hip_runtime.h>
#include <hip/hip_cooperative_groups.h>
#include <cstdio>
#include <cstdint>
namespace cg = cooperative_groups;
namespace pg8 {
#define PG8_LAS __attribute__((address_space(3)))
typedef unsigned short bf16_t;
typedef short bf16x8 __attribute__((ext_vector_type(8)));
typedef float f32x4 __attribute__((ext_vector_type(4)));
typedef unsigned u32x4 __attribute__((ext_vector_type(4)));
constexpr int BM = 256, BK = 64, HALF = 128, HTB = HALF * BK * 2  , STAGE_BYTES = 8 * HTB, NXCD = 8, WGM = 8;

__host__ __device__ __forceinline__ int lds_byte(int r, int c) { const int st = (r >> 4) * 2 + (c >> 5), rr = r & 15, cc = c & 31, ob = rr * 64 + cc * 2; return st * 1024 + (ob ^ (((ob >> 9) & 1) << 5)); }
__host__ __device__ __forceinline__ void stage_rc(int b, int& R, int& C) { const int st = b / 1024, sb = b % 1024, swz = sb ^ (((sb >> 9) & 1) << 5); R = (st >> 1) * 16 + swz / 64; C = (st & 1) * 32 + (swz % 64) / 2; }
__host__ __device__ __forceinline__ int perm32(int rho) { const int n = rho >> 4, i = rho & 15; return 8 * (i >> 2) + 4 * n + (i & 3); }

struct Unit { int pm, pn, k0, ks; };
struct Gemm { const bf16_t* A; const bf16_t* Bt; int M, N, K, ld; };

__device__ __forceinline__ unsigned cvt_pk_bf16(float lo, float hi) { unsigned r; asm volatile("v_cvt_pk_bf16_f32 %0, %1, %2" : "=v"(r) : "v"(lo), "v"(hi)); return r; }
typedef float f32x2 __attribute__((ext_vector_type(2)));
__device__ __forceinline__ f32x2 gelu_pk(f32x2 v) {
    const f32x2 av = __builtin_elementwise_abs(v), d = av * 0.2316418882f + 1.0f;
    f32x2 t; t.x = __builtin_amdgcn_rcpf(d.x); t.y = __builtin_amdgcn_rcpf(d.y);
    f32x2 q = t * 0.5307027145f + (-0.7265760135f); q = q * t + 0.7107068705f; q = q * t + (-0.142248368f); q = q * t + 0.127414796f; q = q * t;
    const f32x2 s = (v * v) * (-0.72134752044f);
    f32x2 e; e.x = __builtin_amdgcn_exp2f(s.x); e.y = __builtin_amdgcn_exp2f(s.y);
    const f32x2 m = v * (q * e), r = v - m;
    f32x2 o; o.x = v.x < 0.f ? m.x : r.x; o.y = v.y < 0.f ? m.y : r.y; return o;
}
template <class Epi, class Sched, bool ALIGN_EPI = false, bool SP2 = false>
__device__ __forceinline__ void gemm_phase(PG8_LAS unsigned char* lds, const Gemm g, const Sched& S, const Epi& E) {
    int tid_ = threadIdx.x; asm volatile("" : "+v"(tid_)); const int tid = tid_, wid = __builtin_amdgcn_readfirstlane(tid >> 6), lane = tid & 63, wr = wid >> 2, wc = wid & 3, fr = lane & 15, fq = lane >> 4;
    const int K = g.K, nt = K / BK;
    unsigned voffA[2], voffB[2];
#pragma unroll
    for (int i = 0; i < 2; ++i) { int R, C; stage_rc(tid * 16 + i * 8192, R, C); const int Rb = Epi::PERM ? ((R & ~31) + perm32(R & 31)) : R;
        voffA[i] = (unsigned)(R * g.ld + C) * 2u; voffB[i] = (unsigned)(Rb * g.ld + C) * 2u; }
    const size_t kstep = (size_t)(BK * 2);
    const size_t hstep = (size_t)HALF * g.ld * 2;
    const size_t tstep = 2 * hstep;
    const unsigned ldsw = (unsigned)wid * 1024u;
    const int aoff = lds_byte(wr * 64 + fr, fq * 8), boff = lds_byte(wc * 32 + fr, fq * 8);
#define PG8_SA(b, h) (((b) * 2 + (h)) * HTB)
#define PG8_SB(b, h) ((4 + (b) * 2 + (h)) * HTB)
#define PG8_STAGE(bufoff, gbase, voff) do { _Pragma("unroll") for (int _i = 0; _i < 2; ++_i) \
        __builtin_amdgcn_global_load_lds((const unsigned*)((const char*)(gbase) + (voff)[_i]), (PG8_LAS unsigned*)(lds + (bufoff) + ldsw + _i * 8192), 16, 0, 0); } while (0)
#define PG8_LDA(dst, b, h) do { _Pragma("unroll") for (int m = 0; m < 4; ++m) _Pragma("unroll") for (int k = 0; k < 2; ++k) dst[m][k] = *(const PG8_LAS bf16x8*)(lds + PG8_SA(b, h) + aoff + m * 2048 + k * 1024); } while (0)
#define PG8_LDB(dst, b, h) do { _Pragma("unroll") for (int n = 0; n < 2; ++n) _Pragma("unroll") for (int k = 0; k < 2; ++k) dst[n][k] = *(const PG8_LAS bf16x8*)(lds + PG8_SB(b, h) + boff + n * 2048 + k * 1024); } while (0)
#define PG8_MMA(ai, bj, At, Bt) do { __builtin_amdgcn_s_setprio(1); _Pragma("unroll") for (int m = 0; m < 4; ++m) _Pragma("unroll") for (int n = 0; n < 2; ++n) _Pragma("unroll") for (int k = 0; k < 2; ++k) \
        acc[ai][bj][m][n] = __builtin_amdgcn_mfma_f32_16x16x32_bf16(Bt[n][k], At[m][k], acc[ai][bj][m][n], 0, 0, 0); __builtin_amdgcn_s_setprio(0); } while (0)
#define PG8_WAIT_V(n) asm volatile("s_waitcnt vmcnt(" #n ")" ::: "memory")
#define PG8_WAIT_L(n) asm volatile("s_waitcnt lgkmcnt(" #n ")" ::: "memory")
#define PG8_BAR __builtin_amdgcn_s_barrier()
#define PG8_SCHED __builtin_amdgcn_sched_barrier(0)
    Unit cur, nxt; int ui = 0;
    if (!S.next(0, cur)) return;
    f32x4 acc[2][2][4][2];
#pragma unroll
    for (int a = 0; a < 2; ++a)
#pragma unroll
        for (int b = 0; b < 2; ++b)
#pragma unroll
            for (int m = 0; m < 4; ++m)
#pragma unroll
                for (int n = 0; n < 2; ++n) acc[a][b][m][n] = (f32x4){0.f, 0.f, 0.f, 0.f};
    bf16x8 At[4][2], B0[2][2], B1[2][2];
    const char* cA = (const char*)g.A + (size_t)cur.pm * tstep + (size_t)cur.k0 * 2; const char* cB = (const char*)g.Bt + (size_t)cur.pn * tstep + (size_t)cur.k0 * 2;
    S.a_ready(cur);
    if constexpr (SP2) {
        PG8_STAGE(PG8_SB(0, 0), cB, voffB); PG8_STAGE(PG8_SB(0, 1), cB + hstep, voffB); PG8_STAGE(PG8_SA(0, 0), cA, voffA); PG8_STAGE(PG8_SA(0, 1), cA + hstep, voffA);
        if (wr == 1) PG8_BAR;
        PG8_WAIT_V(2); PG8_BAR;
        PG8_STAGE(PG8_SB(1, 0), cB + kstep, voffB); PG8_STAGE(PG8_SA(1, 0), cA + kstep, voffA); PG8_STAGE(PG8_SB(1, 1), cB + hstep + kstep, voffB);
        PG8_WAIT_V(6); PG8_BAR;
    } else {
        PG8_STAGE(PG8_SB(0, 0), cB, voffB); PG8_STAGE(PG8_SA(0, 0), cA, voffA); PG8_STAGE(PG8_SB(0, 1), cB + hstep, voffB); PG8_STAGE(PG8_SA(0, 1), cA + hstep, voffA);
        if (wr == 1) PG8_BAR;
        PG8_WAIT_V(4); PG8_BAR;
        PG8_STAGE(PG8_SB(1, 0), cB + kstep, voffB); PG8_STAGE(PG8_SA(1, 0), cA + kstep, voffA); PG8_STAGE(PG8_SB(1, 1), cB + hstep + kstep, voffB);
        PG8_WAIT_V(6); PG8_BAR;
    }
    for (;;) {
        const bool has_next = S.next(ui + 1, nxt);
        const char* nA = has_next ? (const char*)g.A + (size_t)nxt.pm * tstep + (size_t)nxt.k0 * 2 : cA; const char* nB = has_next ? (const char*)g.Bt + (size_t)nxt.pn * tstep + (size_t)nxt.k0 * 2 : cB;
        for (int t = 0; t < nt; t += 2) {
            const bool last = (t == nt - 2);
            const char* a1 = cA + (size_t)(t + 1) * kstep;
            const char* a2 = last ? nA : cA + (size_t)(t + 2) * kstep; const char* b2 = last ? nB : cB + (size_t)(t + 2) * kstep;
            const char* a3 = a2 + kstep; const char* b3 = b2 + kstep;
            if (last && has_next) S.a_ready(nxt);
            if constexpr (SP2) {
            PG8_LDB(B0, 0, 0); PG8_LDB(B1, 0, 1); PG8_SCHED; PG8_LDA(At, 0, 0); PG8_STAGE(PG8_SA(1, 1), a1 + hstep, voffA);
            PG8_WAIT_V(8); PG8_WAIT_L(0); PG8_BAR; PG8_MMA(0, 0, At, B0); PG8_MMA(0, 1, At, B1); PG8_BAR; PG8_SCHED;
            PG8_LDA(At, 0, 1); PG8_STAGE(PG8_SB(0, 0), b2, voffB); PG8_STAGE(PG8_SB(0, 1), b2 + hstep, voffB); PG8_STAGE(PG8_SA(0, 0), a2, voffA);
            PG8_WAIT_V(8); PG8_WAIT_L(0); PG8_BAR; PG8_MMA(1, 0, At, B0); PG8_MMA(1, 1, At, B1); PG8_BAR; PG8_SCHED;
            PG8_LDB(B0, 1, 0); PG8_LDB(B1, 1, 1); PG8_SCHED; PG8_LDA(At, 1, 0); PG8_STAGE(PG8_SA(0, 1), a2 + hstep, voffA);
            PG8_WAIT_V(8); PG8_WAIT_L(0); PG8_BAR; PG8_MMA(0, 0, At, B0); PG8_MMA(0, 1, At, B1); PG8_BAR; PG8_SCHED;
            PG8_LDA(At, 1, 1); PG8_STAGE(PG8_SB(1, 0), b3, voffB); PG8_STAGE(PG8_SB(1, 1), b3 + hstep, voffB); PG8_STAGE(PG8_SA(1, 0), a3, voffA);
            PG8_WAIT_V(8); PG8_WAIT_L(0); PG8_BAR; PG8_MMA(1, 0, At, B0); PG8_MMA(1, 1, At, B1); PG8_BAR; PG8_SCHED;
            } else {
            PG8_LDB(B0, 0, 0); PG8_SCHED; PG8_LDA(At, 0, 0); PG8_STAGE(PG8_SA(1, 1), a1 + hstep, voffA);
            PG8_WAIT_L(8); PG8_BAR; PG8_WAIT_L(0); PG8_MMA(0, 0, At, B0); PG8_BAR; PG8_SCHED;
            PG8_LDB(B1, 0, 1); PG8_STAGE(PG8_SB(0, 0), b2, voffB);
            PG8_BAR; PG8_WAIT_L(0); PG8_MMA(0, 1, At, B1); PG8_BAR;
            PG8_LDA(At, 0, 1); PG8_STAGE(PG8_SA(0, 0), a2, voffA);
            PG8_BAR; PG8_WAIT_L(0); PG8_MMA(1, 0, At, B0); PG8_BAR; PG8_SCHED;
            PG8_STAGE(PG8_SB(0, 1), b2 + hstep, voffB);
            PG8_WAIT_V(6); PG8_BAR; PG8_MMA(1, 1, At, B1); PG8_BAR;
            PG8_LDB(B0, 1, 0); PG8_SCHED; PG8_LDA(At, 1, 0); PG8_STAGE(PG8_SA(0, 1), a2 + hstep, voffA);
            PG8_WAIT_L(8); PG8_BAR; PG8_WAIT_L(0); PG8_MMA(0, 0, At, B0); PG8_BAR; PG8_SCHED;
            PG8_LDB(B1, 1, 1); PG8_STAGE(PG8_SB(1, 0), b3, voffB);
            PG8_BAR; PG8_WAIT_L(0); PG8_MMA(0, 1, At, B1); PG8_BAR;
            PG8_LDA(At, 1, 1); PG8_STAGE(PG8_SA(1, 0), a3, voffA);
            PG8_BAR; PG8_WAIT_L(0); PG8_MMA(1, 0, At, B0); PG8_BAR; PG8_SCHED;
            PG8_STAGE(PG8_SB(1, 1), b3 + hstep, voffB);
            PG8_WAIT_V(6); PG8_BAR; PG8_MMA(1, 1, At, B1); PG8_BAR;
            }
        }
        if constexpr (ALIGN_EPI) { if (wr == 0) PG8_BAR; }
        if constexpr (!Epi::AFTER_DRAIN) { E(acc, cur, wr, wc, fr, fq); S.done(cur); }
        if (!has_next) break;
#pragma unroll
        for (int a = 0; a < 2; ++a)
#pragma unroll
            for (int b = 0; b < 2; ++b)
#pragma unroll
                for (int m = 0; m < 4; ++m)
#pragma unroll
                    for (int n = 0; n < 2; ++n) acc[a][b][m][n] = (f32x4){0.f, 0.f, 0.f, 0.f};
        cur = nxt; cA = nA; cB = nB; ++ui;
        if constexpr (ALIGN_EPI) { if (wr == 1) PG8_BAR; }
    }
    PG8_WAIT_V(0);
    if constexpr (!ALIGN_EPI) { if (wr == 0) PG8_BAR; }
    PG8_BAR;
    if constexpr (Epi::AFTER_DRAIN) { E.fused(acc, cur, wr, wc, fr, fq, lds, wid, lane); S.done(cur); }
#undef PG8_SA
#undef PG8_SB
#undef PG8_STAGE
#undef PG8_LDA
#undef PG8_LDB
#undef PG8_MMA
#undef PG8_WAIT_V
#undef PG8_WAIT_L
#undef PG8_BAR
#undef PG8_SCHED
}
}

#define GAS __attribute__((address_space(1)))
#define LAS __attribute__((address_space(3)))
typedef unsigned short bf16;
typedef float f32x4 __attribute__((ext_vector_type(4)));
typedef float f32x2 __attribute__((ext_vector_type(2)));
typedef float f32x16 __attribute__((ext_vector_type(16)));
typedef short bf16x8 __attribute__((ext_vector_type(8)));
typedef short s16x4 __attribute__((ext_vector_type(4)));
typedef unsigned u32x4 __attribute__((ext_vector_type(4)));
typedef unsigned u32x2 __attribute__((ext_vector_type(2)));

constexpr int NB = 4, SEQ = 2048, CTX = 256, DM = 2048, DEPTH = 2, FF = 8192;
constexpr int TOK = CTX + SEQ;
constexpr int M = NB * TOK;
constexpr int NZ = 4416, NZP = 4608;
constexpr int NUQ = 1152, NUQP = 1280, NUKV = 1536, RANK = 512;
constexpr int MODW = 6 * DM;
constexpr float EPS = 1e-6f;
constexpr float LOG2E = 1.4426950408889634f;
constexpr float DA_QS = 0.125f * LOG2E;
constexpr float MLA_QS = 0.07216878364870322f * LOG2E;
constexpr int NWAVES = 8, NTHR = 512;

enum { I_X = 0, I_C, I_CTX, I_CCTX, I_WMOD, I_BMOD, I_GMIX, I_GMLP, I_WIN, I_LQ1, I_LK1, I_LQ2, I_LK2, I_GDASUB, I_GGMV, I_WSP, I_BSP,
       I_GMQ, I_WUQ, I_GMKV, I_WUKV, I_WOUT, I_WFC1, I_WFC2, I_GFINAL, N_IN };

constexpr size_t al256(size_t x) { return (x + 255) / 256 * 256; }
constexpr size_t WS_ROPE  = 0;
constexpr size_t WS_SCAL  = WS_ROPE + 8192;
constexpr size_t WS_BAR   = WS_SCAL + 256;
constexpr size_t WS_MOD   = WS_BAR + 16384;
constexpr size_t WS_MODP  = al256(WS_MOD + (size_t)DEPTH * 5 * MODW * 4);
constexpr size_t WS_WIN   = al256(WS_MODP + 256);
constexpr size_t WS_WOUT  = al256(WS_WIN + (size_t)DEPTH * NZP * DM * 2);
constexpr size_t WS_WFC1  = al256(WS_WOUT + (size_t)DEPTH * DM * DM * 2);
constexpr size_t WS_WFC2  = al256(WS_WFC1 + (size_t)DEPTH * FF * DM * 2);
constexpr size_t WS_WUQ   = al256(WS_WFC2 + (size_t)DEPTH * DM * FF * 2);
constexpr size_t WS_WUKV  = al256(WS_WUQ + (size_t)DEPTH * NUQP * RANK * 2);
constexpr size_t WS_WSP   = al256(WS_WUKV + (size_t)DEPTH * NUKV * RANK * 2);
constexpr size_t WS_XW    = al256(WS_WSP + (size_t)DEPTH * 4 * 128 * 128 * 2);
constexpr size_t WS_HN    = al256(WS_XW + (size_t)M * DM * 4);
constexpr size_t WS_QDA   = al256(WS_HN + (size_t)M * DM * 2);
constexpr size_t WS_KDA   = al256(WS_QDA + (size_t)M * 768 * 2);
constexpr size_t WS_VDA   = al256(WS_KDA + (size_t)M * 768 * 2);
constexpr size_t WS_U     = al256(WS_VDA + (size_t)M * 768 * 2);
constexpr size_t WS_GV    = al256(WS_U + (size_t)M * 512 * 4);
constexpr size_t WS_GVSS  = al256(WS_GV + (size_t)M * 512 * 4);
constexpr size_t WS_CQSS  = al256(WS_GVSS + (size_t)M * 16 * 4);
constexpr size_t WS_CKVSS = al256(WS_CQSS + (size_t)M * 8 * 4);
constexpr size_t WS_CQ    = al256(WS_CKVSS + (size_t)M * 8 * 4);
constexpr size_t WS_CKV   = al256(WS_CQ + (size_t)M * 512 * 2);
constexpr size_t WS_KMLA  = al256(WS_CKV + (size_t)M * 512 * 2);
constexpr size_t WS_VMLA  = al256(WS_KMLA + (size_t)M * 1152 * 2);
constexpr size_t WS_QMLA  = al256(WS_VMLA + (size_t)M * 768 * 2);
constexpr size_t WS_HEADS = al256(WS_QMLA + (size_t)M * 1152 * 2);
constexpr size_t WS_ACT   = al256(WS_HEADS + (size_t)M * DM * 2);
constexpr size_t WS_STASH = al256(WS_ACT + (size_t)M * FF * 2);
constexpr size_t WS_SLAB  = al256(WS_STASH + (size_t)256 * 64 * 512 * 4);
constexpr size_t WS_END   = al256(WS_SLAB + (size_t)8 * 1024 * DM * 4);

constexpr int LDS_BYTES = 131072 + 1024;

__device__ __forceinline__ unsigned cvtpk(float lo, float hi) { unsigned r; asm volatile("v_cvt_pk_bf16_f32 %0, %1, %2" : "=v"(r) : "v"(lo), "v"(hi)); return r; }
__device__ __forceinline__ u32x4 pack8(f32x4 a, f32x4 b) { u32x4 w; w.x = cvtpk(a[0], a[1]); w.y = cvtpk(a[2], a[3]); w.z = cvtpk(b[0], b[1]); w.w = cvtpk(b[2], b[3]); return w; }
__device__ __forceinline__ float wave_sum(float v) {
#pragma unroll
    for (int o = 1; o < 64; o <<= 1) v += __shfl_xor(v, o);
    return v;
}
__device__ __forceinline__ float bf2f(unsigned short h) { return __uint_as_float(((unsigned)h) << 16); }

struct Args { const float* in[N_IN]; float* out; unsigned char* ws; int ph_lo, ph_hi; };
struct Frame {
    LAS unsigned char* lds;
    int G, vcu;
    float* out; unsigned char* ws;
};
#define WSP(T, off) ((T*)(F.ws + (off)))
template <int I> __device__ __forceinline__ const float* inp() {
    unsigned long long p; asm volatile("s_load_dwordx2 %0, %1, %2\n\ts_waitcnt lgkmcnt(0)" : "=s"(p) : "s"(__builtin_amdgcn_kernarg_segment_ptr()), "n"(I * 8) : "memory"); return (const float*)p; }

__device__ __forceinline__ const float* xrow_in(const Args& A, const Frame& F, int row) {
    const int b = row / TOK, rr = row - b * TOK;
    return rr < CTX ? inp<I_CTX>() + (size_t)(b * CTX + rr) * DM : inp<I_X>() + (size_t)(b * SEQ + rr - CTX) * DM;
}

__device__ __forceinline__ void p0_transpose_item(const float* W, int K, int N, bf16* WT, const float* kscale, LAS float* scr, int item, int lane) {
    const int nblk = N / 32, kb = item / nblk, nb = item % nblk, k0 = 64 * kb, n0 = 32 * nb;
    { const int r8 = lane >> 3, c4 = (lane & 7) * 4; f32x4 v[8];
#pragma unroll
      for (int i = 0; i < 8; ++i) v[i] = *(const f32x4*)(W + (size_t)(k0 + r8 + 8 * i) * N + n0 + c4);
#pragma unroll
      for (int i = 0; i < 8; ++i) { const int kk = r8 + 8 * i; const float s = kscale ? kscale[k0 + kk] : 1.f; LAS float* d = scr + kk * 33 + c4;
          d[0] = v[i][0] * s; d[1] = v[i][1] * s; d[2] = v[i][2] * s; d[3] = v[i][3] * s; } }
    asm volatile("s_waitcnt lgkmcnt(0)" ::: "memory");
    const int c = lane & 7;
#pragma unroll
    for (int j = 0; j < 4; ++j) { const int n = (lane >> 3) + 8 * j; const LAS float* s = scr + (8 * c) * 33 + n;
        u32x4 o; o.x = cvtpk(s[0 * 33], s[1 * 33]); o.y = cvtpk(s[2 * 33], s[3 * 33]); o.z = cvtpk(s[4 * 33], s[5 * 33]); o.w = cvtpk(s[6 * 33], s[7 * 33]);
        *(u32x4*)(WT + (size_t)(n0 + n) * K + k0 + 8 * c) = o; }
    asm volatile("s_waitcnt lgkmcnt(0)" ::: "memory");
}
__device__ __forceinline__ float silu_f(float x) { return x / (1.f + __expf(-x)); }

__device__ __forceinline__ void p0_mod_item(const Args& A, const Frame& F, LAS float* scr, int l, int item, int lane) {
    const int kc = item / 48, nc = item % 48;
    const int k = kc * 64 + lane;
#pragma unroll
    for (int bb = 0; bb < 5; ++bb) { const float cv = bb < 4 ? inp<I_C>()[bb * DM + k] : inp<I_CCTX>()[k]; scr[bb * 64 + lane] = silu_f(cv); }
    asm volatile("s_waitcnt lgkmcnt(0)" ::: "memory");
    const float* W = inp<I_WMOD>() + ((size_t)l * DM + kc * 64) * MODW + nc * 256 + lane * 4;
    f32x4 acc[5];
#pragma unroll
    for (int bb = 0; bb < 5; ++bb) acc[bb] = (f32x4){0.f, 0.f, 0.f, 0.f};
#pragma unroll 8
    for (int kk = 0; kk < 64; ++kk) { const f32x4 w = *(const f32x4*)(W + (size_t)kk * MODW);
#pragma unroll
        for (int bb = 0; bb < 5; ++bb) acc[bb] += w * scr[bb * 64 + kk]; }
    if (kc == 0) { const f32x4 bv = *(const f32x4*)(inp<I_BMOD>() + l * MODW + nc * 256 + lane * 4);
#pragma unroll
        for (int bb = 0; bb < 5; ++bb) acc[bb] += bv; }
    LAS float* t = scr + 512;
    float* Mo = WSP(float, WS_MOD) + (size_t)l * 5 * MODW + nc * 256 + lane;
#pragma unroll
    for (int bb = 0; bb < 5; ++bb) {
        *(LAS f32x4*)(t + lane * 4) = acc[bb]; asm volatile("s_waitcnt lgkmcnt(0)" ::: "memory");
#pragma unroll
        for (int e = 0; e < 4; ++e) { const float v = t[e * 64 + lane]; __hip_atomic_fetch_add(Mo + (size_t)bb * MODW + e * 64, v, __ATOMIC_RELAXED, __HIP_MEMORY_SCOPE_AGENT); }
        asm volatile("s_waitcnt lgkmcnt(0)" ::: "memory");
    }
}
__device__ __forceinline__ void mod_gemv(const Args& A, const Frame& F, int l, int wcu, int ncu) {
    int tid_ = threadIdx.x; asm volatile("" : "+v"(tid_)); const int ptid = tid_, plane = ptid & 63, pwave = __builtin_amdgcn_readfirstlane(ptid >> 6);
    LAS float* scr = (LAS float*)(F.lds + pwave * 16384);
    for (int it = wcu * NWAVES + pwave; it < 32 * 48; it += ncu * NWAVES) p0_mod_item(A, F, scr, l, it, plane);
}

enum { J_IN = 1, J_OUT = 2, J_FC1 = 4, J_FC2 = 8, J_UQ = 16, J_UKV = 32 };
__device__ __forceinline__ void conv_weights(const Args& A, const Frame& F, int l, int jobs, int wcu, int ncu, int shift = 0) {
    int tid_ = threadIdx.x; asm volatile("" : "+v"(tid_)); const int ptid = tid_, plane = ptid & 63, pwave = __builtin_amdgcn_readfirstlane(ptid >> 6);
    LAS float* scr = (LAS float*)(F.lds + pwave * 16384);
    const int NGW = ncu * NWAVES, gw = (wcu * NWAVES + pwave + NGW - (shift % NGW)) % NGW;
    constexpr int T_IN = (DM / 64) * (NZ / 32), T_OUT = (DM / 64) * (DM / 32), T_FC1 = (DM / 64) * (FF / 32), T_FC2 = (FF / 64) * (DM / 32), T_UQ = (RANK / 64) * (NUQ / 32), T_UKV = (RANK / 64) * (NUKV / 32);
    const int n_in = (jobs & J_IN) ? T_IN : 0, n_out = (jobs & J_OUT) ? T_OUT : 0, n_fc1 = (jobs & J_FC1) ? T_FC1 : 0, n_fc2 = (jobs & J_FC2) ? T_FC2 : 0, n_uq = (jobs & J_UQ) ? T_UQ : 0, n_ukv = (jobs & J_UKV) ? T_UKV : 0;
    const int total = n_in + n_out + n_fc1 + n_fc2 + n_uq + n_ukv;
    for (int it = gw; it < total; it += NGW) {
        int r = it;
        if (r < n_in)  { p0_transpose_item(inp<I_WIN>() + (size_t)l * DM * NZ, DM, NZ, WSP(bf16, WS_WIN) + (size_t)l * NZP * DM, nullptr, scr, r, plane); continue; } r -= n_in;
        if (r < n_out) { p0_transpose_item(inp<I_WOUT>() + (size_t)l * DM * DM, DM, DM, WSP(bf16, WS_WOUT) + (size_t)l * DM * DM, nullptr, scr, r, plane); continue; } r -= n_out;
        if (r < n_fc1) { p0_transpose_item(inp<I_WFC1>() + (size_t)l * DM * FF, DM, FF, WSP(bf16, WS_WFC1) + (size_t)l * FF * DM, nullptr, scr, r, plane); continue; } r -= n_fc1;
        if (r < n_fc2) { p0_transpose_item(inp<I_WFC2>() + (size_t)l * FF * DM, FF, DM, WSP(bf16, WS_WFC2) + (size_t)l * DM * FF, nullptr, scr, r, plane); continue; } r -= n_fc2;
        if (r < n_uq)  { p0_transpose_item(inp<I_WUQ>() + (size_t)l * RANK * NUQ, RANK, NUQ, WSP(bf16, WS_WUQ) + (size_t)l * NUQP * RANK, inp<I_GMQ>() + l * RANK, scr, r, plane); continue; } r -= n_uq;
        p0_transpose_item(inp<I_WUKV>() + (size_t)l * RANK * NUKV, RANK, NUKV, WSP(bf16, WS_WUKV) + (size_t)l * NUKV * RANK, inp<I_GMKV>() + l * RANK, scr, r, plane);
    }
}
#ifndef DEFER_CONV
#define DEFER_CONV 1
#endif
__device__ __forceinline__ void p0_prologue(const Args& A, const Frame& F) {
    int tid_ = threadIdx.x; asm volatile("" : "+v"(tid_)); const int ptid = tid_, plane = ptid & 63, pwave = __builtin_amdgcn_readfirstlane(ptid >> 6);
    LAS float* scr = (LAS float*)(F.lds + pwave * 16384);
    const int gw = F.vcu * NWAVES + pwave, NGW = F.G * NWAVES;
    constexpr int I_MOD = 32 * 48;
    mod_gemv(A, F, 0, F.vcu, F.G);
    if (!DEFER_CONV) for (int l = 1; l < DEPTH; ++l) mod_gemv(A, F, l, F.vcu, F.G);
    if (DEFER_CONV) conv_weights(A, F, 0, J_IN | J_UQ | J_UKV, F.vcu, F.G, I_MOD);
    else for (int l = 0; l < DEPTH; ++l) conv_weights(A, F, l, J_IN | J_OUT | J_FC1 | J_FC2 | J_UQ | J_UKV, F.vcu, F.G, I_MOD);
    const int gt = F.vcu * NTHR + ptid, NGT = F.G * NTHR;
    for (int i = gt; i < DEPTH * (NZP - NZ) * DM / 8; i += NGT) { const int l = i / ((NZP - NZ) * DM / 8), r = i % ((NZP - NZ) * DM / 8);
        *(u32x4*)(WSP(bf16, WS_WIN) + ((size_t)l * NZP + NZ) * DM + (size_t)r * 8) = (u32x4){0u, 0u, 0u, 0u}; }
    for (int i = gt; i < DEPTH * (NUQP - NUQ) * RANK / 8; i += NGT) { const int l = i / ((NUQP - NUQ) * RANK / 8), r = i % ((NUQP - NUQ) * RANK / 8);
        *(u32x4*)(WSP(bf16, WS_WUQ) + ((size_t)l * NUQP + NUQ) * RANK + (size_t)r * 8) = (u32x4){0u, 0u, 0u, 0u}; }
    for (int i = gt; i < DEPTH * 4 * 128 * 128 / 8; i += NGT) { const f32x4 a = *(const f32x4*)(inp<I_WSP>() + (size_t)i * 8), b = *(const f32x4*)(inp<I_WSP>() + (size_t)i * 8 + 4);
        *(u32x4*)(WSP(bf16, WS_WSP) + (size_t)i * 8) = pack8(a, b); }
    if (gt < 64 * 16) { const int pos = gt >> 4, f = gt & 15; const float inv = powf(10000.0f, -(float)f / 16.0f); const float ang = (float)pos * inv;
        WSP(float, WS_ROPE)[gt] = cosf(ang); WSP(float, WS_ROPE)[1024 + gt] = sinf(ang); }
    if (gt < 64 * DEPTH) {
        const int l = gt >> 6; const float a = inp<I_LQ1>()[l * 64 + plane] * inp<I_LK1>()[l * 64 + plane], b = inp<I_LQ2>()[l * 64 + plane] * inp<I_LK2>()[l * 64 + plane];
        const float sa = wave_sum(a), sb = wave_sum(b); const float lam_init = 0.8f - 0.6f * expf(-0.3f * (float)l);
        if (plane == 0) WSP(float, WS_SCAL)[l] = expf(sa) - expf(sb) + lam_init;
    }
}
__device__ __forceinline__ void norm_phase(const Args& A, const Frame& F, int l, int src_mode, const float* g, int shoff, const float* slab, bool skip_ctx) {
    int tid_ = threadIdx.x; asm volatile("" : "+v"(tid_)); const int ptid = tid_, plane = ptid & 63, pwave = __builtin_amdgcn_readfirstlane(ptid >> 6);
    const int gw = F.vcu * NWAVES + pwave, NGW = F.G * NWAVES;
    for (int row = gw; row < M; row += NGW) {
        const int b = row / TOK, rr = row - b * TOK; const bool isctx = rr < CTX; const int bsel = isctx ? 4 : b;
        if (isctx && skip_ctx) continue;
        const bool from_in = src_mode == 1 || (src_mode == 2 && isctx);
        const float* xr = from_in ? xrow_in(A, F, row) : WSP(float, WS_XW) + (size_t)row * DM;
        const float* md = WSP(float, WS_MOD) + ((size_t)l * 5 + bsel) * MODW + shoff;
        f32x4 v[8]; float s = 0.f;
#pragma unroll
        for (int j = 0; j < 8; ++j) v[j] = *(const f32x4*)(xr + 4 * plane + 256 * j);
        if (isctx && slab) {
            const float* sp = slab + (size_t)(b * CTX + rr) * DM + 4 * plane;
            for (int ks = 0; ks < 8; ++ks) {
#pragma unroll
                for (int j = 0; j < 8; ++j) v[j] += *(const f32x4*)(sp + (size_t)ks * 1024 * DM + 256 * j); }
            float* xo = WSP(float, WS_XW) + (size_t)row * DM + 4 * plane;
#pragma unroll
            for (int j = 0; j < 8; ++j) *(f32x4*)(xo + 256 * j) = v[j];
        }
#pragma unroll
        for (int j = 0; j < 8; ++j) s += (v[j].x * v[j].x + v[j].y * v[j].y) + (v[j].z * v[j].z + v[j].w * v[j].w);
        const float rstd = 1.0f / sqrtf(wave_sum(s) * (1.f / DM) + EPS);
        bf16* o = WSP(bf16, WS_HN) + (size_t)row * DM;
#pragma unroll
        for (int j = 0; j < 8; ++j) { const int c = 4 * plane + 256 * j; const f32x4 gg = *(const f32x4*)(g + c), sh = *(const f32x4*)(md + c), sc = *(const f32x4*)(md + DM + c);
            const f32x4 y = (v[j] * rstd) * gg * (sc + 1.0f) + sh; u32x2 w; w.x = cvtpk(y.x, y.y); w.y = cvtpk(y.z, y.w); *(u32x2*)(o + c) = w; }
    }
}
__device__ __forceinline__ void final_norm_phase(const Args& A, const Frame& F) {
    int tid_ = threadIdx.x; asm volatile("" : "+v"(tid_)); const int ptid = tid_, plane = ptid & 63, pwave = __builtin_amdgcn_readfirstlane(ptid >> 6);
    const int gw = F.vcu * NWAVES + pwave, NGW = F.G * NWAVES; const float* g = inp<I_GFINAL>();
    for (int r = gw; r < NB * SEQ; r += NGW) {
        const int b = r / SEQ, t = r - b * SEQ; const float* xr = WSP(float, WS_XW) + (size_t)(b * TOK + CTX + t) * DM;
        f32x4 v[8]; float s = 0.f;
#pragma unroll
        for (int j = 0; j < 8; ++j) { v[j] = *(const f32x4*)(xr + 4 * plane + 256 * j); s += (v[j].x * v[j].x + v[j].y * v[j].y) + (v[j].z * v[j].z + v[j].w * v[j].w); }
        const float rstd = 1.0f / sqrtf(wave_sum(s) * (1.f / DM) + EPS);
        float* o = F.out + (size_t)r * DM;
#pragma unroll
        for (int j = 0; j < 8; ++j) { const int c = 4 * plane + 256 * j; const f32x4 gg = *(const f32x4*)(g + c); *(f32x4*)(o + c) = (v[j] * rstd) * gg; }
    }
}

struct TileOrder {
    int nM, nN, nwg, G, c, mode, nsplit, kslice;
    __device__ void init(int N, int G_, int c_, int mode_, int nsplit_ = 1, int kslice_ = 0) { mode = mode_; nsplit = nsplit_; kslice = kslice_; nM = mode_ == 0 ? 36 : (mode_ == 1 ? 32 : 4); nN = N / 256; nwg = nM * nN * nsplit_; G = G_; c = c_; }
    __device__ bool next(int i, pg8::Unit& u) const {
        const long L = (long)i * G + c; if (L >= nwg) return false;
        int wgid = (int)L; { const int q = nwg / 8, r = nwg % 8, xcd = wgid % 8, off = wgid / 8; wgid = (xcd < r ? xcd * (q + 1) : r * (q + 1) + (xcd - r) * q) + off; }
        if (mode == 3) {
            const int per = 4 * nN, ks = wgid / per, rem = wgid - ks * per; u.ks = ks; u.k0 = ks * kslice; u.pn = rem >> 2; u.pm = (rem & 3) * 9; return true; }
        const int nig = 8 * nN, gid = wgid / nig, fm = gid * 8, gsz = (nM - fm) < 8 ? (nM - fm) : 8;
        int pm = fm + ((wgid % nig) % gsz); u.pn = (wgid % nig) / gsz;
        if (mode == 1) pm = (pm >> 3) * 9 + 1 + (pm & 7); else if (mode == 2) pm = pm * 9;
        u.pm = pm; u.k0 = 0; u.ks = 0; return true;
    }
    __device__ __forceinline__ void a_ready(const pg8::Unit&) const {}
    __device__ __forceinline__ void done(const pg8::Unit&) const {}
};

__device__ __forceinline__ void rope8(f32x4& v0, f32x4& v1, const float* ropetab, int pos, int f0) {
    const f32x4 c = *(const f32x4*)(ropetab + pos * 16 + f0), s = *(const f32x4*)(ropetab + 1024 + pos * 16 + f0);
    const f32x4 a = v0, b = v1;
    v0[0] = a[0] * c[0] - a[1] * s[0]; v0[1] = a[0] * s[0] + a[1] * c[0]; v0[2] = a[2] * c[1] - a[3] * s[1]; v0[3] = a[2] * s[1] + a[3] * c[1];
    v1[0] = b[0] * c[2] - b[1] * s[2]; v1[1] = b[0] * s[2] + b[1] * c[2]; v1[2] = b[2] * c[3] - b[3] * s[3]; v1[3] = b[2] * s[3] + b[3] * c[3];
}
__device__ __forceinline__ f32x4 gelu4(f32x4 v) { const f32x2 a = pg8::gelu_pk((f32x2){v[0], v[1]}), b = pg8::gelu_pk((f32x2){v[2], v[3]}); return (f32x4){a.x, a.y, b.x, b.y}; }
__device__ __forceinline__ float ss8(f32x4 a, f32x4 b) { return (a[0] * a[0] + a[1] * a[1]) + (a[2] * a[2] + a[3] * a[3]) + (b[0] * b[0] + b[1] * b[1]) + (b[2] * b[2] + b[3] * b[3]); }

struct EpiZ {
    static constexpr bool PERM = true, AFTER_DRAIN = false;
    unsigned char* ws; const float* ropetab;
    __device__ __forceinline__ void operator()(const f32x4 (&acc)[2][2][4][2], const pg8::Unit& u, int wr, int wc, int fr_, int fq_) const {
        int fr = fr_, fq = fq_; asm volatile("" : "+v"(fr), "+v"(fq));
        const int pn = u.pn;
#pragma unroll
        for (int ai = 0; ai < 2; ++ai)
#pragma unroll
            for (int m = 0; m < 4; ++m) {
                const int row = u.pm * 256 + ai * 128 + wr * 64 + m * 16 + fr;
                const int b = row / TOK, rr = row - b * TOK; const bool lat = rr >= CTX; const int t = rr - CTX, prow = (t >> 6) & 31, pcol = t & 63;
                float ssq = 0.f;
#pragma unroll
                for (int bj = 0; bj < 2; ++bj) {
                    const int colt = bj * 128 + wc * 32 + 8 * fq;
                    f32x4 v0 = acc[ai][bj][m][0], v1 = acc[ai][bj][m][1];
                    if (pn < 6) {
                        if (lat) { const int j0 = (colt & 63) >> 1; rope8(v0, v1, ropetab, j0 < 16 ? prow : pcol, j0 & 15); }
                        if (pn < 3) { v0 *= DA_QS; v1 *= DA_QS; *(u32x4*)((bf16*)(ws + WS_QDA) + (size_t)row * 768 + pn * 256 + colt) = pack8(v0, v1); }
                        else *(u32x4*)((bf16*)(ws + WS_KDA) + (size_t)row * 768 + (pn - 3) * 256 + colt) = pack8(v0, v1);
                    } else if (pn < 9) {
                        *(u32x4*)((bf16*)(ws + WS_VDA) + (size_t)row * 768 + (pn - 6) * 256 + colt) = pack8(v0, v1);
                    } else if (pn < 11) {
                        float* o = (float*)(ws + WS_U) + (size_t)row * 512 + (pn - 9) * 256 + colt; *(f32x4*)o = gelu4(v0); *(f32x4*)(o + 4) = gelu4(v1);
                    } else if (pn < 13) {
                        v0 = gelu4(v0); v1 = gelu4(v1);
                        float* o = (float*)(ws + WS_GV) + (size_t)row * 512 + (pn - 11) * 256 + colt; *(f32x4*)o = v0; *(f32x4*)(o + 4) = v1;
                        float s = ss8(v0, v1); s += __shfl_xor(s, 16); s += __shfl_xor(s, 32);
                        if (fq == 0) ((float*)(ws + WS_GVSS))[(size_t)row * 16 + ((pn - 11) * 2 + bj) * 4 + wc] = s;
                    } else if (pn < 15) {
                        *(u32x4*)((bf16*)(ws + WS_CQ) + (size_t)row * 512 + (pn - 13) * 256 + colt) = pack8(v0, v1); ssq += ss8(v0, v1);
                    } else if (pn < 17) {
                        *(u32x4*)((bf16*)(ws + WS_CKV) + (size_t)row * 512 + (pn - 15) * 256 + colt) = pack8(v0, v1); ssq += ss8(v0, v1);
                    } else {
                        if (colt < 64) {
                            if (lat) { const int j0 = colt >> 1; rope8(v0, v1, ropetab, j0 < 16 ? prow : pcol, j0 & 15); }
                            const u32x4 w = pack8(v0, v1); bf16* o = (bf16*)(ws + WS_KMLA) + (size_t)row * 1152 + 128 + colt;
#pragma unroll
                            for (int h = 0; h < 6; ++h) *(u32x4*)(o + h * 192) = w;
                        }
                    }
                }
                if (pn >= 13 && pn < 17) {
                    ssq += __shfl_xor(ssq, 16); ssq += __shfl_xor(ssq, 32);
                    if (fq == 0) { if (pn < 15) ((float*)(ws + WS_CQSS))[(size_t)row * 8 + (pn - 13) * 4 + wc] = ssq; else ((float*)(ws + WS_CKVSS))[(size_t)row * 8 + (pn - 15) * 4 + wc] = ssq; }
                }
            }
    }
};
__device__ __forceinline__ float rstd8(const float* p, float inv_n) { const f32x4 a = *(const f32x4*)p, b = *(const f32x4*)(p + 4); return 1.0f / sqrtf(((a[0] + a[1]) + (a[2] + a[3]) + (b[0] + b[1]) + (b[2] + b[3])) * inv_n + EPS); }

struct EpiKV {
    static constexpr bool PERM = true, AFTER_DRAIN = false;
    unsigned char* ws;
    __device__ __forceinline__ void operator()(const f32x4 (&acc)[2][2][4][2], const pg8::Unit& u, int wr, int wc, int fr_, int fq_) const {
        int fr = fr_, fq = fq_; asm volatile("" : "+v"(fr), "+v"(fq));
#pragma unroll
        for (int ai = 0; ai < 2; ++ai)
#pragma unroll
            for (int m = 0; m < 4; ++m) {
                const int row = u.pm * 256 + ai * 128 + wr * 64 + m * 16 + fr;
                const float rs = rstd8((const float*)(ws + WS_CKVSS) + (size_t)row * 8, 1.f / RANK);
                const int c = wc * 32 + 8 * fq;
                *(u32x4*)((bf16*)(ws + WS_KMLA) + (size_t)row * 1152 + u.pn * 192 + c) = pack8(acc[ai][0][m][0] * rs, acc[ai][0][m][1] * rs);
                *(u32x4*)((bf16*)(ws + WS_VMLA) + (size_t)row * 768 + u.pn * 128 + c) = pack8(acc[ai][1][m][0] * rs, acc[ai][1][m][1] * rs);
            }
    }
};
struct EpiQ {
    static constexpr bool PERM = true, AFTER_DRAIN = false;
    unsigned char* ws; const float* ropetab;
    __device__ __forceinline__ void operator()(const f32x4 (&acc)[2][2][4][2], const pg8::Unit& u, int wr, int wc, int fr_, int fq_) const {
        int fr = fr_, fq = fq_; asm volatile("" : "+v"(fr), "+v"(fq));
#pragma unroll
        for (int ai = 0; ai < 2; ++ai)
#pragma unroll
            for (int m = 0; m < 4; ++m) {
                const int row = u.pm * 256 + ai * 128 + wr * 64 + m * 16 + fr;
                const int b = row / TOK, rr = row - b * TOK; const bool lat = rr >= CTX; const int t = rr - CTX, prow = (t >> 6) & 31, pcol = t & 63;
                const float rs = rstd8((const float*)(ws + WS_CQSS) + (size_t)row * 8, 1.f / RANK) * MLA_QS;
#pragma unroll
                for (int bj = 0; bj < 2; ++bj) {
                    const int col = u.pn * 256 + bj * 128 + wc * 32 + 8 * fq;
                    if (col < NUQ) {
                        f32x4 v0 = acc[ai][bj][m][0] * rs, v1 = acc[ai][bj][m][1] * rs;
                        const int hd = col / 192, i = col - hd * 192;
                        if (lat && i >= 128) { const int j0 = (i - 128) >> 1; rope8(v0, v1, ropetab, j0 < 16 ? prow : pcol, j0 & 15); }
                        *(u32x4*)((bf16*)(ws + WS_QMLA) + (size_t)row * 1152 + col) = pack8(v0, v1);
                    }
                }
            }
    }
};
struct EpiResid {
    static constexpr bool PERM = true, AFTER_DRAIN = false;
    unsigned char* ws; const float* xin; const float* cin; const float* gate; bool from_inputs; bool dry = false;
    __device__ __forceinline__ void operator()(const f32x4 (&acc)[2][2][4][2], const pg8::Unit& u, int wr, int wc, int fr_, int fq_) const {
        int fr = fr_, fq = fq_; asm volatile("" : "+v"(fr), "+v"(fq));
        const int b = u.pm / 9; const bool isctx = (u.pm - b * 9) == 0; const int bsel = isctx ? 4 : b;
        const int c0 = u.pn * 256 + wc * 32 + 8 * fq;
        const float* gp = gate + (size_t)bsel * MODW + c0;
        const int row0 = u.pm * 256 + wr * 64 + fr, rr0 = row0 - b * TOK;
        const float* bp = (from_inputs ? (isctx ? cin + (size_t)(b * CTX + rr0) * DM : xin + (size_t)(b * SEQ + rr0 - CTX) * DM) : (const float*)(ws + WS_XW) + (size_t)row0 * DM) + c0;
        float* op = (float*)(ws + (dry ? WS_QDA : WS_XW)) + (size_t)row0 * DM + c0;
        f32x4 g[2][2];
#pragma unroll
        for (int bj = 0; bj < 2; ++bj) { g[bj][0] = *(const f32x4*)(gp + bj * 128); g[bj][1] = *(const f32x4*)(gp + bj * 128 + 4); }
#pragma unroll
        for (int ai = 0; ai < 2; ++ai)
#pragma unroll
            for (int m = 0; m < 4; ++m) {
#pragma unroll
                for (int bj = 0; bj < 2; ++bj) {
                    const f32x4 b0 = *(const f32x4*)(bp + bj * 128), b1 = *(const f32x4*)(bp + bj * 128 + 4);
                    *(f32x4*)(op + bj * 128) = b0 + g[bj][0] * acc[ai][bj][m][0]; *(f32x4*)(op + bj * 128 + 4) = b1 + g[bj][1] * acc[ai][bj][m][1]; }
                const int adv = (m == 3 ? 80 : 16) * DM; bp += adv; op += adv; asm volatile("" : "+v"(bp), "+v"(op));
            }
    }
};
struct EpiSlab {
    static constexpr bool PERM = true, AFTER_DRAIN = false;
    float* slab; const float* gate;
    __device__ __forceinline__ void operator()(const f32x4 (&acc)[2][2][4][2], const pg8::Unit& u, int wr, int wc, int fr_, int fq_) const {
        int fr = fr_, fq = fq_; asm volatile("" : "+v"(fr), "+v"(fq));
        const int b = u.pm / 9; const int c0 = u.pn * 256 + wc * 32 + 8 * fq; const float* gp = gate + c0;
        float* op = slab + ((size_t)u.ks * 1024 + b * CTX + wr * 64 + fr) * DM + c0;
        f32x4 g[2][2];
#pragma unroll
        for (int bj = 0; bj < 2; ++bj) { g[bj][0] = *(const f32x4*)(gp + bj * 128); g[bj][1] = *(const f32x4*)(gp + bj * 128 + 4); }
#pragma unroll
        for (int ai = 0; ai < 2; ++ai)
#pragma unroll
            for (int m = 0; m < 4; ++m) {
#pragma unroll
                for (int bj = 0; bj < 2; ++bj) { *(f32x4*)(op + bj * 128) = g[bj][0] * acc[ai][bj][m][0]; *(f32x4*)(op + bj * 128 + 4) = g[bj][1] * acc[ai][bj][m][1]; }
                op += (m == 3 ? 80 : 16) * DM; asm volatile("" : "+v"(op));
            }
    }
};
struct EpiFc1 {
    static constexpr bool PERM = true, AFTER_DRAIN = false;
    unsigned char* ws;
    __device__ __forceinline__ void operator()(const f32x4 (&acc)[2][2][4][2], const pg8::Unit& u, int wr, int wc, int fr_, int fq_) const {
        int fr = fr_, fq = fq_; asm volatile("" : "+v"(fr), "+v"(fq));
#pragma unroll
        for (int ai = 0; ai < 2; ++ai)
#pragma unroll
            for (int m = 0; m < 4; ++m) {
                const int row = u.pm * 256 + ai * 128 + wr * 64 + m * 16 + fr;
#pragma unroll
                for (int bj = 0; bj < 2; ++bj) { const int c = u.pn * 256 + bj * 128 + wc * 32 + 8 * fq;
                    f32x4 v0 = __builtin_elementwise_max(acc[ai][bj][m][0], (f32x4){0.f, 0.f, 0.f, 0.f}), v1 = __builtin_elementwise_max(acc[ai][bj][m][1], (f32x4){0.f, 0.f, 0.f, 0.f});
                    *(u32x4*)((bf16*)(ws + WS_ACT) + (size_t)row * FF + c) = pack8(v0 * v0, v1 * v1); }
            }
    }
};
#define XB_TMO      128
#define XB_XCNT(j)  (256  + 64 * (j))
#define XB_XSUB(j)  (1280 + 64 * (j))
#define XB_XGEN(j)  (2304 + 64 * (j))
#define XB_TOP      3328
#define XB_TOPGEN   3392
#define XCD_BAR_WORDS 3456
#define XB_SPIN_CAP (1u << 18)

__device__ __forceinline__ unsigned xb_ld(unsigned* p)              { return __hip_atomic_load(p, __ATOMIC_RELAXED, __HIP_MEMORY_SCOPE_AGENT); }
__device__ __forceinline__ unsigned xb_add(unsigned* p, unsigned v) { return __hip_atomic_fetch_add(p, v, __ATOMIC_RELAXED, __HIP_MEMORY_SCOPE_AGENT); }
__device__ __forceinline__ unsigned xb_xcc_id() { return (unsigned)__builtin_amdgcn_s_getreg((3 << 11) | 20) & 0xFu; }
#define XB_SPIN(cond, bar) do { unsigned _sp = 0; while (cond) { __builtin_amdgcn_s_sleep(1); \
    if ((++_sp & 255u) == 0u) { if (xb_ld(&(bar)[XB_TMO])) break; if (_sp > XB_SPIN_CAP) { atomicAdd(&(bar)[XB_TMO], 1u); break; } } } } while (0)

struct XcdBarrier {
    unsigned* bar; unsigned x;
    volatile LAS unsigned* st;
};

__device__ __forceinline__ XcdBarrier xcd_barrier_post(unsigned* bar, volatile LAS unsigned* st) {
    XcdBarrier b; b.bar = bar; b.x = xb_xcc_id(); b.st = st;
    if (threadIdx.x == 0) (void)xb_add(&bar[XB_XCNT(b.x)], 1u);
    return b;
}
__device__ __forceinline__ void xcd_barrier_complete(unsigned* bar, unsigned x, unsigned& nloc, unsigned& nx) {
    const unsigned G = gridDim.x * gridDim.y * gridDim.z;
    unsigned sum, cnt, mine, sp = 0u;
    for (;;) {
        sum = 0u; cnt = 0u; mine = 0u;
#pragma unroll
        for (unsigned j = 0; j < 16; ++j) { const unsigned c = xb_ld(&bar[XB_XCNT(j)]); sum += c; cnt += (c > 0u) ? 1u : 0u; mine = (j == x) ? c : mine; }
        if (sum == G) break;
        __builtin_amdgcn_s_sleep(1);
        if ((++sp & 255u) == 0u) { if (xb_ld(&bar[XB_TMO])) break; if (sp > XB_SPIN_CAP) { atomicAdd(&bar[XB_TMO], 1u); break; } }
    }
    nloc = mine > 0u ? mine : 1u; nx = cnt > 0u ? cnt : 1u;
}

__device__ __forceinline__ void xcd_barrier(const XcdBarrier& b) {
    asm volatile("s_waitcnt vmcnt(0)" ::: "memory");
    __syncthreads();
    if (threadIdx.x == 0) {
        unsigned* bar = b.bar;
        __builtin_amdgcn_s_waitcnt(0);
        unsigned nloc = b.st[0], nx = b.st[1];
        if (nloc == 0u) { xcd_barrier_complete(bar, b.x, nloc, nx); b.st[0] = nloc; b.st[1] = nx; }
        const unsigned old = xb_add(&bar[XB_XSUB(b.x)], 1u);
        const unsigned gen = old / nloc;
        if (old + 1u == (gen + 1u) * nloc) {
            __builtin_amdgcn_fence(__ATOMIC_RELEASE, "agent");
            asm volatile("s_waitcnt vmcnt(0)" ::: "memory");
            const unsigned og = xb_add(&bar[XB_TOP], 1u);
            const unsigned tg = og / nx;
            if (og + 1u == (tg + 1u) * nx) xb_add(&bar[XB_TOPGEN], 1u);
            else XB_SPIN(xb_ld(&bar[XB_TOPGEN]) == tg, bar);
            __builtin_amdgcn_fence(__ATOMIC_ACQUIRE, "agent");
            xb_add(&bar[XB_XGEN(b.x)], 1u);
            asm volatile("s_waitcnt vmcnt(0)" ::: "memory");
        } else {
            XB_SPIN(xb_ld(&bar[XB_XGEN(b.x)]) == gen, bar);
            __builtin_amdgcn_fence(__ATOMIC_ACQUIRE, "agent");
            asm volatile("s_waitcnt vmcnt(0)" ::: "memory");
        }
    }
    __syncthreads();
}

namespace att {
#define SBAR() __builtin_amdgcn_sched_barrier(0)
constexpr int V_TILE = 64 * 128 * 2, K_OFF = 2 * V_TILE, K_TILE_MAX = 64 * 192 * 2, WS_OFF = K_OFF + 2 * K_TILE_MAX;
constexpr int QR_OFF = WS_OFF + 2048;
constexpr float THR = 6.0f;
__device__ __forceinline__ int crow(int r, int hi) { return (r & 3) + 8 * (r >> 2) + 4 * hi; }
__device__ __forceinline__ int v_st(int k, int c) { const int kk = (k & ~0xC) | ((k & 4) << 1) | ((k & 8) >> 1); return ((kk >> 3) * 4 + (c >> 5)) * 512 + ((kk & 7) * 32 + (c & 31)) * 2; }
__device__ __forceinline__ int v_rd_base(int lane) { return ((lane & 3) << 3) | (((lane >> 2) & 3) << 6) | (((lane >> 4) & 1) << 5) | (((lane >> 5) & 1) << 8); }
constexpr int v_rd_off(int d0, int ks, int half) { return d0 * 512 + ks * 4096 + half * 2048; }
template <int OFF> __device__ __forceinline__ s16x4 tr_read(int vb) { s16x4 r; asm volatile("ds_read_b64_tr_b16 %0, %1 offset:%2" : "=&v"(r) : "v"(vb), "i"(OFF) : "memory"); return r; }
template <int D0> __device__ __forceinline__ void pv_one(f32x16& od, int vb, bf16x8 pa0, bf16x8 pa1, bf16x8 pa2, bf16x8 pa3) {
    const s16x4 l0 = tr_read<v_rd_off(D0, 0, 0)>(vb), h0 = tr_read<v_rd_off(D0, 0, 1)>(vb), l1 = tr_read<v_rd_off(D0, 1, 0)>(vb), h1 = tr_read<v_rd_off(D0, 1, 1)>(vb);
    const s16x4 l2 = tr_read<v_rd_off(D0, 2, 0)>(vb), h2 = tr_read<v_rd_off(D0, 2, 1)>(vb), l3 = tr_read<v_rd_off(D0, 3, 0)>(vb), h3 = tr_read<v_rd_off(D0, 3, 1)>(vb);
    asm volatile("s_waitcnt lgkmcnt(0)" ::: "memory"); SBAR();
#define PK(L, H) (bf16x8){L[0], L[1], L[2], L[3], H[0], H[1], H[2], H[3]}
    od = __builtin_amdgcn_mfma_f32_32x32x16_bf16(pa0, PK(l0, h0), od, 0, 0, 0);
    od = __builtin_amdgcn_mfma_f32_32x32x16_bf16(pa1, PK(l1, h1), od, 0, 0, 0);
    od = __builtin_amdgcn_mfma_f32_32x32x16_bf16(pa2, PK(l2, h2), od, 0, 0, 0);
    od = __builtin_amdgcn_mfma_f32_32x32x16_bf16(pa3, PK(l3, h3), od, 0, 0, 0);
#undef PK
}

template <int KS> __device__ __forceinline__ void v_read8(int vb, s16x4 (&L)[4], s16x4 (&H)[4]) {
    L[0] = tr_read<v_rd_off(0, KS, 0)>(vb); H[0] = tr_read<v_rd_off(0, KS, 1)>(vb); L[1] = tr_read<v_rd_off(1, KS, 0)>(vb); H[1] = tr_read<v_rd_off(1, KS, 1)>(vb);
    L[2] = tr_read<v_rd_off(2, KS, 0)>(vb); H[2] = tr_read<v_rd_off(2, KS, 1)>(vb); L[3] = tr_read<v_rd_off(3, KS, 0)>(vb); H[3] = tr_read<v_rd_off(3, KS, 1)>(vb);
}
#define PKV(L, H) (bf16x8){L[0], L[1], L[2], L[3], H[0], H[1], H[2], H[3]}
__device__ __forceinline__ void pv_mma4(f32x16 (&o)[4], bf16x8 pa, const s16x4 (&L)[4], const s16x4 (&H)[4]) {
    o[0] = __builtin_amdgcn_mfma_f32_32x32x16_bf16(pa, PKV(L[0], H[0]), o[0], 0, 0, 0);
    o[1] = __builtin_amdgcn_mfma_f32_32x32x16_bf16(pa, PKV(L[1], H[1]), o[1], 0, 0, 0);
    o[2] = __builtin_amdgcn_mfma_f32_32x32x16_bf16(pa, PKV(L[2], H[2]), o[2], 0, 0, 0);
    o[3] = __builtin_amdgcn_mfma_f32_32x32x16_bf16(pa, PKV(L[3], H[3]), o[3], 0, 0, 0);
}
__device__ __forceinline__ void pv_all(f32x16 (&o)[4], int vb, bf16x8 pa0, bf16x8 pa1, bf16x8 pa2, bf16x8 pa3) {
    s16x4 LA[4], HA[4], LB[4], HB[4];
    v_read8<0>(vb, LA, HA); v_read8<1>(vb, LB, HB);
    asm volatile("s_waitcnt lgkmcnt(8)" ::: "memory"); SBAR(); pv_mma4(o, pa0, LA, HA); SBAR();
    v_read8<2>(vb, LA, HA);
    asm volatile("s_waitcnt lgkmcnt(8)" ::: "memory"); SBAR(); pv_mma4(o, pa1, LB, HB); SBAR();
    v_read8<3>(vb, LB, HB);
    asm volatile("s_waitcnt lgkmcnt(8)" ::: "memory"); SBAR(); pv_mma4(o, pa2, LA, HA); SBAR();
    asm volatile("s_waitcnt lgkmcnt(0)" ::: "memory"); SBAR(); pv_mma4(o, pa3, LB, HB);
}
#undef PKV
template <int DQK> __device__ __forceinline__ int k_off(int r, int c) { return r * (DQK * 2) + ((c ^ ((r >> 1) & 7)) << 4); }

template <int DQK>
__device__ __forceinline__ void attn_pass(f32x16 (&o)[4], const bf16* __restrict__ Qw, int ldq, const bf16* __restrict__ Kb, int ldk, const bf16* __restrict__ Vb, int ldv, int NT, LAS unsigned char* lds) {
    constexpr int KT = 64 * DQK * 2, NKC = DQK / 8, NKS = (64 * NKC) / NTHR, ND = DQK / 16;
    int tid_ = threadIdx.x; asm volatile("" : "+v"(tid_)); const int tid = tid_, wid = tid >> 6, lane = tid & 63, r32 = lane & 31, hi = lane >> 5;
    LAS unsigned char* V_lds = lds; LAS unsigned char* K_lds = lds + K_OFF;
    LAS float* wsf = (LAS float*)(lds + WS_OFF) + wid * 64;
    constexpr int NDR = ND < 8 ? ND : 8;
    bf16x8 qr[NDR];
#pragma unroll
    for (int d0 = 0; d0 < NDR; ++d0) qr[d0] = *(const bf16x8*)(Qw + (size_t)r32 * ldq + d0 * 16 + hi * 8);
    LAS unsigned char* qpark = lds + QR_OFF + wid * 4096 + lane * 16;
#pragma unroll
    for (int d0 = NDR; d0 < ND; ++d0) *(LAS bf16x8*)(qpark + (d0 - NDR) * 1024) = *(const bf16x8*)(Qw + (size_t)r32 * ldq + d0 * 16 + hi * 8);
    unsigned kgo[NKS]; int klo[NKS];
#pragma unroll
    for (int i = 0; i < NKS; ++i) { const int idx = tid + NTHR * i, r = idx / NKC, c = idx - r * NKC; kgo[i] = (unsigned)(r * ldk + c * 8) * 2u; klo[i] = k_off<DQK>(r, c); }
    const int sr = tid >> 4, sc = (tid & 15) * 8, vst0 = v_st(sr, sc), vst1 = v_st(32 + sr, sc);
    const unsigned vgo0 = (unsigned)(sr * ldv + sc) * 2u, vgo1 = (unsigned)((32 + sr) * ldv + sc) * 2u;
    const int vb0 = (int)(uintptr_t)V_lds + v_rd_base(lane);
    bf16x8 ksA[NKS], vsA0, vsA1, ksB[NKS], vsB0, vsB1;
#define SLOAD(S, k0) do { const char* kt_ = (const char*)(Kb + (size_t)(k0) * ldk); const char* vt_ = (const char*)(Vb + (size_t)(k0) * ldv); \
        _Pragma("unroll") for (int i_ = 0; i_ < NKS; ++i_) ks##S[i_] = *(const bf16x8*)(kt_ + kgo[i_]); \
        vs##S##0 = *(const bf16x8*)(vt_ + vgo0); vs##S##1 = *(const bf16x8*)(vt_ + vgo1); } while (0)
#define SWRITE(S, buf) do { _Pragma("unroll") for (int i_ = 0; i_ < NKS; ++i_) *(LAS bf16x8*)(K_lds + (buf) * KT + klo[i_]) = ks##S[i_]; \
        *(LAS bf16x8*)(V_lds + (buf) * V_TILE + vst0) = vs##S##0; *(LAS bf16x8*)(V_lds + (buf) * V_TILE + vst1) = vs##S##1; } while (0)
    float m_reg = -1e30f, l_reg = 0.f;
#pragma unroll
    for (int d = 0; d < 4; ++d) o[d] = f32x16{};
#define TILE(buf) do { \
        f32x16 p0 = f32x16{}, p1 = f32x16{}; \
        { const LAS unsigned char* Kt = K_lds + (buf) * KT; \
          _Pragma("unroll") for (int d0 = 0; d0 < ND; ++d0) { \
              const bf16x8 b0 = *(const LAS bf16x8*)(Kt + k_off<DQK>(r32, 2 * d0 + hi)), b1 = *(const LAS bf16x8*)(Kt + k_off<DQK>(32 + r32, 2 * d0 + hi)); \
              bf16x8 qf; if (d0 < NDR) qf = qr[d0 < NDR ? d0 : 0]; else qf = *(const LAS bf16x8*)(qpark + (d0 - NDR) * 1024); \
              p0 = __builtin_amdgcn_mfma_f32_32x32x16_bf16(b0, qf, p0, 0, 0, 0); \
              p1 = __builtin_amdgcn_mfma_f32_32x32x16_bf16(b1, qf, p1, 0, 0, 0); } } \
        float pmax = p0[0]; \
        _Pragma("unroll") for (int r = 1; r < 16; ++r) pmax = fmaxf(pmax, p0[r]); \
        _Pragma("unroll") for (int r = 0; r < 16; ++r) pmax = fmaxf(pmax, p1[r]); \
        { auto rr = __builtin_amdgcn_permlane32_swap(__float_as_uint(pmax), __float_as_uint(pmax), false, false); pmax = fmaxf(__uint_as_float(rr[0]), __uint_as_float(rr[1])); } \
        float alpha = 1.f; \
        if (!__all(pmax - m_reg <= THR)) { const float mn = fmaxf(m_reg, pmax); alpha = __builtin_amdgcn_exp2f(m_reg - mn); m_reg = mn; \
            if (hi == 0) wsf[r32] = alpha; asm volatile("s_waitcnt lgkmcnt(0)" ::: "memory"); \
            _Pragma("unroll") for (int r = 0; r < 16; ++r) { const float a = wsf[crow(r, hi)]; \
                _Pragma("unroll") for (int d = 0; d < 4; ++d) o[d][r] *= a; } \
            asm volatile("s_waitcnt lgkmcnt(0)" ::: "memory"); } \
        float ps = 0.f; \
        _Pragma("unroll") for (int r = 0; r < 16; ++r) { p0[r] = __builtin_amdgcn_exp2f(p0[r] - m_reg); p1[r] = __builtin_amdgcn_exp2f(p1[r] - m_reg); ps += p0[r] + p1[r]; } \
        { auto rr = __builtin_amdgcn_permlane32_swap(__float_as_uint(ps), __float_as_uint(ps), false, false); ps = __uint_as_float(rr[0]) + __uint_as_float(rr[1]); } \
        l_reg = l_reg * alpha + ps; \
        bf16x8 pa0, pa1, pa2, pa3; \
        PK4(p0, 0, pa0); PK4(p0, 8, pa1); PK4(p1, 0, pa2); PK4(p1, 8, pa3); \
        SBAR(); \
        { const int vb = vb0 + (buf) * V_TILE; \
          if constexpr (DQK == 64) pv_all(o, vb, pa0, pa1, pa2, pa3); else { pv_one<0>(o[0], vb, pa0, pa1, pa2, pa3); pv_one<1>(o[1], vb, pa0, pa1, pa2, pa3); pv_one<2>(o[2], vb, pa0, pa1, pa2, pa3); pv_one<3>(o[3], vb, pa0, pa1, pa2, pa3); } } \
    } while (0)
#define PK4(P, BASE, OUT) do { unsigned a0 = cvtpk(P[BASE + 0], P[BASE + 1]), a1 = cvtpk(P[BASE + 2], P[BASE + 3]); \
        unsigned b0 = cvtpk(P[BASE + 4], P[BASE + 5]), b1 = cvtpk(P[BASE + 6], P[BASE + 7]); \
        auto r0 = __builtin_amdgcn_permlane32_swap(a0, b0, false, false); auto r1 = __builtin_amdgcn_permlane32_swap(a1, b1, false, false); \
        u32x4 w = {r0[0], r1[0], r0[1], r1[1]}; OUT = __builtin_bit_cast(bf16x8, w); } while (0)
    if constexpr (DQK == 64) {
    SLOAD(A, 0); SLOAD(B, 64); SWRITE(A, 0); __syncthreads();
    for (int j = 0; j < NT; j += 2) {
        { const int t2 = (j + 2 < NT) ? j + 2 : NT - 2; SLOAD(A, t2 * 64); }
        TILE(0);
        SWRITE(B, 1);
        __syncthreads();
        { const int t3 = (j + 3 < NT) ? j + 3 : NT - 1; SLOAD(B, t3 * 64); }
        TILE(1);
        SWRITE(A, 0);
        __syncthreads();
    }
    } else {
    SLOAD(A, 0); SWRITE(A, 0); __syncthreads();
    for (int j = 0; j < NT; j += 2) {
        SLOAD(A, (j + 1) * 64);
        TILE(0);
        SWRITE(A, 1);
        __syncthreads();
        if (j + 2 < NT) SLOAD(A, (j + 2) * 64);
        TILE(1);
        if (j + 2 < NT) SWRITE(A, 0);
        __syncthreads();
    }
    }
#undef PK4
#undef TILE
    if (hi == 0) wsf[32 + r32] = l_reg; asm volatile("s_waitcnt lgkmcnt(0)" ::: "memory");
#pragma unroll
    for (int r = 0; r < 16; ++r) { const float rl = 1.0f / wsf[32 + crow(r, hi)];
#pragma unroll
        for (int d = 0; d < 4; ++d) o[d][r] *= rl; }
    asm volatile("s_waitcnt lgkmcnt(0)" ::: "memory");
#undef SLOAD
#undef SWRITE
}


__device__ __forceinline__ void attn_pass64(f32x16 (&o)[4], const bf16* __restrict__ Qw, int ldq, const bf16* __restrict__ Kb, int ldk, const bf16* __restrict__ Vb, int ldv, int NT, LAS unsigned char* lds) {
    constexpr int KT = 64 * 64 * 2;
    int tid_ = threadIdx.x; asm volatile("" : "+v"(tid_)); const int tid = tid_, wid = tid >> 6, lane = tid & 63, r32 = lane & 31, hi = lane >> 5;
    LAS unsigned char* V_lds = lds; LAS unsigned char* K_lds = lds + K_OFF;
    LAS float* wsf = (LAS float*)(lds + WS_OFF) + wid * 64;
    bf16x8 qr[4];
#pragma unroll
    for (int d0 = 0; d0 < 4; ++d0) qr[d0] = *(const bf16x8*)(Qw + (size_t)r32 * ldq + d0 * 16 + hi * 8);
    const int kr_ = tid >> 3, kc_ = tid & 7; const unsigned kgo = (unsigned)(kr_ * ldk + kc_ * 8) * 2u; const int klo = k_off<64>(kr_, kc_);
    const int sr = tid >> 4, sc = (tid & 15) * 8, vst0 = v_st(sr, sc), vst1 = v_st(32 + sr, sc);
    const unsigned vgo0 = (unsigned)(sr * ldv + sc) * 2u, vgo1 = (unsigned)((32 + sr) * ldv + sc) * 2u;
    const int vb0 = (int)(uintptr_t)V_lds + v_rd_base(lane);
    bf16x8 ksE, vsE0, vsE1, ksO, vsO0, vsO1;
#define SLOAD(S, k0) do { const char* kt_ = (const char*)(Kb + (size_t)(k0) * ldk); const char* vt_ = (const char*)(Vb + (size_t)(k0) * ldv); \
        ks##S = *(const bf16x8*)(kt_ + kgo); vs##S##0 = *(const bf16x8*)(vt_ + vgo0); vs##S##1 = *(const bf16x8*)(vt_ + vgo1); } while (0)
#define SWRITE(S, buf) do { *(LAS bf16x8*)(K_lds + (buf) * KT + klo) = ks##S; *(LAS bf16x8*)(V_lds + (buf) * V_TILE + vst0) = vs##S##0; *(LAS bf16x8*)(V_lds + (buf) * V_TILE + vst1) = vs##S##1; } while (0)
#define QKT(P0, P1, buf) do { const LAS unsigned char* Kt = K_lds + (buf) * KT; P0 = f32x16{}; P1 = f32x16{}; \
        _Pragma("unroll") for (int d0 = 0; d0 < 4; ++d0) { \
            const bf16x8 b0 = *(const LAS bf16x8*)(Kt + k_off<64>(r32, 2 * d0 + hi)), b1 = *(const LAS bf16x8*)(Kt + k_off<64>(32 + r32, 2 * d0 + hi)); \
            P0 = __builtin_amdgcn_mfma_f32_32x32x16_bf16(b0, qr[d0], P0, 0, 0, 0); P1 = __builtin_amdgcn_mfma_f32_32x32x16_bf16(b1, qr[d0], P1, 0, 0, 0); } } while (0)
#define PARTSM(P0, P1, AL) do { float pmax = P0[0]; \
        _Pragma("unroll") for (int r = 1; r < 16; ++r) pmax = fmaxf(pmax, P0[r]); \
        _Pragma("unroll") for (int r = 0; r < 16; ++r) pmax = fmaxf(pmax, P1[r]); \
        { auto rr = __builtin_amdgcn_permlane32_swap(__float_as_uint(pmax), __float_as_uint(pmax), false, false); pmax = fmaxf(__uint_as_float(rr[0]), __uint_as_float(rr[1])); } \
        if (__builtin_expect(__all(pmax - m_reg <= THR), 1)) { AL = 1.f; } else { const float mn = fmaxf(m_reg, pmax); AL = __builtin_amdgcn_exp2f(m_reg - mn); m_reg = mn; } \
        _Pragma("unroll") for (int r = 0; r < 16; ++r) { P0[r] -= m_reg; P1[r] -= m_reg; } \
        _Pragma("unroll") for (int r = 0; r < 16; ++r) P0[r] = __builtin_amdgcn_exp2f(P0[r]); } while (0)
#define PK4(P, BASE, OUT) do { unsigned a0 = cvtpk(P[BASE + 0], P[BASE + 1]), a1 = cvtpk(P[BASE + 2], P[BASE + 3]); \
        unsigned b0 = cvtpk(P[BASE + 4], P[BASE + 5]), b1 = cvtpk(P[BASE + 6], P[BASE + 7]); \
        auto r0 = __builtin_amdgcn_permlane32_swap(a0, b0, false, false); auto r1 = __builtin_amdgcn_permlane32_swap(a1, b1, false, false); \
        u32x4 w = {r0[0], r1[0], r0[1], r1[1]}; OUT = __builtin_bit_cast(bf16x8, w); } while (0)
#define FINSM(P0, P1, AL) do { \
        _Pragma("unroll") for (int r = 0; r < 16; ++r) P1[r] = __builtin_amdgcn_exp2f(P1[r]); \
        float ps = 0.f; _Pragma("unroll") for (int r = 0; r < 16; ++r) ps += P0[r]; _Pragma("unroll") for (int r = 0; r < 16; ++r) ps += P1[r]; \
        { auto rr = __builtin_amdgcn_permlane32_swap(__float_as_uint(ps), __float_as_uint(ps), false, false); ps = __uint_as_float(rr[0]) + __uint_as_float(rr[1]); } \
        l_reg = l_reg * AL + ps; PK4(P0, 0, pa0); PK4(P0, 8, pa1); PK4(P1, 0, pa2); PK4(P1, 8, pa3); } while (0)
#define RESC(AL) do { if (__any((AL) < 1.f)) { if (hi == 0) wsf[r32] = (AL); asm volatile("s_waitcnt lgkmcnt(0)" ::: "memory"); \
        _Pragma("unroll") for (int r = 0; r < 16; ++r) { const float a = wsf[crow(r, hi)]; _Pragma("unroll") for (int d = 0; d < 4; ++d) o[d][r] *= a; } \
        asm volatile("s_waitcnt lgkmcnt(0)" ::: "memory"); } } while (0)
    float m_reg = -1e30f, l_reg = 0.f;
#pragma unroll
    for (int d = 0; d < 4; ++d) o[d] = f32x16{};
    f32x16 pA0, pA1, pB0, pB1; float alA, alB; bf16x8 pa0, pa1, pa2, pa3;
    SLOAD(E, 0); SLOAD(O, 64); SWRITE(E, 0); __syncthreads();
    QKT(pA0, pA1, 0); PARTSM(pA0, pA1, alA);
    SLOAD(E, 128);
    SWRITE(O, 1); __syncthreads();
    RESC(alA);
    for (int j = 1; j + 1 < NT; j += 2) {
        SBAR(); QKT(pB0, pB1, 1);
        FINSM(pA0, pA1, alA); SBAR();
        { const int t = (j + 2 < NT) ? j + 2 : NT - 1; SLOAD(O, t * 64); } SBAR();
        pv_all(o, vb0, pa0, pa1, pa2, pa3); PARTSM(pB0, pB1, alB);
        __syncthreads(); SWRITE(E, 0);
        RESC(alB); __syncthreads();
        SBAR(); QKT(pA0, pA1, 0);
        FINSM(pB0, pB1, alB); SBAR();
        { const int t = (j + 3 < NT) ? j + 3 : NT - 2; SLOAD(E, t * 64); } SBAR();
        pv_all(o, vb0 + V_TILE, pa0, pa1, pa2, pa3); PARTSM(pA0, pA1, alA);
        __syncthreads(); if (j + 2 < NT) SWRITE(O, 1);
        RESC(alA); __syncthreads();
    }
    SBAR(); QKT(pB0, pB1, 1);
    FINSM(pA0, pA1, alA); SBAR();
    pv_all(o, vb0, pa0, pa1, pa2, pa3); PARTSM(pB0, pB1, alB);
    RESC(alB);
    FINSM(pB0, pB1, alB); SBAR();
    pv_all(o, vb0 + V_TILE, pa0, pa1, pa2, pa3);
    __syncthreads();
    if (hi == 0) wsf[32 + r32] = l_reg; asm volatile("s_waitcnt lgkmcnt(0)" ::: "memory");
#pragma unroll
    for (int r = 0; r < 16; ++r) { const float rl = 1.0f / wsf[32 + crow(r, hi)];
#pragma unroll
        for (int d = 0; d < 4; ++d) o[d][r] *= rl; }
    asm volatile("s_waitcnt lgkmcnt(0)" ::: "memory");
#undef SLOAD
#undef SWRITE
#undef QKT
#undef PARTSM
#undef PK4
#undef FINSM
#undef RESC
}

__device__ __forceinline__ void store_o(const f32x16 (&o)[4], const float (&rs)[16], const float (&gcol)[4], bf16* dst, int ld, LAS unsigned char* lds, int wid, int lane) {
    const int r32 = lane & 31, hi = lane >> 5;
    LAS unsigned short* stg = (LAS unsigned short*)(lds + wid * 8192);
#pragma unroll
    for (int d = 0; d < 4; ++d)
#pragma unroll
        for (int r = 0; r < 16; ++r) stg[crow(r, hi) * 128 + d * 32 + r32] = (unsigned short)(cvtpk(o[d][r] * rs[r] * gcol[d], 0.f) & 0xffffu);
    asm volatile("s_waitcnt lgkmcnt(0)" ::: "memory");
    bf16* p = dst + (size_t)(lane >> 4) * ld + (lane & 15) * 8;
#pragma unroll
    for (int i = 0; i < 8; ++i) { const u32x4 v = *(const LAS u32x4*)(stg + (i * 4 + (lane >> 4)) * 128 + (lane & 15) * 8); *(u32x4*)p = v; p += 4 * (size_t)ld; asm volatile("" : "+v"(p)); }
}

__device__ __forceinline__ void da_unit(const Args& A, const Frame& F, int l, int q0, int k0, int NT, int h) {
    int tid_ = threadIdx.x; asm volatile("" : "+v"(tid_)); const int tid = tid_, wid = tid >> 6, lane = tid & 63, r32 = lane & 31, hi = lane >> 5;
    const bf16* Q = WSP(bf16, WS_QDA); const bf16* K = WSP(bf16, WS_KDA); const bf16* V = WSP(bf16, WS_VDA);
    float* stash = WSP(float, WS_STASH) + ((size_t)blockIdx.x * NTHR + tid) * 64;
    const float lam = WSP(float, WS_SCAL)[l]; const float lam_init = 0.8f - 0.6f * expf(-0.3f * (float)l);
    f32x16 o[4];
    attn_pass64(o, Q + (size_t)(q0 + wid * 32) * 768 + (2 * h) * 64, 768, K + (size_t)k0 * 768 + (2 * h) * 64, 768, V + (size_t)k0 * 768 + h * 128, 768, NT, F.lds);
#pragma unroll
    for (int d = 0; d < 4; ++d)
#pragma unroll
        for (int r = 0; r < 16; r += 4) *(f32x4*)(stash + d * 16 + r) = (f32x4){o[d][r], o[d][r + 1], o[d][r + 2], o[d][r + 3]};
    attn_pass64(o, Q + (size_t)(q0 + wid * 32) * 768 + (2 * h + 1) * 64, 768, K + (size_t)k0 * 768 + (2 * h + 1) * 64, 768, V + (size_t)k0 * 768 + h * 128, 768, NT, F.lds);
    float ss[16];
#pragma unroll
    for (int r = 0; r < 16; ++r) ss[r] = 0.f;
#pragma unroll
    for (int d = 0; d < 4; ++d) {
#pragma unroll
        for (int r = 0; r < 16; r += 4) { const f32x4 s4 = *(const f32x4*)(stash + d * 16 + r);
#pragma unroll
            for (int e = 0; e < 4; ++e) { const float v = s4[e] - lam * o[d][r + e]; o[d][r + e] = v; ss[r + e] += v * v; } }
        asm volatile("" ::: "memory"); SBAR(); }
#pragma unroll
    for (int r = 0; r < 16; ++r) { float s = ss[r]; s += __shfl_xor(s, 1); s += __shfl_xor(s, 2); s += __shfl_xor(s, 4); s += __shfl_xor(s, 8); s += __shfl_xor(s, 16);
        ss[r] = (1.0f / sqrtf(s * (1.f / 128.f) + EPS)) * (1.f - lam_init); }
    const float* gs = inp<I_GDASUB>() + l * 128;
    float gcol[4];
#pragma unroll
    for (int d = 0; d < 4; ++d) gcol[d] = gs[d * 32 + r32];
    store_o(o, ss, gcol, WSP(bf16, WS_HEADS) + (size_t)(q0 + wid * 32) * DM + h * 128, DM, F.lds, wid, lane);
    __syncthreads();
}
__device__ __forceinline__ void mla_unit(const Args& A, const Frame& F, int q0, int k0, int NT, int h) {
    int tid_ = threadIdx.x; asm volatile("" : "+v"(tid_)); const int tid = tid_, wid = tid >> 6, lane = tid & 63, r32 = lane & 31, hi = lane >> 5;
    f32x16 o[4];
    attn_pass<192>(o, WSP(bf16, WS_QMLA) + (size_t)(q0 + wid * 32) * 1152 + h * 192, 1152, WSP(bf16, WS_KMLA) + (size_t)k0 * 1152 + h * 192, 1152, WSP(bf16, WS_VMLA) + (size_t)k0 * 768 + h * 128, 768, NT, F.lds);
    float rs[16], gcol[4];
#pragma unroll
    for (int r = 0; r < 16; ++r) rs[r] = 1.f;
#pragma unroll
    for (int d = 0; d < 4; ++d) gcol[d] = 1.f;
    store_o(o, rs, gcol, WSP(bf16, WS_HEADS) + (size_t)(q0 + wid * 32) * DM + 1280 + h * 128, DM, F.lds, wid, lane);
    __syncthreads();
}
__device__ __forceinline__ void da_latent(const Args& A, const Frame& F, int l, int v) { const int bh = v >> 3, qb = v & 7, b = bh / 6, h = bh - b * 6; da_unit(A, F, l, b * TOK + CTX + qb * 256, b * TOK, 36, h); }
__device__ __forceinline__ void da_ctx(const Args& A, const Frame& F, int l, int v) { const int b = v / 6, h = v - b * 6; da_unit(A, F, l, b * TOK, b * TOK, 4, h); }
__device__ __forceinline__ void mla_latent(const Args& A, const Frame& F, int v) { const int bh = v >> 3, qb = v & 7, b = bh / 6, h = bh - b * 6; mla_unit(A, F, b * TOK + CTX + qb * 256, b * TOK, 36, h); }
__device__ __forceinline__ void mla_ctx(const Args& A, const Frame& F, int v) { const int b = v / 6, h = v - b * 6; mla_unit(A, F, b * TOK, b * TOK, 4, h); }
__device__ __forceinline__ void mla_phase(const Args& A, const Frame& F, bool with_ctx) {
    const int nun = with_ctx ? 216 : 192;
    for (int un = F.vcu; un < nun; un += F.G) {
        if (un < 192) { const int bh = un >> 3, qb = un & 7, b = bh / 6, h = bh - b * 6; mla_unit(A, F, b * TOK + CTX + qb * 256, b * TOK, 36, h); }
        else { const int v = un - 192, b = v / 6, h = v - b * 6; mla_unit(A, F, b * TOK, b * TOK, 4, h); }
    }
}

__device__ __forceinline__ void gate_unit(const Args& A, const Frame& F, int l, int ch, int g) {
    int tid_ = threadIdx.x; asm volatile("" : "+v"(tid_)); const int tid = tid_, wid = tid >> 6, lane = tid & 63, r32 = lane & 31, hi = lane >> 5;
    const int r0 = ch * 128;
    LAS unsigned char* img = F.lds;
    { const int sc = (tid & 15) * 8; const float* gain = inp<I_GGMV>() + (l * 4 + g) * 128 + sc; const f32x4 g0 = *(const f32x4*)gain, g1 = *(const f32x4*)(gain + 4);
#pragma unroll
      for (int i = 0; i < 4; ++i) { const int q = (tid >> 4) + 32 * i, row = r0 + q;
          const float* src = WSP(float, WS_GV) + (size_t)row * 512 + g * 128 + sc; const f32x4 a = *(const f32x4*)src, b = *(const f32x4*)(src + 4);
          const f32x4 sq = *(const f32x4*)(WSP(float, WS_GVSS) + (size_t)row * 16 + g * 4); const float rs = 1.0f / sqrtf(((sq[0] + sq[1]) + (sq[2] + sq[3])) * (1.f / 128.f) + EPS);
          *(LAS u32x4*)(img + (q >> 6) * V_TILE + v_st(q & 63, sc)) = pack8(a * rs * g0, b * rs * g1); } }
    __syncthreads();
    const int pb = wid & 3, chh = wid >> 2;
    const bf16* Wsg = WSP(bf16, WS_WSP) + ((size_t)(l * 4 + g) * 128 + pb * 32 + r32) * 128 + hi * 8;
    f32x16 acc0 = f32x16{}, acc1 = f32x16{};
    const int vb0 = (int)(uintptr_t)img + v_rd_base(lane);
#pragma unroll
    for (int t = 0; t < 2; ++t) {
        const bf16x8 a0 = *(const bf16x8*)(Wsg + t * 64), a1 = *(const bf16x8*)(Wsg + t * 64 + 16), a2 = *(const bf16x8*)(Wsg + t * 64 + 32), a3 = *(const bf16x8*)(Wsg + t * 64 + 48);
        const int vb = vb0 + t * V_TILE;
        if (chh == 0) { pv_one<0>(acc0, vb, a0, a1, a2, a3); pv_one<1>(acc1, vb, a0, a1, a2, a3); }
        else          { pv_one<2>(acc0, vb, a0, a1, a2, a3); pv_one<3>(acc1, vb, a0, a1, a2, a3); }
    }
    const float* bs = inp<I_BSP>() + (l * 4 + g) * 128 + pb * 32;
    LAS float* mix = (LAS float*)(F.lds + 2 * V_TILE);
#pragma unroll
    for (int r = 0; r < 16; ++r) { const int p = crow(r, hi); const float bias = bs[p]; LAS float* mp = mix + (pb * 32 + p) * 128 + chh * 64 + r32; mp[0] = acc0[r] + bias; mp[32] = acc1[r] + bias; }
    __syncthreads();
    { const int sc = (tid & 15) * 8; const float* up = WSP(float, WS_U) + (size_t)(r0 + (tid >> 4)) * 512 + g * 128 + sc; bf16* hp = WSP(bf16, WS_HEADS) + (size_t)(r0 + (tid >> 4)) * DM + 768 + g * 128 + sc;
#pragma unroll
      for (int i = 0; i < 4; ++i) { const LAS float* mp = mix + ((tid >> 4) + 32 * i) * 128 + sc; const f32x4 m0 = *(const LAS f32x4*)mp, m1 = *(const LAS f32x4*)(mp + 4);
          const f32x4 u0 = *(const f32x4*)up, u1 = *(const f32x4*)(up + 4); *(u32x4*)hp = pack8(u0 * m0, u1 * m1);
          up += 32 * 512; hp += 32 * (size_t)DM; asm volatile("" : "+v"(up), "+v"(hp)); } }
    __syncthreads();
}
#undef SBAR
}

#ifndef MK_SPLIT
#define MK_SPLIT 0
#endif
constexpr int PH_PER_LAYER = 8, PH_FINAL = 2 + PH_PER_LAYER * DEPTH, N_PHASES = PH_FINAL + 1;

__global__ void __launch_bounds__(NTHR, 2) fwd_kernel(Args args) {
    extern __shared__ __attribute__((aligned(16))) unsigned char lds_raw[];
    cg::grid_group grid = cg::this_grid();
    Frame F;
    F.lds = (LAS unsigned char*)lds_raw;
    F.G = gridDim.x; { const int bx = blockIdx.x; F.vcu = (F.G % 8 == 0) ? (bx % 8) * (F.G / 8) + bx / 8 : bx; }
    const Args& A = args;
    F.out = args.out; F.ws = args.ws;
    const int lo = args.ph_lo, hi = args.ph_hi;
#ifndef PH_MASK
#define PH_MASK 0x7ff
#endif
#define PHM(j) (((PH_MASK) >> (j)) & 1)
#ifndef RPT_MASK
#define RPT_MASK 0
#endif
#define NREP(j) ((((RPT_MASK) >> (j)) & 1) ? 2 : 1)
#define IN(k) (lo <= (k) && (k) < hi)
#define SEAM(k) do { if (IN(k) && IN((k) + ((k) == 0 ? 2 : 1))) xcd_barrier(xb); } while (0)
    const float* ropetab = WSP(float, WS_ROPE);
    volatile LAS unsigned* MISC = (volatile LAS unsigned*)(F.lds + 131072);
    if (threadIdx.x < 64) MISC[threadIdx.x] = 0u;
    unsigned* barw = (unsigned*)(F.ws + WS_BAR);
    __syncthreads();
    if (args.ph_lo < 0) grid.sync();
    XcdBarrier xb = xcd_barrier_post(barw, MISC + 8);

    for (int rep_ = 0; rep_ < NREP(0); ++rep_) { if (rep_) xcd_barrier(xb); if (PHM(0) && IN(0)) { p0_prologue(A, F); } } SEAM(0);

    for (int l = 0; l < DEPTH; ++l) {
        const int pb = 2 + PH_PER_LAYER * l; const bool last = (l == DEPTH - 1); const bool first = (l == 0);
        const float* modl = WSP(float, WS_MOD) + (size_t)l * 5 * MODW;
        for (int rep_ = 0; rep_ < NREP(2); ++rep_) { if (rep_) xcd_barrier(xb); if (PHM(2) && IN(pb + 0)) { norm_phase(A, F, l, first ? 1 : 0, inp<I_GMIX>() + l * DM, 0, first ? nullptr : WSP(float, WS_SLAB), false); } } SEAM(pb + 0);
        for (int rep_ = 0; rep_ < NREP(3); ++rep_) { if (rep_) xcd_barrier(xb); if (PHM(3) && IN(pb + 1)) {
            pg8::Gemm g{WSP(bf16, WS_HN), WSP(bf16, WS_WIN) + (size_t)l * NZP * DM, M, NZP, DM, DM}; TileOrder S; S.init(NZP, F.G, (int)blockIdx.x, 0);
            EpiZ E{F.ws, ropetab};
            pg8::gemm_phase<EpiZ, TileOrder, true, true>(F.lds, g, S, E);
            if (DEFER_CONV) {
                const int nun = 36 * (NZP / 256), rem = nun % F.G, nidle = rem ? F.G - rem : F.G, cid = rem ? (int)blockIdx.x - rem : (int)blockIdx.x;
                if (cid >= 0) { __syncthreads(); if (!last) mod_gemv(A, F, l + 1, cid, nidle); else conv_weights(A, F, l, J_FC2, cid, nidle); __syncthreads(); }
            }
        } } SEAM(pb + 1);
        for (int rep_ = 0; rep_ < NREP(4); ++rep_) { if (rep_) xcd_barrier(xb); if (PHM(4) && IN(pb + 2)) {
            const bool split = F.G == 256; const int xg = F.vcu >> 5, xl = F.vcu & 31; const bool isaux = !split || xl >= 24;
            const int naux = split ? 64 : F.G, caux = split ? xg * 8 + (xl - 24) : F.vcu, catt = xg * 24 + xl;
            if (!isaux) { att::da_latent(A, F, l, catt); }
            else {
                { pg8::Gemm g{WSP(bf16, WS_CKV), WSP(bf16, WS_WUKV) + (size_t)l * NUKV * RANK, M, NUKV, RANK, RANK}; TileOrder S; S.init(NUKV, naux, split ? (xl - 24) * 8 + xg : caux, 0);
                  EpiKV E{F.ws}; pg8::gemm_phase<EpiKV, TileOrder, true, true>(F.lds, g, S, E); }
                { pg8::Gemm g{WSP(bf16, WS_CQ), WSP(bf16, WS_WUQ) + (size_t)l * NUQP * RANK, M, NUQP, RANK, RANK}; TileOrder S; S.init(NUQP, naux, split ? (xl - 24) * 8 + xg : caux, last ? 1 : 0);
                  EpiQ E{F.ws, ropetab}; pg8::gemm_phase<EpiQ, TileOrder, true, true>(F.lds, g, S, E); }
                if (!last) for (int un = caux; un < 24; un += naux) att::da_ctx(A, F, l, un);
                if (!split) for (int un = caux; un < 192; un += naux) att::da_latent(A, F, l, un);
                if (DEFER_CONV) { __syncthreads(); conv_weights(A, F, l, J_OUT, caux, naux); __syncthreads(); }
            }
        } } SEAM(pb + 2);
        for (int rep_ = 0; rep_ < NREP(5); ++rep_) { if (rep_) xcd_barrier(xb); if (PHM(5) && IN(pb + 3)) {
            const bool split = F.G == 256; const int xg = F.vcu >> 5, xl = F.vcu & 31; const bool isaux = !split || xl >= 24;
            const int naux = split ? 64 : F.G, caux = split ? xg * 8 + (xl - 24) : F.vcu, catt = xg * 24 + xl;
            if (split) { if (!isaux) att::mla_latent(A, F, catt); else if (!last && caux < 24) att::mla_ctx(A, F, caux); }
            else att::mla_phase(A, F, !last);
            if (isaux) for (int un = caux; un < 72 * 4; un += naux) { const int ch = un >> 2, g = un & 3; if (last && (ch % 18) < 2) continue; att::gate_unit(A, F, l, ch, g); }
            if (DEFER_CONV && isaux) { __syncthreads(); conv_weights(A, F, l, J_FC1, caux, naux); __syncthreads(); }
        } } SEAM(pb + 3);
        for (int rep_ = 0; rep_ < NREP(6); ++rep_) { if (rep_) xcd_barrier(xb); if (PHM(6) && IN(pb + 4)) {
            { pg8::Gemm g{WSP(bf16, WS_HEADS), WSP(bf16, WS_WOUT) + (size_t)l * DM * DM, M, DM, DM, DM}; TileOrder S; S.init(DM, F.G, (int)blockIdx.x, 1);
              EpiResid E{F.ws, inp<I_X>(), inp<I_CTX>(), modl + 2 * DM, first, NREP(6) == 2 && rep_ == 0};
              pg8::gemm_phase<EpiResid, TileOrder, true, true>(F.lds, g, S, E); }
            if (!last) {
              pg8::Gemm g{WSP(bf16, WS_HEADS), WSP(bf16, WS_WOUT) + (size_t)l * DM * DM, M, DM, DM / 8, DM}; TileOrder S; S.init(DM, F.G, (int)blockIdx.x, 3, 8, DM / 8);
              EpiSlab E{WSP(float, WS_SLAB), modl + 4 * MODW + 2 * DM};
              pg8::gemm_phase<EpiSlab, TileOrder, true, true>(F.lds, g, S, E); }
        } } SEAM(pb + 4);
        for (int rep_ = 0; rep_ < NREP(7); ++rep_) { if (rep_) xcd_barrier(xb); if (PHM(7) && IN(pb + 5)) { norm_phase(A, F, l, first ? 2 : 0, inp<I_GMLP>() + l * DM, 3 * DM, last ? nullptr : WSP(float, WS_SLAB), last); } } SEAM(pb + 5);
        for (int rep_ = 0; rep_ < NREP(8); ++rep_) { if (rep_) xcd_barrier(xb); if (PHM(8) && IN(pb + 6)) {
            pg8::Gemm g{WSP(bf16, WS_HN), WSP(bf16, WS_WFC1) + (size_t)l * FF * DM, M, FF, DM, DM}; TileOrder S; S.init(FF, F.G, (int)blockIdx.x, last ? 1 : 0);
            EpiFc1 E{F.ws};
            pg8::gemm_phase<EpiFc1, TileOrder, true, true>(F.lds, g, S, E);
            if (DEFER_CONV && !last) {
                const int nun = 36 * (FF / 256), rem = nun % F.G, nidle = rem ? F.G - rem : F.G, cid = rem ? (int)blockIdx.x - rem : (int)blockIdx.x;
                if (cid >= 0) { __syncthreads(); conv_weights(A, F, l, J_FC2, cid, nidle); conv_weights(A, F, l + 1, J_IN | J_UQ | J_UKV, cid, nidle); __syncthreads(); }
            }
        } } SEAM(pb + 6);
        for (int rep_ = 0; rep_ < NREP(9); ++rep_) { if (rep_) xcd_barrier(xb); if (PHM(9) && IN(pb + 7)) {
            { pg8::Gemm g{WSP(bf16, WS_ACT), WSP(bf16, WS_WFC2) + (size_t)l * DM * FF, M, DM, FF, FF}; TileOrder S; S.init(DM, F.G, (int)blockIdx.x, 1);
              EpiResid E{F.ws, inp<I_X>(), inp<I_CTX>(), modl + 5 * DM, false, NREP(9) == 2 && rep_ == 0};
              pg8::gemm_phase<EpiResid, TileOrder, true, true>(F.lds, g, S, E); }
            if (!last) {
              pg8::Gemm g{WSP(bf16, WS_ACT), WSP(bf16, WS_WFC2) + (size_t)l * DM * FF, M, DM, FF / 8, FF}; TileOrder S; S.init(DM, F.G, (int)blockIdx.x, 3, 8, FF / 8);
              EpiSlab E{WSP(float, WS_SLAB), modl + 4 * MODW + 5 * DM};
              pg8::gemm_phase<EpiSlab, TileOrder, true, true>(F.lds, g, S, E); }
        } } SEAM(pb + 7);
    }
    for (int rep_ = 0; rep_ < NREP(10); ++rep_) { if (rep_) xcd_barrier(xb); if (PHM(10) && IN(PH_FINAL)) { final_norm_phase(A, F); } }
#undef IN
#undef SEAM
}

extern "C" void kernel_launch(void* const* d_in, const int* in_sizes, int n_in, void* d_out, int out_size, void* d_ws, size_t ws_size, hipStream_t stream) {
    static int grid = 0;
    if (grid == 0) {
        if (n_in != N_IN || ws_size < WS_END || out_size != NB * SEQ * DM) { fprintf(stderr, "kernel_launch: unexpected shapes: n_in %d ws %zu (need %zu) out %d\n", n_in, ws_size, (size_t)WS_END, out_size); grid = -1; return; }
        int dev = 0, cus = 0, per_cu = 0;
        if (hipGetDevice(&dev) != hipSuccess || hipDeviceGetAttribute(&cus, hipDeviceAttributeMultiprocessorCount, dev) != hipSuccess) { fprintf(stderr, "kernel_launch: device query failed\n"); grid = -1; return; }
        if (hipFuncSetAttribute((const void*)fwd_kernel, hipFuncAttributeMaxDynamicSharedMemorySize, LDS_BYTES) != hipSuccess) { fprintf(stderr, "kernel_launch: hipFuncSetAttribute failed\n"); grid = -1; return; }
        if (hipOccupancyMaxActiveBlocksPerMultiprocessor(&per_cu, (const void*)fwd_kernel, NTHR, LDS_BYTES) != hipSuccess || per_cu < 1) { fprintf(stderr, "kernel_launch: occupancy query says %d blocks/CU\n", per_cu); (void)hipGetLastError(); per_cu = 1; }
        grid = cus * per_cu; if (grid > 256) grid = 256;
        grid -= grid % 8;
        fprintf(stderr, "kernel_launch: cus %d per_cu %d grid %d\n", cus, per_cu, grid);
    }
    if (grid <= 0) return;
    if (hipMemsetAsync((char*)d_ws + WS_BAR, 0, 16384 + (size_t)DEPTH * 5 * MODW * 4, stream) != hipSuccess) { fprintf(stderr, "kernel_launch: memset failed\n"); return; }
    Args a{};
    for (int i = 0; i < N_IN; ++i) a.in[i] = (const float*)d_in[i];
    a.out = (float*)d_out; a.ws = (unsigned char*)d_ws;
#if MK_SPLIT
    for (int p = 0; p < N_PHASES; ++p) {
        a.ph_lo = p; a.ph_hi = p + 1; void* kargs[] = {&a};
        hipError_t e = hipLaunchCooperativeKernel((const void*)fwd_kernel, dim3(grid), dim3(NTHR), kargs, LDS_BYTES, stream);
        if (e != hipSuccess) { fprintf(stderr, "kernel_launch: launch of phase %d failed: %s\n", p, hipGetErrorString(e)); break; }
    }
#else
    a.ph_lo = 0; a.ph_hi = N_PHASES; void* kargs[] = {&a};
    hipError_t e = hipLaunchCooperativeKernel((const void*)fwd_kernel, dim3(grid), dim3(NTHR), kargs, LDS_BYTES, stream);
    if (e != hipSuccess) fprintf(stderr, "kernel_launch: cooperative launch failed: %s (grid %d)\n", hipGetErrorString(e), grid);
#endif
}
```
